# Optimizing an MI355X kernel written in HIP

```python
import math
import jax, jax.numpy as jnp
from jax import lax
import numpy as np

D_MODEL = 2048
BATCH = 4
SEQ = 2048
DEPTH = 1
DEC_BATCH = 128
DEC_SEQ = 8
PAST_LEN = 16384
PAGE_SIZE = 128

D_MIX = D_MODEL
SSD_WIDTH = D_MIX // 2
SSD_HEADDIM = 64
SSD_HEADS = SSD_WIDTH // SSD_HEADDIM
SSD_GROUPS = 2
SSD_STATE = 128
SSD_CHUNK = 128
CONV_K = 4
CONV_DIM = SSD_WIDTH + 2 * SSD_GROUPS * SSD_STATE
GM_WIDTH = D_MIX - SSD_WIDTH
GM_HEAD = 128
GM_HEADS = GM_WIDTH // GM_HEAD
GM_CHUNK = 128
D_FF = 4 * D_MODEL
D_IN_PROJ = SSD_WIDTH + CONV_DIM + SSD_HEADS + 2 * GM_WIDTH
ALPHA = (2.0 * DEPTH) ** 0.25
BETA = (8.0 * DEPTH) ** -0.25
LN_EPS = 1e-5

kernel_name = "hymba_ssd_gmlp_deepnorm_adaln_step"


def layer_norm(x, g, b):
    xf = x.astype(jnp.float32)
    mu = jnp.mean(xf, -1, keepdims=True)
    var = jnp.mean(jnp.square(xf - mu), -1, keepdims=True)
    return ((xf - mu) * lax.rsqrt(var + LN_EPS) * g + b).astype(x.dtype)


def gated_group_rmsnorm(y, z, g):
    h = (y * jax.nn.silu(z)).astype(jnp.float32)
    shp = h.shape
    h = h.reshape(shp[:-1] + (SSD_GROUPS, shp[-1] // SSD_GROUPS))
    h = h * lax.rsqrt(jnp.mean(h * h, -1, keepdims=True) + LN_EPS)
    return (h.reshape(shp) * g).astype(y.dtype)


def causal_dwconv(xbc, buf, w, b):
    xp = jnp.concatenate([buf.astype(xbc.dtype), xbc], axis=1)
    y = lax.conv_general_dilated(xp, w[:, None, :].astype(xbc.dtype), window_strides=(1,), padding='VALID',
                                 dimension_numbers=('NWC', 'WIO', 'NWC'), feature_group_count=xbc.shape[-1])
    return jax.nn.silu(y + b), xp[:, -(CONV_K - 1):]


def ssd_scan(x, dt, A, Bm, Cm, D, s0):
    b, L, H, P = x.shape
    q = math.gcd(L, SSD_CHUNK)
    nc = L // q
    rep = H // SSD_GROUPS
    f32 = jnp.float32
    xc = x.astype(f32).reshape(b, nc, q, H, P)
    dtc = dt.astype(f32).reshape(b, nc, q, H)
    Bh = jnp.repeat(Bm.astype(f32), rep, axis=2).reshape(b, nc, q, H, -1)
    Ch = jnp.repeat(Cm.astype(f32), rep, axis=2).reshape(b, nc, q, H, -1)
    acum = jnp.cumsum(dtc * A.astype(f32), axis=2)
    seg = acum[:, :, :, None, :] - acum[:, :, None, :, :]
    causal = jnp.tril(jnp.ones((q, q), bool))[:, :, None]
    decay = jnp.exp(jnp.where(causal, seg, -jnp.inf))
    xdt = xc * dtc[..., None]
    scores = jnp.einsum('bcihn,bcjhn->bcijh', Ch, Bh) * decay
    y_diag = jnp.einsum('bcijh,bcjhp->bcihp', scores, xdt)
    decay_end = jnp.exp(acum[:, :, -1:, :] - acum)
    chunk_states = jnp.einsum('bcjhn,bcjhp->bchpn', Bh * decay_end[..., None], xdt)
    chunk_decay = jnp.exp(acum[:, :, -1, :])

    def step(s, inp):
        st, dc = inp
        return dc[:, :, None, None] * s + st, s

    s_final, s_in = lax.scan(step, s0.astype(f32),
                             (jnp.moveaxis(chunk_states, 1, 0), jnp.moveaxis(chunk_decay, 1, 0)))
    s_in = jnp.moveaxis(s_in, 0, 1)
    y_off = jnp.einsum('bcihn,bchpn->bcihp', Ch, s_in) * jnp.exp(acum)[..., None]
    y = y_diag + y_off + D.astype(f32)[:, None] * xc
    return y.reshape(b, L, H, P).astype(x.dtype), s_final.astype(s0.dtype)


def chunk_spatial_gate(u, v, ln_g, ln_b, w_s, b_s):
    b, L, _ = u.shape
    q = min(GM_CHUNK, L)
    nc = L // q
    u = jax.nn.gelu(u)
    v = layer_norm(jax.nn.gelu(v), ln_g, ln_b)
    w = jnp.where(jnp.tril(jnp.ones((q, q), bool)), w_s[:, :q, :q], 0.0)
    vc = v.reshape(b, nc, q, GM_HEADS, GM_HEAD)
    mixed = jnp.einsum('hij,bcjhd->bcihd', w, vc) + jnp.transpose(b_s[:, :q])[None, None, :, :, None]
    return u * mixed.reshape(b, L, GM_WIDTH).astype(u.dtype), v


def hybrid_mixer(h, conv_buf, ssm_state, w_in, conv_w, conv_b, dt_bias, a_log, d_skip, ssd_norm_g,
                 gm_ln_g, gm_ln_b, gm_w_s, gm_b_s, w_out):
    b, L, _ = h.shape
    proj = h @ w_in
    i1 = SSD_WIDTH
    i2 = i1 + CONV_DIM
    i3 = i2 + SSD_HEADS
    i4 = i3 + GM_WIDTH
    z, xbc, dt_raw, u, v = jnp.split(proj, [i1, i2, i3, i4], axis=-1)
    xbc, new_buf = causal_dwconv(xbc, conv_buf, conv_w, conv_b)
    xs, Bm, Cm = jnp.split(xbc, [SSD_WIDTH, SSD_WIDTH + SSD_GROUPS * SSD_STATE], axis=-1)
    dt = jax.nn.softplus((dt_raw + dt_bias).astype(jnp.float32))
    A = -jnp.exp(a_log.astype(jnp.float32))
    y, s_new = ssd_scan(xs.reshape(b, L, SSD_HEADS, SSD_HEADDIM), dt, A,
                        Bm.reshape(b, L, SSD_GROUPS, SSD_STATE), Cm.reshape(b, L, SSD_GROUPS, SSD_STATE),
                        d_skip, ssm_state)
    y_ssd = gated_group_rmsnorm(y.reshape(b, L, SSD_WIDTH), z, ssd_norm_g)
    y_gm, v_rows = chunk_spatial_gate(u, v, gm_ln_g, gm_ln_b, gm_w_s, gm_b_s)
    out = jnp.concatenate([y_ssd, y_gm], axis=-1) @ w_out
    return out, new_buf, s_new, v_rows


def decoder_layer(x, c, conv_buf, ssm_state, w_mod, b_mod, w_in, conv_w, conv_b, dt_bias, a_log, d_skip,
                  ssd_norm_g, gm_ln_g, gm_ln_b, gm_w_s, gm_b_s, w_out, ln_mix_g, ln_mix_b,
                  w_ff1, w_ff2, ln_ffn_g, ln_ffn_b):
    mod = (jax.nn.silu(c) @ w_mod + b_mod)[:, None, :]
    sh_m, sc_m, g_m, sh_f, sc_f, g_f = jnp.split(mod, 6, axis=-1)
    h = x * (1 + sc_m) + sh_m
    mix, new_buf, s_new, v_rows = hybrid_mixer(h, conv_buf, ssm_state, w_in, conv_w, conv_b, dt_bias, a_log,
                                               d_skip, ssd_norm_g, gm_ln_g, gm_ln_b, gm_w_s, gm_b_s, w_out)
    x = layer_norm(ALPHA * x + (1 + g_m) * mix, ln_mix_g, ln_mix_b)
    h = x * (1 + sc_f) + sh_f
    f = jnp.square(jax.nn.relu(h @ w_ff1)) @ w_ff2
    x = layer_norm(ALPHA * x + (1 + g_f) * f, ln_ffn_g, ln_ffn_b)
    return x, new_buf, s_new, v_rows


def setup_inputs(seed: int = 0) -> dict:
    key = jax.random.key(seed)
    ks = iter(jax.random.split(key, 40))
    f32 = jnp.float32

    def nrm(shape, s):
        return jax.random.normal(next(ks), shape, f32) * s

    dt0 = jnp.exp(jax.random.uniform(next(ks), (DEPTH, SSD_HEADS), f32, math.log(1e-3), math.log(1e-1)))
    dt_bias = dt0 + jnp.log(-jnp.expm1(-dt0))
    a_log = jnp.log(jax.random.uniform(next(ks), (DEPTH, SSD_HEADS), f32, 1.0, 16.0))
    return {
        "x_prompt": nrm((BATCH, SEQ, D_MODEL), 1.0),
        "x_sample": nrm((DEC_BATCH, DEC_SEQ, D_MODEL), 1.0),
        "state_ssm": nrm((DEPTH, DEC_BATCH, SSD_HEADS, SSD_HEADDIM, SSD_STATE), 0.5),
        "state_conv": nrm((DEPTH, DEC_BATCH, CONV_K - 1, CONV_DIM), 1.0),
        "c_prompt": nrm((BATCH, D_MODEL), 1.0),
        "c_sample": nrm((DEC_BATCH, D_MODEL), 1.0),
        "ln_in_g": 1.0 + nrm((D_MODEL,), 0.02),
        "ln_in_b": nrm((D_MODEL,), 0.02),
        "w_mod": nrm((DEPTH, D_MODEL, 6 * D_MODEL), 0.5 * D_MODEL ** -0.5),
        "b_mod": nrm((DEPTH, 6 * D_MODEL), 0.02),
        "w_in": nrm((DEPTH, D_MODEL, D_IN_PROJ), D_MODEL ** -0.5),
        "conv_w": nrm((DEPTH, CONV_K, CONV_DIM), CONV_K ** -0.5),
        "conv_b": nrm((DEPTH, CONV_DIM), 0.02),
        "dt_bias": dt_bias,
        "a_log": a_log,
        "d_skip": 1.0 + nrm((DEPTH, SSD_HEADS), 0.02),
        "ssd_norm_g": 1.0 + nrm((DEPTH, SSD_WIDTH), 0.02),
        "gm_ln_g": 1.0 + nrm((DEPTH, GM_WIDTH), 0.02),
        "gm_ln_b": nrm((DEPTH, GM_WIDTH), 0.02),
        "gm_w_s": nrm((DEPTH, GM_HEADS, GM_CHUNK, GM_CHUNK), GM_CHUNK ** -0.5),
        "gm_b_s": 1.0 + nrm((DEPTH, GM_HEADS, GM_CHUNK), 0.02),
        "w_out": nrm((DEPTH, D_MIX, D_MODEL), BETA * D_MIX ** -0.5),
        "ln_mix_g": 1.0 + nrm((DEPTH, D_MODEL), 0.02),
        "ln_mix_b": nrm((DEPTH, D_MODEL), 0.02),
        "w_ff1": nrm((DEPTH, D_MODEL, D_FF), D_MODEL ** -0.5),
        "w_ff2": nrm((DEPTH, D_FF, D_MODEL), BETA * D_FF ** -0.5),
        "ln_ffn_g": 1.0 + nrm((DEPTH, D_MODEL), 0.02),
        "ln_ffn_b": nrm((DEPTH, D_MODEL), 0.02),
    }


def reference(x_prompt, x_sample, state_ssm, state_conv, c_prompt, c_sample, ln_in_g, ln_in_b,
              w_mod, b_mod, w_in, conv_w, conv_b, dt_bias, a_log, d_skip, ssd_norm_g, gm_ln_g, gm_ln_b,
              gm_w_s, gm_b_s, w_out, ln_mix_g, ln_mix_b, w_ff1, w_ff2, ln_ffn_g, ln_ffn_b):
    bp = x_prompt.shape[0]
    xp = layer_norm(x_prompt, ln_in_g, ln_in_b)
    xs = layer_norm(x_sample, ln_in_g, ln_in_b)
    ssm_p, conv_p, ssm_s, conv_s, v_s = [], [], [], [], []
    for l in range(DEPTH):
        prm = (w_mod[l], b_mod[l], w_in[l], conv_w[l], conv_b[l], dt_bias[l], a_log[l], d_skip[l],
               ssd_norm_g[l], gm_ln_g[l], gm_ln_b[l], gm_w_s[l], gm_b_s[l], w_out[l], ln_mix_g[l], ln_mix_b[l],
               w_ff1[l], w_ff2[l], ln_ffn_g[l], ln_ffn_b[l])
        zero_buf = jnp.zeros((bp, CONV_K - 1, CONV_DIM), xp.dtype)
        zero_ssm = jnp.zeros((bp, SSD_HEADS, SSD_HEADDIM, SSD_STATE), state_ssm.dtype)
        xp, buf_p, s_p, _ = decoder_layer(xp, c_prompt, zero_buf, zero_ssm, *prm)
        xs, buf_s, s_s, v_rows = decoder_layer(xs, c_sample, state_conv[l], state_ssm[l], *prm)
        ssm_p.append(s_p)
        conv_p.append(buf_p)
        ssm_s.append(s_s)
        conv_s.append(buf_s)
        v_s.append(v_rows)
    return (xp, xs, jnp.stack(ssm_p), jnp.stack(conv_p), jnp.stack(ssm_s), jnp.stack(conv_s), jnp.stack(v_s))
```

```cpp
#include <hip/hip_runtime.h>
#include <cstdio>
#include <cstdint>
namespace pg8 {
#define PG8_LAS __attribute__((address_space(3)))
typedef unsigned short bf16_t;
typedef short bf16x8 __attribute__((ext_vector_type(8)));
typedef float f32x4 __attribute__((ext_vector_type(4)));
typedef unsigned u32x4 __attribute__((ext_vector_type(4)));
constexpr int BM = 256, BK = 64, HALF = 128, HTB = HALF * BK * 2  , STAGE_BYTES = 8 * HTB, NXCD = 8, WGM = 8;

__host__ __device__ __forceinline__ int lds_byte(int r, int c) { const int st = (r >> 4) * 2 + (c >> 5), rr = r & 15, cc = c & 31, ob = rr * 64 + cc * 2; return st * 1024 + (ob ^ (((ob >> 9) & 1) << 5)); }
__host__ __device__ __forceinline__ void stage_rc(int b, int& R, int& C) { const int st = b / 1024, sb = b % 1024, swz = sb ^ (((sb >> 9) & 1) << 5); R = (st >> 1) * 16 + swz / 64; C = (st & 1) * 32 + (swz % 64) / 2; }
__host__ __device__ __forceinline__ int perm32(int rho) { const int n = rho >> 4, i = rho & 15; return 8 * (i >> 2) + 4 * n + (i & 3); }

struct Unit { int pm, pn; };
struct Gemm { const bf16_t* A; const bf16_t* Bt; int M, N, K, pad; };

struct StaticOrder {
    int nM, nN, nwg, G, c;
    __host__ __device__ void init(int M, int N, int G_, int c_) { nM = M / BM; nN = N / BM; nwg = nM * nN; G = G_; c = c_; }
    __host__ __device__ bool next(int i, Unit& u) const {
        const long L = (long)i * G + c; if (L >= nwg) return false;
        int wgid = (int)L; { const int q = nwg / NXCD, r = nwg % NXCD, xcd = wgid % NXCD, off = wgid / NXCD; wgid = (xcd < r ? xcd * (q + 1) : r * (q + 1) + (xcd - r) * q) + off; }
        const int nig = WGM * nN, gid = wgid / nig, fm = gid * WGM, gsz = (nM - fm) < WGM ? (nM - fm) : WGM;
        u.pm = fm + ((wgid % nig) % gsz); u.pn = (wgid % nig) / gsz; return true;
    }
    __device__ __forceinline__ void a_ready(const Unit&) const {}
    __device__ __forceinline__ void done(const Unit&) const {}
};

__device__ __forceinline__ unsigned cvt_pk_bf16(float lo, float hi) { unsigned r; asm volatile("v_cvt_pk_bf16_f32 %0, %1, %2" : "=v"(r) : "v"(lo), "v"(hi)); return r; }

template <int ACT  > struct EpiBf16P {
    static constexpr bool PERM = true, AFTER_DRAIN = false;
    bf16_t* O; int ldc, pad;
    __device__ __forceinline__ void operator()(const f32x4 (&acc)[2][2][4][2], const Unit& u, int wr, int wc, int fr, int fq) const {
        const int row0 = u.pm * BM + wr * 64 + fr; const int col0 = u.pn * BM + wc * 32 + 8 * fq;
#pragma unroll
        for (int ai = 0; ai < 2; ++ai)
#pragma unroll
            for (int m = 0; m < 4; ++m) { bf16_t* rowp = O + (size_t)(row0 + ai * HALF + m * 16) * ldc + col0;
#pragma unroll
                for (int bj = 0; bj < 2; ++bj) { f32x4 v0 = acc[ai][bj][m][0], v1 = acc[ai][bj][m][1];
                    if (ACT == 2) {
#pragma unroll
                        for (int j = 0; j < 4; ++j) { const float a = fmaxf(v0[j], 0.f), b = fmaxf(v1[j], 0.f); v0[j] = a * a; v1[j] = b * b; } }
                    u32x4 w; w.x = cvt_pk_bf16(v0[0], v0[1]); w.y = cvt_pk_bf16(v0[2], v0[3]); w.z = cvt_pk_bf16(v1[0], v1[1]); w.w = cvt_pk_bf16(v1[2], v1[3]);
                    *(u32x4*)(rowp + bj * HALF) = w; } }
    }
};
struct EpiF32P {
    static constexpr bool PERM = false, AFTER_DRAIN = false;
    float* C; int ldc, pad;
    __device__ __forceinline__ void operator()(const f32x4 (&acc)[2][2][4][2], const Unit& u, int wr, int wc, int fr, int fq) const {
        const int row0 = u.pm * BM + wr * 64 + fr, col0 = u.pn * BM + wc * 32 + 4 * fq;
#pragma unroll
        for (int ai = 0; ai < 2; ++ai)
#pragma unroll
            for (int m = 0; m < 4; ++m) { float* rowp = C + (size_t)(row0 + ai * HALF + m * 16) * ldc + col0;
#pragma unroll
                for (int bj = 0; bj < 2; ++bj)
#pragma unroll
                    for (int n = 0; n < 2; ++n) *(f32x4*)(rowp + bj * HALF + n * 16) = acc[ai][bj][m][n]; }
    }
};
template <class Epi, class Sched, bool ALIGN_EPI = false, bool SP2 = false>
__device__ __forceinline__ void gemm_phase(PG8_LAS unsigned char* lds, const Gemm g, const Sched& S, const Epi& E) {
    const int tid = threadIdx.x, wid = __builtin_amdgcn_readfirstlane(tid >> 6), lane = tid & 63, wr = wid >> 2, wc = wid & 3, fr = lane & 15, fq = lane >> 4;
    const int K = g.K, nt = K / BK;
    unsigned voffA[2], voffB[2];
#pragma unroll
    for (int i = 0; i < 2; ++i) { int R, C; stage_rc(tid * 16 + i * 8192, R, C); const int Rb = Epi::PERM ? ((R & ~31) + perm32(R & 31)) : R;
        voffA[i] = (unsigned)(R * K + C) * 2u; voffB[i] = (unsigned)(Rb * K + C) * 2u; }
    const size_t kstep = (size_t)(BK * 2);
    const size_t hstep = (size_t)HALF * K * 2;
    const size_t tstep = 2 * hstep;
    const unsigned ldsw = (unsigned)wid * 1024u;
    const int aoff = lds_byte(wr * 64 + fr, fq * 8), boff = lds_byte(wc * 32 + fr, fq * 8);
#define PG8_SA(b, h) (((b) * 2 + (h)) * HTB)
#define PG8_SB(b, h) ((4 + (b) * 2 + (h)) * HTB)
#define PG8_STAGE(bufoff, gbase, voff) do { _Pragma("unroll") for (int _i = 0; _i < 2; ++_i) \
        __builtin_amdgcn_global_load_lds((const unsigned*)((const char*)(gbase) + (voff)[_i]), (PG8_LAS unsigned*)(lds + (bufoff) + ldsw + _i * 8192), 16, 0, 0); } while (0)
#define PG8_LDA(dst, b, h) do { _Pragma("unroll") for (int m = 0; m < 4; ++m) _Pragma("unroll") for (int k = 0; k < 2; ++k) dst[m][k] = *(const PG8_LAS bf16x8*)(lds + PG8_SA(b, h) + aoff + m * 2048 + k * 1024); } while (0)
#define PG8_LDB(dst, b, h) do { _Pragma("unroll") for (int n = 0; n < 2; ++n) _Pragma("unroll") for (int k = 0; k < 2; ++k) dst[n][k] = *(const PG8_LAS bf16x8*)(lds + PG8_SB(b, h) + boff + n * 2048 + k * 1024); } while (0)
#define PG8_MMA(ai, bj, At, Bt) do { __builtin_amdgcn_s_setprio(1); _Pragma("unroll") for (int m = 0; m < 4; ++m) _Pragma("unroll") for (int n = 0; n < 2; ++n) _Pragma("unroll") for (int k = 0; k < 2; ++k) \
        acc[ai][bj][m][n] = __builtin_amdgcn_mfma_f32_16x16x32_bf16(Bt[n][k], At[m][k], acc[ai][bj][m][n], 0, 0, 0); __builtin_amdgcn_s_setprio(0); } while (0)
#define PG8_WAIT_V(n) asm volatile("s_waitcnt vmcnt(" #n ")" ::: "memory")
#define PG8_WAIT_L(n) asm volatile("s_waitcnt lgkmcnt(" #n ")" ::: "memory")
#define PG8_BAR __builtin_amdgcn_s_barrier()
#define PG8_SCHED __builtin_amdgcn_sched_barrier(0)
    Unit cur, nxt; int ui = 0;
    if (!S.next(0, cur)) return;
    f32x4 acc[2][2][4][2];
#pragma unroll
    for (int a = 0; a < 2; ++a)
#pragma unroll
        for (int b = 0; b < 2; ++b)
#pragma unroll
            for (int m = 0; m < 4; ++m)
#pragma unroll
                for (int n = 0; n < 2; ++n) acc[a][b][m][n] = (f32x4){0.f, 0.f, 0.f, 0.f};
    bf16x8 At[4][2], B0[2][2], B1[2][2];
    const char* cA = (const char*)g.A + (size_t)cur.pm * tstep; const char* cB = (const char*)g.Bt + (size_t)cur.pn * tstep;
    S.a_ready(cur);
    if constexpr (SP2) {
        PG8_STAGE(PG8_SB(0, 0), cB, voffB); PG8_STAGE(PG8_SB(0, 1), cB + hstep, voffB); PG8_STAGE(PG8_SA(0, 0), cA, voffA); PG8_STAGE(PG8_SA(0, 1), cA + hstep, voffA);
        if (wr == 1) PG8_BAR;
        PG8_WAIT_V(2); PG8_BAR;
        PG8_STAGE(PG8_SB(1, 0), cB + kstep, voffB); PG8_STAGE(PG8_SA(1, 0), cA + kstep, voffA); PG8_STAGE(PG8_SB(1, 1), cB + hstep + kstep, voffB);
        PG8_WAIT_V(6); PG8_BAR;
    } else {
        PG8_STAGE(PG8_SB(0, 0), cB, voffB); PG8_STAGE(PG8_SA(0, 0), cA, voffA); PG8_STAGE(PG8_SB(0, 1), cB + hstep, voffB); PG8_STAGE(PG8_SA(0, 1), cA + hstep, voffA);
        if (wr == 1) PG8_BAR;
        PG8_WAIT_V(4); PG8_BAR;
        PG8_STAGE(PG8_SB(1, 0), cB + kstep, voffB); PG8_STAGE(PG8_SA(1, 0), cA + kstep, voffA); PG8_STAGE(PG8_SB(1, 1), cB + hstep + kstep, voffB);
        PG8_WAIT_V(6); PG8_BAR;
    }
    for (;;) {
        const bool has_next = S.next(ui + 1, nxt);
        const char* nA = has_next ? (const char*)g.A + (size_t)nxt.pm * tstep : cA; const char* nB = has_next ? (const char*)g.Bt + (size_t)nxt.pn * tstep : cB;
        for (int t = 0; t < nt; t += 2) {
            const bool last = (t == nt - 2);
            const char* a1 = cA + (size_t)(t + 1) * kstep;
            const char* a2 = last ? nA : cA + (size_t)(t + 2) * kstep; const char* b2 = last ? nB : cB + (size_t)(t + 2) * kstep;
            const char* a3 = a2 + kstep; const char* b3 = b2 + kstep;
            if (last && has_next) S.a_ready(nxt);
            if constexpr (SP2) {
            PG8_LDB(B0, 0, 0); PG8_LDB(B1, 0, 1); PG8_SCHED; PG8_LDA(At, 0, 0); PG8_STAGE(PG8_SA(1, 1), a1 + hstep, voffA);
            PG8_WAIT_V(8); PG8_WAIT_L(0); PG8_BAR; PG8_MMA(0, 0, At, B0); PG8_MMA(0, 1, At, B1); PG8_BAR; PG8_SCHED;
            PG8_LDA(At, 0, 1); PG8_STAGE(PG8_SB(0, 0), b2, voffB); PG8_STAGE(PG8_SB(0, 1), b2 + hstep, voffB); PG8_STAGE(PG8_SA(0, 0), a2, voffA);
            PG8_WAIT_V(8); PG8_WAIT_L(0); PG8_BAR; PG8_MMA(1, 0, At, B0); PG8_MMA(1, 1, At, B1); PG8_BAR; PG8_SCHED;
            PG8_LDB(B0, 1, 0); PG8_LDB(B1, 1, 1); PG8_SCHED; PG8_LDA(At, 1, 0); PG8_STAGE(PG8_SA(0, 1), a2 + hstep, voffA);
            PG8_WAIT_V(8); PG8_WAIT_L(0); PG8_BAR; PG8_MMA(0, 0, At, B0); PG8_MMA(0, 1, At, B1); PG8_BAR; PG8_SCHED;
            PG8_LDA(At, 1, 1); PG8_STAGE(PG8_SB(1, 0), b3, voffB); PG8_STAGE(PG8_SB(1, 1), b3 + hstep, voffB); PG8_STAGE(PG8_SA(1, 0), a3, voffA);
            PG8_WAIT_V(8); PG8_WAIT_L(0); PG8_BAR; PG8_MMA(1, 0, At, B0); PG8_MMA(1, 1, At, B1); PG8_BAR; PG8_SCHED;
            } else {
            PG8_LDB(B0, 0, 0); PG8_SCHED; PG8_LDA(At, 0, 0); PG8_STAGE(PG8_SA(1, 1), a1 + hstep, voffA);
            PG8_WAIT_L(8); PG8_BAR; PG8_WAIT_L(0); PG8_MMA(0, 0, At, B0); PG8_BAR; PG8_SCHED;
            PG8_LDB(B1, 0, 1); PG8_STAGE(PG8_SB(0, 0), b2, voffB);
            PG8_BAR; PG8_WAIT_L(0); PG8_MMA(0, 1, At, B1); PG8_BAR;
            PG8_LDA(At, 0, 1); PG8_STAGE(PG8_SA(0, 0), a2, voffA);
            PG8_BAR; PG8_WAIT_L(0); PG8_MMA(1, 0, At, B0); PG8_BAR; PG8_SCHED;
            PG8_STAGE(PG8_SB(0, 1), b2 + hstep, voffB);
            PG8_WAIT_V(6); PG8_BAR; PG8_MMA(1, 1, At, B1); PG8_BAR;
            PG8_LDB(B0, 1, 0); PG8_SCHED; PG8_LDA(At, 1, 0); PG8_STAGE(PG8_SA(0, 1), a2 + hstep, voffA);
            PG8_WAIT_L(8); PG8_BAR; PG8_WAIT_L(0); PG8_MMA(0, 0, At, B0); PG8_BAR; PG8_SCHED;
            PG8_LDB(B1, 1, 1); PG8_STAGE(PG8_SB(1, 0), b3, voffB);
            PG8_BAR; PG8_WAIT_L(0); PG8_MMA(0, 1, At, B1); PG8_BAR;
            PG8_LDA(At, 1, 1); PG8_STAGE(PG8_SA(1, 0), a3, voffA);
            PG8_BAR; PG8_WAIT_L(0); PG8_MMA(1, 0, At, B0); PG8_BAR; PG8_SCHED;
            PG8_STAGE(PG8_SB(1, 1), b3 + hstep, voffB);
            PG8_WAIT_V(6); PG8_BAR; PG8_MMA(1, 1, At, B1); PG8_BAR;
            }
        }
        if constexpr (ALIGN_EPI) { if (wr == 0) PG8_BAR; }
        if constexpr (!Epi::AFTER_DRAIN) { E(acc, cur, wr, wc, fr, fq); S.done(cur); }
        if (!has_next) break;
#pragma unroll
        for (int a = 0; a < 2; ++a)
#pragma unroll
            for (int b = 0; b < 2; ++b)
#pragma unroll
                for (int m = 0; m < 4; ++m)
#pragma unroll
                    for (int n = 0; n < 2; ++n) acc[a][b][m][n] = (f32x4){0.f, 0.f, 0.f, 0.f};
        cur = nxt; cA = nA; cB = nB; ++ui;
        if constexpr (ALIGN_EPI) { if (wr == 1) PG8_BAR; }
    }
    PG8_WAIT_V(0);
    if constexpr (!ALIGN_EPI) { if (wr == 0) PG8_BAR; }
    PG8_BAR;
    if constexpr (Epi::AFTER_DRAIN) { E.fused(acc, cur, wr, wc, fr, fq, lds, wid, lane); S.done(cur); }
#undef PG8_SA
#undef PG8_SB
#undef PG8_STAGE
#undef PG8_LDA
#undef PG8_LDB
#undef PG8_MMA
#undef PG8_WAIT_V
#undef PG8_WAIT_L
#undef PG8_BAR
#undef PG8_SCHED
}
}

typedef unsigned short bf16;
typedef float f32x4 __attribute__((ext_vector_type(4)));
constexpr int DM = 2048, NPB = 4, SEQ = 2048, NSB = 128, DSEQ = 8;
constexpr int MP = NPB * SEQ, MS = NSB * DSEQ, MROWS = MP + MS;
constexpr int NSEQ = NPB + NSB;
constexpr int SSDW = 1024, HDIM = 64, NHEAD = 16, NGRP = 2, NSTATE = 128, CONVD = 1536, GMW = 1024, GMHD = 128, GMNH = 8, DFF = 8192;
constexpr int DINP = 4624, NPROJ = 4608;
constexpr int PZ = 0, PX = 1024, PU = 2560, PV = 3584;
constexpr int NMOD = 6 * DM;
constexpr float LN_EPS = 1e-5f, ALPHA = 1.189207115002721f;
constexpr size_t O_YP = 0, O_YS = 16777216, O_SSMP = 18874368, O_CONVP = 19398656, O_SSMS = 19417088, O_CONVS = 36194304, O_CV = 36784128;
constexpr size_t MiB = 1u << 20;
constexpr size_t WS_WIN = 2 * MiB, WS_WOUT = 20 * MiB, WS_WFF1 = 28 * MiB, WS_WFF2 = 60 * MiB, WS_WDT = 92 * MiB, WS_MOD = 93 * MiB, WS_STATS = 100 * MiB, WS_DT = 101 * MiB;
constexpr size_t WS_H = 102 * MiB;
constexpr size_t WS_BIG = 138 * MiB;
constexpr size_t WS_ACT = WS_BIG + 81 * MiB;
constexpr size_t WS_E = 282 * MiB;
constexpr size_t WS_VN = WS_E + 36 * MiB;
constexpr size_t WS_END = 354 * MiB;

__device__ __forceinline__ float bf2f(bf16 b) { return __uint_as_float(((unsigned)b) << 16); }
__device__ __forceinline__ bf16 f2bf(float f) { unsigned u = __float_as_uint(f); return (bf16)((u + 0x7fffu + ((u >> 16) & 1u)) >> 16); }
__device__ __forceinline__ float silu_f(float x) { return x / (1.f + expf(-x)); }
__device__ __forceinline__ float softplus_f(float x) { return fmaxf(x, 0.f) + log1pf(expf(-fabsf(x))); }
__device__ __forceinline__ float gelu_f(float x) { return 0.5f * x * (1.f + tanhf(0.7978845608028654f * (x + 0.044715f * x * x * x))); }
__device__ __forceinline__ int modrow(int r) { return r < MP ? (r >> 11) : NPB + ((r - MP) >> 3); }
__device__ __forceinline__ float wave_sum(float v) {
#pragma unroll
    for (int o = 1; o < 64; o <<= 1) v += __shfl_xor(v, o);
    return v;
}
__device__ __forceinline__ float block_sum256(float v, float* red) {
    v = wave_sum(v);
    __syncthreads();
    if ((threadIdx.x & 63) == 0) red[threadIdx.x >> 6] = v;
    __syncthreads();
    return (red[0] + red[1]) + (red[2] + red[3]);
}

__global__ void __launch_bounds__(256) k_transpose(const float* __restrict__ W, int K, int ld, int col0, int N, bf16* __restrict__ WT) {
    __shared__ float tile[64][65];
    const int nb = N / 64, kb = blockIdx.x / nb, nbi = blockIdx.x % nb, k0 = kb * 64, n0 = nbi * 64, tid = threadIdx.x;
#pragma unroll
    for (int i = 0; i < 16; ++i) { const int kk = i * 4 + (tid >> 6), nn = tid & 63; tile[kk][nn] = W[(size_t)(k0 + kk) * ld + col0 + n0 + nn]; }
    __syncthreads();
#pragma unroll
    for (int i = 0; i < 16; ++i) { const int nn = i * 4 + (tid >> 6), kk = tid & 63; WT[(size_t)(n0 + nn) * K + k0 + kk] = f2bf(tile[kk][nn]); }
}
__global__ void __launch_bounds__(256) k_wdt(const float* __restrict__ w_in, float* __restrict__ wdt) {
    const int i = blockIdx.x * 256 + threadIdx.x; if (i >= 16 * DM) return;
    const int h = i / DM, k = i % DM; wdt[i] = w_in[(size_t)k * DINP + 2560 + h];
}
__global__ void __launch_bounds__(256) k_mod(const float* __restrict__ c_prompt, const float* __restrict__ c_sample, const float* __restrict__ w_mod, const float* __restrict__ b_mod, float* __restrict__ mod) {
    __shared__ float sc[12][256];
    const int tid = threadIdx.x, n = blockIdx.x * 256 + tid, r0 = blockIdx.y * 12;
    float acc[12];
#pragma unroll
    for (int i = 0; i < 12; ++i) acc[i] = 0.f;
    for (int k0 = 0; k0 < DM; k0 += 256) {
        __syncthreads();
#pragma unroll
        for (int i = 0; i < 12; ++i) { const int r = r0 + i; const float* c = r < NPB ? c_prompt + (size_t)r * DM : c_sample + (size_t)(r - NPB) * DM; sc[i][tid] = silu_f(c[k0 + tid]); }
        __syncthreads();
        for (int kk = 0; kk < 256; ++kk) { const float w = w_mod[(size_t)(k0 + kk) * NMOD + n];
#pragma unroll
            for (int i = 0; i < 12; ++i) acc[i] += sc[i][kk] * w; }
    }
    const float bb = b_mod[n];
#pragma unroll
    for (int i = 0; i < 12; ++i) mod[(size_t)(r0 + i) * NMOD + n] = acc[i] + bb;
}
__global__ void __launch_bounds__(256) k_ln_h1(const float* __restrict__ x_prompt, const float* __restrict__ x_sample, const float* __restrict__ g, const float* __restrict__ b,
                                               const float* __restrict__ mod, float* __restrict__ stats, bf16* __restrict__ h1) {
    __shared__ float red[4];
    const int r = blockIdx.x, tid = threadIdx.x;
    const float* xr = r < MP ? x_prompt + (size_t)r * DM : x_sample + (size_t)(r - MP) * DM;
    float v[8];
    { const f32x4 a = *(const f32x4*)(xr + tid * 4), c = *(const f32x4*)(xr + 1024 + tid * 4); v[0] = a[0]; v[1] = a[1]; v[2] = a[2]; v[3] = a[3]; v[4] = c[0]; v[5] = c[1]; v[6] = c[2]; v[7] = c[3]; }
    float s = 0.f;
#pragma unroll
    for (int j = 0; j < 8; ++j) s += v[j];
    const float mean = block_sum256(s, red) * (1.f / DM);
    float q = 0.f;
#pragma unroll
    for (int j = 0; j < 8; ++j) { const float d = v[j] - mean; q += d * d; }
    const float rstd = 1.f / sqrtf(block_sum256(q, red) * (1.f / DM) + LN_EPS);
    if (tid == 0) { stats[2 * r] = mean; stats[2 * r + 1] = rstd; }
    const float* mr = mod + (size_t)modrow(r) * NMOD;
#pragma unroll
    for (int j = 0; j < 8; ++j) { const int c = (j < 4 ? 0 : 1024) + tid * 4 + (j & 3);
        const float xn = (v[j] - mean) * rstd * g[c] + b[c];
        h1[(size_t)r * DM + c] = f2bf(xn * (1.f + mr[DM + c]) + mr[c]); }
}
__global__ void __launch_bounds__(256) k_dt(const bf16* __restrict__ h1, const float* __restrict__ wdt, const float* __restrict__ dt_bias, float* __restrict__ dt) {
    const int tid = threadIdx.x, r = blockIdx.x * 16 + (tid >> 4), h = tid & 15;
    const bf16* hr = h1 + (size_t)r * DM; const float* w = wdt + (size_t)h * DM;
    float a = 0.f;
    for (int k = 0; k < DM; ++k) a += bf2f(hr[k]) * w[k];
    dt[r * 16 + h] = softplus_f(a + dt_bias[h]);
}
__global__ void __launch_bounds__(256) k_conv(const bf16* __restrict__ proj, const float* __restrict__ state_conv, const float* __restrict__ conv_w, const float* __restrict__ conv_b,
                                              float* __restrict__ act, float* __restrict__ out) {
    const int r = blockIdx.x, c = blockIdx.y * 256 + threadIdx.x;
    int t, rowbase; const float* sc = nullptr;
    if (r < MP) { t = r & (SEQ - 1); rowbase = r - t; } else { const int bs = (r - MP) >> 3; t = (r - MP) & 7; rowbase = r - t; sc = state_conv + (size_t)bs * 3 * CONVD; }
    float a = conv_b[c];
#pragma unroll
    for (int k = 0; k < 4; ++k) { const int tp = t - 3 + k; float xv;
        if (tp >= 0) xv = bf2f(proj[(size_t)(rowbase + tp) * NPROJ + PX + c]); else xv = sc ? sc[(size_t)(tp + 3) * CONVD + c] : 0.f;
        a += conv_w[k * CONVD + c] * xv; }
    act[(size_t)r * CONVD + c] = silu_f(a);
    const float pre = bf2f(proj[(size_t)r * NPROJ + PX + c]);
    if (r < MP) { if (t >= SEQ - 3) out[O_CONVP + ((size_t)(r >> 11) * 3 + (t - (SEQ - 3))) * CONVD + c] = pre; }
    else { if (t >= DSEQ - 3) out[O_CONVS + ((size_t)((r - MP) >> 3) * 3 + (t - (DSEQ - 3))) * CONVD + c] = pre; }
}
__global__ void __launch_bounds__(256) k_ssd_seq(const float* __restrict__ act, const float* __restrict__ dt, const float* __restrict__ a_log, const float* __restrict__ d_skip,
                                                 const float* __restrict__ state_ssm, float* __restrict__ y, float* __restrict__ out) {
    const int seq = blockIdx.x >> 4, h = blockIdx.x & 15, tid = threadIdx.x, p = tid >> 2, q = tid & 3, g = h >> 3;
    const float A = -expf(a_log[h]), D = d_skip[h];
    int row0, L; float* sout;
    float S[32];
    if (seq < NPB) { row0 = seq * SEQ; L = SEQ; sout = out + O_SSMP + ((size_t)(seq * NHEAD + h) * HDIM + p) * NSTATE + q * 32;
#pragma unroll
        for (int n = 0; n < 32; ++n) S[n] = 0.f; }
    else { const int bs = seq - NPB; row0 = MP + bs * DSEQ; L = DSEQ; sout = out + O_SSMS + ((size_t)(bs * NHEAD + h) * HDIM + p) * NSTATE + q * 32;
        const float* s0 = state_ssm + ((size_t)(bs * NHEAD + h) * HDIM + p) * NSTATE + q * 32;
#pragma unroll
        for (int n = 0; n < 32; ++n) S[n] = s0[n]; }
    for (int t = 0; t < L; ++t) {
        const int r = row0 + t; const float* ar = act + (size_t)r * CONVD;
        const float dtv = dt[r * 16 + h], dA = expf(dtv * A), xv = ar[h * HDIM + p], xd = dtv * xv;
        const float* Bp = ar + SSDW + g * NSTATE + q * 32; const float* Cp = ar + SSDW + NGRP * NSTATE + g * NSTATE + q * 32;
        float part = 0.f;
#pragma unroll
        for (int n = 0; n < 32; ++n) { S[n] = dA * S[n] + xd * Bp[n]; part += S[n] * Cp[n]; }
        part += __shfl_xor(part, 1); part += __shfl_xor(part, 2);
        if (q == 0) y[(size_t)r * SSDW + h * HDIM + p] = part + D * xv;
    }
#pragma unroll
    for (int n = 0; n < 32; ++n) sout[n] = S[n];
}
__global__ void __launch_bounds__(256) k_gated_norm(const float* __restrict__ y, const bf16* __restrict__ proj, const float* __restrict__ gw, bf16* __restrict__ A2) {
    __shared__ float red[4];
    const int r = blockIdx.x, tid = threadIdx.x, c0 = tid * 4;
    float hv[4]; float q = 0.f;
#pragma unroll
    for (int j = 0; j < 4; ++j) { const float z = bf2f(proj[(size_t)r * NPROJ + PZ + c0 + j]); hv[j] = y[(size_t)r * SSDW + c0 + j] * silu_f(z); q += hv[j] * hv[j]; }
    q = wave_sum(q);
    if ((tid & 63) == 0) red[tid >> 6] = q;
    __syncthreads();
    const float ms = (tid < 128 ? red[0] + red[1] : red[2] + red[3]) * (1.f / 512.f);
    const float rs = 1.f / sqrtf(ms + LN_EPS);
#pragma unroll
    for (int j = 0; j < 4; ++j) A2[(size_t)r * DM + c0 + j] = f2bf(hv[j] * rs * gw[c0 + j]);
}
__global__ void __launch_bounds__(256) k_vn(const bf16* __restrict__ proj, const float* __restrict__ g, const float* __restrict__ b, float* __restrict__ vn, float* __restrict__ out) {
    __shared__ float red[4];
    const int r = blockIdx.x, tid = threadIdx.x, c0 = tid * 4;
    float v[4]; float s = 0.f;
#pragma unroll
    for (int j = 0; j < 4; ++j) { v[j] = gelu_f(bf2f(proj[(size_t)r * NPROJ + PV + c0 + j])); s += v[j]; }
    const float mean = block_sum256(s, red) * (1.f / GMW);
    float q = 0.f;
#pragma unroll
    for (int j = 0; j < 4; ++j) { const float d = v[j] - mean; q += d * d; }
    const float rstd = 1.f / sqrtf(block_sum256(q, red) * (1.f / GMW) + LN_EPS);
#pragma unroll
    for (int j = 0; j < 4; ++j) { const float o = (v[j] - mean) * rstd * g[c0 + j] + b[c0 + j]; vn[(size_t)r * GMW + c0 + j] = o; if (r >= MP) out[O_CV + (size_t)(r - MP) * GMW + c0 + j] = o; }
}
__global__ void __launch_bounds__(256) k_gmlp_mix(const bf16* __restrict__ proj, const float* __restrict__ vn, const float* __restrict__ w_s, const float* __restrict__ b_s, bf16* __restrict__ A2) {
    const int r = blockIdx.x, tid = threadIdx.x, c0 = tid * 4, hd = c0 >> 7;
    const int i = r < MP ? (r & 127) : ((r - MP) & 7), base = r - i;
    const float* wrow = w_s + ((size_t)hd * 128 + i) * 128;
    float a[4] = {0.f, 0.f, 0.f, 0.f};
    for (int j = 0; j <= i; ++j) { const float w = wrow[j]; const f32x4 vv = *(const f32x4*)(vn + (size_t)(base + j) * GMW + c0);
#pragma unroll
        for (int e = 0; e < 4; ++e) a[e] += w * vv[e]; }
    const float bs = b_s[hd * 128 + i];
#pragma unroll
    for (int e = 0; e < 4; ++e) { const float u = gelu_f(bf2f(proj[(size_t)r * NPROJ + PU + c0 + e])); A2[(size_t)r * DM + SSDW + c0 + e] = f2bf(u * (a[e] + bs)); }
}
__global__ void __launch_bounds__(256) k_ln_mix(const float* __restrict__ x_prompt, const float* __restrict__ x_sample, const float* __restrict__ stats, const float* __restrict__ lg, const float* __restrict__ lb,
                                                const float* __restrict__ mod, const float* __restrict__ mix, const float* __restrict__ g2, const float* __restrict__ b2, float* __restrict__ x1, bf16* __restrict__ h2) {
    __shared__ float red[4];
    const int r = blockIdx.x, tid = threadIdx.x;
    const float* xr = r < MP ? x_prompt + (size_t)r * DM : x_sample + (size_t)(r - MP) * DM;
    const float mean0 = stats[2 * r], rstd0 = stats[2 * r + 1];
    const float* mr = mod + (size_t)modrow(r) * NMOD;
    float v[8]; float s = 0.f;
#pragma unroll
    for (int j = 0; j < 8; ++j) { const int c = (j < 4 ? 0 : 1024) + tid * 4 + (j & 3);
        const float xn = (xr[c] - mean0) * rstd0 * lg[c] + lb[c];
        v[j] = ALPHA * xn + (1.f + mr[2 * DM + c]) * mix[(size_t)r * DM + c]; s += v[j]; }
    const float mean = block_sum256(s, red) * (1.f / DM);
    float q = 0.f;
#pragma unroll
    for (int j = 0; j < 8; ++j) { const float d = v[j] - mean; q += d * d; }
    const float rstd = 1.f / sqrtf(block_sum256(q, red) * (1.f / DM) + LN_EPS);
#pragma unroll
    for (int j = 0; j < 8; ++j) { const int c = (j < 4 ? 0 : 1024) + tid * 4 + (j & 3);
        const float o = (v[j] - mean) * rstd * g2[c] + b2[c];
        x1[(size_t)r * DM + c] = o;
        h2[(size_t)r * DM + c] = f2bf(o * (1.f + mr[4 * DM + c]) + mr[3 * DM + c]); }
}
__global__ void __launch_bounds__(256) k_ln_out(const float* __restrict__ mod, const float* __restrict__ f, const float* __restrict__ g3, const float* __restrict__ b3, float* __restrict__ xy) {
    __shared__ float red[4];
    const int r = blockIdx.x, tid = threadIdx.x;
    const float* mr = mod + (size_t)modrow(r) * NMOD;
    float v[8]; float s = 0.f;
#pragma unroll
    for (int j = 0; j < 8; ++j) { const int c = (j < 4 ? 0 : 1024) + tid * 4 + (j & 3);
        v[j] = ALPHA * xy[(size_t)r * DM + c] + (1.f + mr[5 * DM + c]) * f[(size_t)r * DM + c]; s += v[j]; }
    const float mean = block_sum256(s, red) * (1.f / DM);
    float q = 0.f;
#pragma unroll
    for (int j = 0; j < 8; ++j) { const float d = v[j] - mean; q += d * d; }
    const float rstd = 1.f / sqrtf(block_sum256(q, red) * (1.f / DM) + LN_EPS);
#pragma unroll
    for (int j = 0; j < 8; ++j) { const int c = (j < 4 ? 0 : 1024) + tid * 4 + (j & 3); xy[(size_t)r * DM + c] = (v[j] - mean) * rstd * g3[c] + b3[c]; }
}
constexpr int GEMM_LDS = 131072 + 1024;
template <class Epi> __global__ void __launch_bounds__(512, 2) k_gemm(pg8::Gemm g, Epi E) {
    extern __shared__ __attribute__((aligned(16))) unsigned char lds[];
    pg8::StaticOrder S; S.init(g.M, g.N, (int)gridDim.x, (int)blockIdx.x);
    pg8::gemm_phase<Epi, pg8::StaticOrder, true, true>((PG8_LAS unsigned char*)lds, g, S, E);
}
template <class Epi> static void launch_gemm(const bf16* A, const bf16* Bt, int M, int N, int K, Epi E, hipStream_t stream) {
    static bool attr_done = false;
    if (!attr_done) { (void)hipFuncSetAttribute((const void*)k_gemm<Epi>, hipFuncAttributeMaxDynamicSharedMemorySize, GEMM_LDS); attr_done = true; }
    pg8::Gemm g{A, Bt, M, N, K};
    hipLaunchKernelGGL(k_gemm<Epi>, dim3(256), dim3(512), GEMM_LDS, stream, g, E);
}

extern "C" void kernel_launch(void* const* d_in, const int* in_sizes, int n_in, void* d_out, int out_size, void* d_ws, size_t ws_size, hipStream_t stream) {
    if (n_in != 28 || ws_size < WS_END) { fprintf(stderr, "kernel_launch: unexpected n_in %d / ws_size %zu\n", n_in, ws_size); return; }
    const float* x_prompt = (const float*)d_in[0]; const float* x_sample = (const float*)d_in[1]; const float* state_ssm = (const float*)d_in[2]; const float* state_conv = (const float*)d_in[3];
    const float* c_prompt = (const float*)d_in[4]; const float* c_sample = (const float*)d_in[5]; const float* ln_in_g = (const float*)d_in[6]; const float* ln_in_b = (const float*)d_in[7];
    const float* w_mod = (const float*)d_in[8]; const float* b_mod = (const float*)d_in[9]; const float* w_in = (const float*)d_in[10]; const float* conv_w = (const float*)d_in[11];
    const float* conv_b = (const float*)d_in[12]; const float* dt_bias = (const float*)d_in[13]; const float* a_log = (const float*)d_in[14]; const float* d_skip = (const float*)d_in[15];
    const float* ssd_norm_g = (const float*)d_in[16]; const float* gm_ln_g = (const float*)d_in[17]; const float* gm_ln_b = (const float*)d_in[18]; const float* gm_w_s = (const float*)d_in[19];
    const float* gm_b_s = (const float*)d_in[20]; const float* w_out = (const float*)d_in[21]; const float* ln_mix_g = (const float*)d_in[22]; const float* ln_mix_b = (const float*)d_in[23];
    const float* w_ff1 = (const float*)d_in[24]; const float* w_ff2 = (const float*)d_in[25]; const float* ln_ffn_g = (const float*)d_in[26]; const float* ln_ffn_b = (const float*)d_in[27];
    float* out = (float*)d_out; unsigned char* ws = (unsigned char*)d_ws;
    bf16* Wt_in = (bf16*)(ws + WS_WIN); bf16* Wt_out = (bf16*)(ws + WS_WOUT); bf16* Wt_ff1 = (bf16*)(ws + WS_WFF1); bf16* Wt_ff2 = (bf16*)(ws + WS_WFF2);
    float* wdt = (float*)(ws + WS_WDT); float* mod = (float*)(ws + WS_MOD); float* stats = (float*)(ws + WS_STATS); float* dt = (float*)(ws + WS_DT);
    bf16* hbuf = (bf16*)(ws + WS_H); bf16* proj = (bf16*)(ws + WS_BIG); float* act = (float*)(ws + WS_ACT); bf16* hid = (bf16*)(ws + WS_BIG);
    float* ybuf = (float*)(ws + WS_E); float* vn = (float*)(ws + WS_VN); float* mix = (float*)(ws + WS_E); float* fbuf = (float*)(ws + WS_E);

    hipLaunchKernelGGL(k_transpose, dim3((DM / 64) * (2560 / 64)), dim3(256), 0, stream, w_in, DM, DINP, 0, 2560, Wt_in);
    hipLaunchKernelGGL(k_transpose, dim3((DM / 64) * (2048 / 64)), dim3(256), 0, stream, w_in, DM, DINP, 2576, 2048, Wt_in + (size_t)2560 * DM);
    hipLaunchKernelGGL(k_transpose, dim3((DM / 64) * (DM / 64)), dim3(256), 0, stream, w_out, DM, DM, 0, DM, Wt_out);
    hipLaunchKernelGGL(k_transpose, dim3((DM / 64) * (DFF / 64)), dim3(256), 0, stream, w_ff1, DM, DFF, 0, DFF, Wt_ff1);
    hipLaunchKernelGGL(k_transpose, dim3((DFF / 64) * (DM / 64)), dim3(256), 0, stream, w_ff2, DFF, DM, 0, DM, Wt_ff2);
    hipLaunchKernelGGL(k_wdt, dim3(16 * DM / 256), dim3(256), 0, stream, w_in, wdt);
    hipLaunchKernelGGL(k_mod, dim3(NMOD / 256, NSEQ / 12), dim3(256), 0, stream, c_prompt, c_sample, w_mod, b_mod, mod);
    hipLaunchKernelGGL(k_ln_h1, dim3(MROWS), dim3(256), 0, stream, x_prompt, x_sample, ln_in_g, ln_in_b, mod, stats, hbuf);
    launch_gemm(hbuf, Wt_in, MROWS, NPROJ, DM, pg8::EpiBf16P<0>{proj, NPROJ}, stream);
    hipLaunchKernelGGL(k_dt, dim3(MROWS / 16), dim3(256), 0, stream, hbuf, wdt, dt_bias, dt);
    hipLaunchKernelGGL(k_conv, dim3(MROWS, CONVD / 256), dim3(256), 0, stream, proj, state_conv, conv_w, conv_b, act, out);
    hipLaunchKernelGGL(k_ssd_seq, dim3(NSEQ * NHEAD), dim3(256), 0, stream, act, dt, a_log, d_skip, state_ssm, ybuf, out);
    hipLaunchKernelGGL(k_gated_norm, dim3(MROWS), dim3(256), 0, stream, ybuf, proj, ssd_norm_g, hbuf);
    hipLaunchKernelGGL(k_vn, dim3(MROWS), dim3(256), 0, stream, proj, gm_ln_g, gm_ln_b, vn, out);
    hipLaunchKernelGGL(k_gmlp_mix, dim3(MROWS), dim3(256), 0, stream, proj, vn, gm_w_s, gm_b_s, hbuf);
    launch_gemm(hbuf, Wt_out, MROWS, DM, DM, pg8::EpiF32P{mix, DM}, stream);
    hipLaunchKernelGGL(k_ln_mix, dim3(MROWS), dim3(256), 0, stream, x_prompt, x_sample, stats, ln_in_g, ln_in_b, mod, mix, ln_mix_g, ln_mix_b, out + O_YP, hbuf);
    launch_gemm(hbuf, Wt_ff1, MROWS, DFF, DM, pg8::EpiBf16P<2>{hid, DFF}, stream);
    launch_gemm(hid, Wt_ff2, MROWS, DM, DFF, pg8::EpiF32P{fbuf, DM}, stream);
    hipLaunchKernelGGL(k_ln_out, dim3(MROWS), dim3(256), 0, stream, mod, fbuf, ln_ffn_g, ln_ffn_b, out + O_YP);
}
```

```cpp
#include <hip/hip_runtime.h>
#include <cstdio>
#include <cstdint>
namespace pg8 {
#define PG8_LAS __attribute__((address_space(3)))
typedef unsigned short bf16_t;
typedef short bf16x8 __attribute__((ext_vector_type(8)));
typedef float f32x4 __attribute__((ext_vector_type(4)));
typedef unsigned u32x4 __attribute__((ext_vector_type(4)));
constexpr int BM = 256, BK = 64, HALF = 128, HTB = HALF * BK * 2  , STAGE_BYTES = 8 * HTB, NXCD = 8, WGM = 8;

__host__ __device__ __forceinline__ int lds_byte(int r, int c) { const int st = (r >> 4) * 2 + (c >> 5), rr = r & 15, cc = c & 31, ob = rr * 64 + cc * 2; return st * 1024 + (ob ^ (((ob >> 9) & 1) << 5)); }
__host__ __device__ __forceinline__ void stage_rc(int b, int& R, int& C) { const int st = b / 1024, sb = b % 1024, swz = sb ^ (((sb >> 9) & 1) << 5); R = (st >> 1) * 16 + swz / 64; C = (st & 1) * 32 + (swz % 64) / 2; }
__host__ __device__ __forceinline__ int perm32(int rho) { const int n = rho >> 4, i = rho & 15; return 8 * (i >> 2) + 4 * n + (i & 3); }

struct Unit { int pm, pn, kt0, nkt, slab; };
struct Gemm { const bf16_t* A; const bf16_t* Bt; int M, N, K, pad; };

struct StaticOrder {
    int nM, nN, nwg, G, c, nktf;
    __host__ __device__ void init(int M, int N, int G_, int c_, int K) { nM = M / BM; nN = N / BM; nwg = nM * nN; G = G_; c = c_; nktf = K / BK; }
    __host__ __device__ bool next(int i, Unit& u) const {
        const long L = (long)i * G + c; if (L >= nwg) return false;
        int wgid = (int)L; { const int q = nwg / NXCD, r = nwg % NXCD, xcd = wgid % NXCD, off = wgid / NXCD; wgid = (xcd < r ? xcd * (q + 1) : r * (q + 1) + (xcd - r) * q) + off; }
        const int nig = WGM * nN, gid = wgid / nig, fm = gid * WGM, gsz = (nM - fm) < WGM ? (nM - fm) : WGM;
        u.pm = fm + ((wgid % nig) % gsz); u.pn = (wgid % nig) / gsz; u.kt0 = 0; u.nkt = nktf; u.slab = -1; return true;
    }
    __device__ __forceinline__ void a_ready(const Unit&) const {}
    __device__ __forceinline__ void done(const Unit&) const {}
};

struct SplitOrder {
    int c, nktf;
    __host__ __device__ void init(int c_, int K) { c = c_; nktf = K / BK; }
    __host__ __device__ bool next(int i, Unit& u) const {
        if (i > 1) return false;
        const bool sl = (i == 0);
        const int hi = c >> 3, lo = c & 7, nks = nktf / 8;
        u.pm = sl ? 32 + (hi >> 3) : 4 * lo + (hi >> 3); u.pn = hi & 7; u.nkt = sl ? nks : nktf; u.kt0 = sl ? lo * nks : 0; u.slab = sl ? lo : -1;
        return true;
    }
    __device__ __forceinline__ void a_ready(const Unit&) const {}
    __device__ __forceinline__ void done(const Unit&) const {}
};

__device__ __forceinline__ void st_wt16(void* p, u32x4 v) { asm volatile("global_store_dwordx4 %0, %1, off sc1\n\ts_nop 1" :: "v"(p), "v"(v) : "memory"); }
__device__ __forceinline__ unsigned cvt_pk_bf16(float lo, float hi) { unsigned r; asm volatile("v_cvt_pk_bf16_f32 %0, %1, %2" : "=v"(r) : "v"(lo), "v"(hi)); return r; }

template <int ACT  > struct EpiBf16P {
    static constexpr bool PERM = true, AFTER_DRAIN = false;
    bf16_t* O; int ldc, pad;
    __device__ __forceinline__ void operator()(const f32x4 (&acc)[2][2][4][2], const Unit& u, int wr, int wc, int fr, int fq) const {
        const int row0 = u.pm * BM + wr * 64 + fr; const int col0 = u.pn * BM + wc * 32 + 8 * fq;
#pragma unroll
        for (int ai = 0; ai < 2; ++ai)
#pragma unroll
            for (int m = 0; m < 4; ++m) { bf16_t* rowp = O + (size_t)(row0 + ai * HALF + m * 16) * ldc + col0;
#pragma unroll
                for (int bj = 0; bj < 2; ++bj) { f32x4 v0 = acc[ai][bj][m][0], v1 = acc[ai][bj][m][1];
                    if (ACT == 2) {
#pragma unroll
                        for (int j = 0; j < 4; ++j) { const float a = fmaxf(v0[j], 0.f), b = fmaxf(v1[j], 0.f); v0[j] = a * a; v1[j] = b * b; } }
                    u32x4 w; w.x = cvt_pk_bf16(v0[0], v0[1]); w.y = cvt_pk_bf16(v0[2], v0[3]); w.z = cvt_pk_bf16(v1[0], v1[1]); w.w = cvt_pk_bf16(v1[2], v1[3]);
                    st_wt16(rowp + bj * HALF, w); } }
    }
};
struct EpiF32P {
    static constexpr bool PERM = false, AFTER_DRAIN = false;
    float* C; int ldc, pad;
    __device__ __forceinline__ void operator()(const f32x4 (&acc)[2][2][4][2], const Unit& u, int wr, int wc, int fr, int fq) const {
        const int row0 = u.pm * BM + wr * 64 + fr, col0 = u.pn * BM + wc * 32 + 4 * fq;
#pragma unroll
        for (int ai = 0; ai < 2; ++ai)
#pragma unroll
            for (int m = 0; m < 4; ++m) { float* rowp = C + (size_t)(row0 + ai * HALF + m * 16) * ldc + col0;
#pragma unroll
                for (int bj = 0; bj < 2; ++bj)
#pragma unroll
                    for (int n = 0; n < 2; ++n) *(f32x4*)(rowp + bj * HALF + n * 16) = acc[ai][bj][m][n]; }
    }
};

__device__ __forceinline__ float softplus_e(float x) { return fmaxf(x, 0.f) + __logf(1.f + __expf(-fabsf(x))); }
struct EpiProj {
    static constexpr bool PERM = true, AFTER_DRAIN = false;
    bf16_t* O; float* dt; const float* dt_bias;
    __device__ __forceinline__ void operator()(const f32x4 (&acc)[2][2][4][2], const Unit& u, int wr, int wc, int fr, int fq) const {
        const int row0 = u.pm * BM + wr * 64 + fr;
        if (u.pn < 18) {
            const int col0 = u.pn * BM + wc * 32 + 8 * fq;
#pragma unroll
            for (int ai = 0; ai < 2; ++ai)
#pragma unroll
                for (int m = 0; m < 4; ++m) { bf16_t* rowp = O + (size_t)(row0 + ai * HALF + m * 16) * 4608 + col0;
#pragma unroll
                    for (int bj = 0; bj < 2; ++bj) { const f32x4 v0 = acc[ai][bj][m][0], v1 = acc[ai][bj][m][1];
                        u32x4 w; w.x = cvt_pk_bf16(v0[0], v0[1]); w.y = cvt_pk_bf16(v0[2], v0[3]); w.z = cvt_pk_bf16(v1[0], v1[1]); w.w = cvt_pk_bf16(v1[2], v1[3]);
                        *(u32x4*)(rowp + bj * HALF) = w; } }
        } else if (wc == 0 && fq < 2) {
#pragma unroll
            for (int ai = 0; ai < 2; ++ai)
#pragma unroll
                for (int m = 0; m < 4; ++m) { float* rowp = dt + (size_t)(row0 + ai * HALF + m * 16) * 16 + 8 * fq;
#pragma unroll
                    for (int n = 0; n < 2; ++n) { f32x4 v = acc[ai][0][m][n];
#pragma unroll
                        for (int j = 0; j < 4; ++j) v[j] = softplus_e(v[j] + dt_bias[8 * fq + 4 * n + j]);
                        *(f32x4*)(rowp + 4 * n) = v; } }
        }
    }
};

struct EpiF32S {
    static constexpr bool PERM = false, AFTER_DRAIN = false;
    float* C; float* slab; int ldc, pad;
    __device__ __forceinline__ void operator()(const f32x4 (&acc)[2][2][4][2], const Unit& u, int wr, int wc, int fr, int fq) const {
        const int row0 = u.pm * BM + wr * 64 + fr, col0 = u.pn * BM + wc * 32 + 4 * fq;
        float* base = u.slab < 0 ? C + (size_t)row0 * ldc : slab + (size_t)u.slab * (1024 * 2048) + (size_t)(row0 - 8192) * ldc;
#pragma unroll
        for (int ai = 0; ai < 2; ++ai)
#pragma unroll
            for (int m = 0; m < 4; ++m) { float* rowp = base + (size_t)(ai * HALF + m * 16) * ldc + col0;
#pragma unroll
                for (int bj = 0; bj < 2; ++bj)
#pragma unroll
                    for (int n = 0; n < 2; ++n) *(f32x4*)(rowp + bj * HALF + n * 16) = acc[ai][bj][m][n]; }
    }
};

struct EpiBf16S {
    static constexpr bool PERM = true, AFTER_DRAIN = false;
    bf16_t* O; bf16_t* slab; int ldc, pad;
    __device__ __forceinline__ void operator()(const f32x4 (&acc)[2][2][4][2], const Unit& u, int wr, int wc, int fr, int fq) const {
        const int row0 = u.pm * BM + wr * 64 + fr, col0 = u.pn * BM + wc * 32 + 8 * fq;
        bf16_t* base = u.slab < 0 ? O + (size_t)row0 * ldc + col0 : slab + (size_t)u.slab * (1024 * 2048) + (size_t)(row0 - 8192) * ldc + col0;
#pragma unroll
        for (int ai = 0; ai < 2; ++ai)
#pragma unroll
            for (int m = 0; m < 4; ++m) { bf16_t* rowp = base + (size_t)(ai * HALF + m * 16) * ldc;
#pragma unroll
                for (int bj = 0; bj < 2; ++bj) { const f32x4 v0 = acc[ai][bj][m][0], v1 = acc[ai][bj][m][1];
                    u32x4 w; w.x = cvt_pk_bf16(v0[0], v0[1]); w.y = cvt_pk_bf16(v0[2], v0[3]); w.z = cvt_pk_bf16(v1[0], v1[1]); w.w = cvt_pk_bf16(v1[2], v1[3]);
                    *(u32x4*)(rowp + bj * HALF) = w; } }
    }
};
template <class Epi, class Sched, bool ALIGN_EPI = false, bool SP2 = false>
__device__ __forceinline__ void gemm_phase(PG8_LAS unsigned char* lds, const Gemm g, const Sched& S, const Epi& E) {
    int tid = threadIdx.x; asm volatile("" : "+v"(tid)); const int wid = __builtin_amdgcn_readfirstlane(tid >> 6), lane = tid & 63, wr = wid >> 2, wc = wid & 3, fr = lane & 15, fq = lane >> 4;
    const int K = g.K; int nt;
    unsigned voffA[2], voffB[2];
#pragma unroll
    for (int i = 0; i < 2; ++i) { int R, C; stage_rc(tid * 16 + i * 8192, R, C); const int Rb = Epi::PERM ? ((R & ~31) + perm32(R & 31)) : R;
        voffA[i] = (unsigned)(R * K + C) * 2u; voffB[i] = (unsigned)(Rb * K + C) * 2u; }
    const size_t kstep = (size_t)(BK * 2);
    const size_t hstep = (size_t)HALF * K * 2;
    const size_t tstep = 2 * hstep;
    const unsigned ldsw = (unsigned)wid * 1024u;
    const int aoff = lds_byte(wr * 64 + fr, fq * 8), boff = lds_byte(wc * 32 + fr, fq * 8);
#define PG8_SA(b, h) (((b) * 2 + (h)) * HTB)
#define PG8_SB(b, h) ((4 + (b) * 2 + (h)) * HTB)
#define PG8_STAGE(bufoff, gbase, voff) do { _Pragma("unroll") for (int _i = 0; _i < 2; ++_i) \
        __builtin_amdgcn_global_load_lds((const unsigned*)((const char*)(gbase) + (voff)[_i]), (PG8_LAS unsigned*)(lds + (bufoff) + ldsw + _i * 8192), 16, 0, 0); } while (0)
#define PG8_LDA(dst, b, h) do { _Pragma("unroll") for (int m = 0; m < 4; ++m) _Pragma("unroll") for (int k = 0; k < 2; ++k) dst[m][k] = *(const PG8_LAS bf16x8*)(lds + PG8_SA(b, h) + aoff + m * 2048 + k * 1024); } while (0)
#define PG8_LDB(dst, b, h) do { _Pragma("unroll") for (int n = 0; n < 2; ++n) _Pragma("unroll") for (int k = 0; k < 2; ++k) dst[n][k] = *(const PG8_LAS bf16x8*)(lds + PG8_SB(b, h) + boff + n * 2048 + k * 1024); } while (0)
#define PG8_MMA(ai, bj, At, Bt) do { __builtin_amdgcn_s_setprio(1); _Pragma("unroll") for (int m = 0; m < 4; ++m) _Pragma("unroll") for (int n = 0; n < 2; ++n) _Pragma("unroll") for (int k = 0; k < 2; ++k) \
        acc[ai][bj][m][n] = __builtin_amdgcn_mfma_f32_16x16x32_bf16(Bt[n][k], At[m][k], acc[ai][bj][m][n], 0, 0, 0); __builtin_amdgcn_s_setprio(0); } while (0)
#define PG8_WAIT_V(n) asm volatile("s_waitcnt vmcnt(" #n ")" ::: "memory")
#define PG8_WAIT_L(n) asm volatile("s_waitcnt lgkmcnt(" #n ")" ::: "memory")
#define PG8_BAR __builtin_amdgcn_s_barrier()
#define PG8_SCHED __builtin_amdgcn_sched_barrier(0)
    Unit cur, nxt; int ui = 0;
    if (!S.next(0, cur)) return;
    f32x4 acc[2][2][4][2];
#pragma unroll
    for (int a = 0; a < 2; ++a)
#pragma unroll
        for (int b = 0; b < 2; ++b)
#pragma unroll
            for (int m = 0; m < 4; ++m)
#pragma unroll
                for (int n = 0; n < 2; ++n) acc[a][b][m][n] = (f32x4){0.f, 0.f, 0.f, 0.f};
    bf16x8 At[4][2], B0[2][2], B1[2][2];
    const char* cA = (const char*)g.A + (size_t)cur.pm * tstep + (size_t)cur.kt0 * kstep; const char* cB = (const char*)g.Bt + (size_t)cur.pn * tstep + (size_t)cur.kt0 * kstep; nt = cur.nkt;
    S.a_ready(cur);
    if constexpr (SP2) {
        PG8_STAGE(PG8_SB(0, 0), cB, voffB); PG8_STAGE(PG8_SB(0, 1), cB + hstep, voffB); PG8_STAGE(PG8_SA(0, 0), cA, voffA); PG8_STAGE(PG8_SA(0, 1), cA + hstep, voffA);
        if (wr == 1) PG8_BAR;
        PG8_WAIT_V(2); PG8_BAR;
        PG8_STAGE(PG8_SB(1, 0), cB + kstep, voffB); PG8_STAGE(PG8_SA(1, 0), cA + kstep, voffA); PG8_STAGE(PG8_SB(1, 1), cB + hstep + kstep, voffB);
        PG8_WAIT_V(6); PG8_BAR;
    } else {
        PG8_STAGE(PG8_SB(0, 0), cB, voffB); PG8_STAGE(PG8_SA(0, 0), cA, voffA); PG8_STAGE(PG8_SB(0, 1), cB + hstep, voffB); PG8_STAGE(PG8_SA(0, 1), cA + hstep, voffA);
        if (wr == 1) PG8_BAR;
        PG8_WAIT_V(4); PG8_BAR;
        PG8_STAGE(PG8_SB(1, 0), cB + kstep, voffB); PG8_STAGE(PG8_SA(1, 0), cA + kstep, voffA); PG8_STAGE(PG8_SB(1, 1), cB + hstep + kstep, voffB);
        PG8_WAIT_V(6); PG8_BAR;
    }
    for (;;) {
        const bool has_next = S.next(ui + 1, nxt);
        const char* nA = has_next ? (const char*)g.A + (size_t)nxt.pm * tstep + (size_t)nxt.kt0 * kstep : cA; const char* nB = has_next ? (const char*)g.Bt + (size_t)nxt.pn * tstep + (size_t)nxt.kt0 * kstep : cB;
        for (int t = 0; t < nt; t += 2) {
            const bool last = (t == nt - 2);
            const char* a1 = cA + (size_t)(t + 1) * kstep;
            const char* a2 = last ? nA : cA + (size_t)(t + 2) * kstep; const char* b2 = last ? nB : cB + (size_t)(t + 2) * kstep;
            const char* a3 = a2 + kstep; const char* b3 = b2 + kstep;
            if (last && has_next) S.a_ready(nxt);
            if constexpr (SP2) {
            PG8_LDB(B0, 0, 0); PG8_LDB(B1, 0, 1); PG8_SCHED; PG8_LDA(At, 0, 0); PG8_STAGE(PG8_SA(1, 1), a1 + hstep, voffA);
            PG8_WAIT_V(8); PG8_WAIT_L(0); PG8_BAR; PG8_MMA(0, 0, At, B0); PG8_MMA(0, 1, At, B1); PG8_BAR; PG8_SCHED;
            PG8_LDA(At, 0, 1); PG8_STAGE(PG8_SB(0, 0), b2, voffB); PG8_STAGE(PG8_SB(0, 1), b2 + hstep, voffB); PG8_STAGE(PG8_SA(0, 0), a2, voffA);
            PG8_WAIT_V(8); PG8_WAIT_L(0); PG8_BAR; PG8_MMA(1, 0, At, B0); PG8_MMA(1, 1, At, B1); PG8_BAR; PG8_SCHED;
            PG8_LDB(B0, 1, 0); PG8_LDB(B1, 1, 1); PG8_SCHED; PG8_LDA(At, 1, 0); PG8_STAGE(PG8_SA(0, 1), a2 + hstep, voffA);
            PG8_WAIT_V(8); PG8_WAIT_L(0); PG8_BAR; PG8_MMA(0, 0, At, B0); PG8_MMA(0, 1, At, B1); PG8_BAR; PG8_SCHED;
            PG8_LDA(At, 1, 1); PG8_STAGE(PG8_SB(1, 0), b3, voffB); PG8_STAGE(PG8_SB(1, 1), b3 + hstep, voffB); PG8_STAGE(PG8_SA(1, 0), a3, voffA);
            PG8_WAIT_V(8); PG8_WAIT_L(0); PG8_BAR; PG8_MMA(1, 0, At, B0); PG8_MMA(1, 1, At, B1); PG8_BAR; PG8_SCHED;
            } else {
            PG8_LDB(B0, 0, 0); PG8_SCHED; PG8_LDA(At, 0, 0); PG8_STAGE(PG8_SA(1, 1), a1 + hstep, voffA);
            PG8_WAIT_L(8); PG8_BAR; PG8_WAIT_L(0); PG8_MMA(0, 0, At, B0); PG8_BAR; PG8_SCHED;
            PG8_LDB(B1, 0, 1); PG8_STAGE(PG8_SB(0, 0), b2, voffB);
            PG8_BAR; PG8_WAIT_L(0); PG8_MMA(0, 1, At, B1); PG8_BAR;
            PG8_LDA(At, 0, 1); PG8_STAGE(PG8_SA(0, 0), a2, voffA);
            PG8_BAR; PG8_WAIT_L(0); PG8_MMA(1, 0, At, B0); PG8_BAR; PG8_SCHED;
            PG8_STAGE(PG8_SB(0, 1), b2 + hstep, voffB);
            PG8_WAIT_V(6); PG8_BAR; PG8_MMA(1, 1, At, B1); PG8_BAR;
            PG8_LDB(B0, 1, 0); PG8_SCHED; PG8_LDA(At, 1, 0); PG8_STAGE(PG8_SA(0, 1), a2 + hstep, voffA);
            PG8_WAIT_L(8); PG8_BAR; PG8_WAIT_L(0); PG8_MMA(0, 0, At, B0); PG8_BAR; PG8_SCHED;
            PG8_LDB(B1, 1, 1); PG8_STAGE(PG8_SB(1, 0), b3, voffB);
            PG8_BAR; PG8_WAIT_L(0); PG8_MMA(0, 1, At, B1); PG8_BAR;
            PG8_LDA(At, 1, 1); PG8_STAGE(PG8_SA(1, 0), a3, voffA);
            PG8_BAR; PG8_WAIT_L(0); PG8_MMA(1, 0, At, B0); PG8_BAR; PG8_SCHED;
            PG8_STAGE(PG8_SB(1, 1), b3 + hstep, voffB);
            PG8_WAIT_V(6); PG8_BAR; PG8_MMA(1, 1, At, B1); PG8_BAR;
            }
        }
        if constexpr (ALIGN_EPI) { if (wr == 0) PG8_BAR; }
        if (!Epi::AFTER_DRAIN || has_next) { E(acc, cur, wr, wc, fr, fq); S.done(cur); }
        if (!has_next) break;
#pragma unroll
        for (int a = 0; a < 2; ++a)
#pragma unroll
            for (int b = 0; b < 2; ++b)
#pragma unroll
                for (int m = 0; m < 4; ++m)
#pragma unroll
                    for (int n = 0; n < 2; ++n) acc[a][b][m][n] = (f32x4){0.f, 0.f, 0.f, 0.f};
        cur = nxt; cA = nA; cB = nB; ++ui; nt = cur.nkt;
        if constexpr (ALIGN_EPI) { if (wr == 1) PG8_BAR; }
    }
    PG8_WAIT_V(0);
    if constexpr (!ALIGN_EPI) { if (wr == 0) PG8_BAR; }
    PG8_BAR;
    if constexpr (Epi::AFTER_DRAIN) { E.fused(acc, cur, wr, wc, fr, fq, lds, wid, lane); S.done(cur); }
#undef PG8_SA
#undef PG8_SB
#undef PG8_STAGE
#undef PG8_LDA
#undef PG8_LDB
#undef PG8_MMA
#undef PG8_WAIT_V
#undef PG8_WAIT_L
#undef PG8_BAR
#undef PG8_SCHED
}
}

typedef unsigned short bf16;
typedef float f32x4 __attribute__((ext_vector_type(4)));
constexpr int DM = 2048, NPB = 4, SEQ = 2048, NSB = 128, DSEQ = 8;
constexpr int MP = NPB * SEQ, MS = NSB * DSEQ, MROWS = MP + MS;
constexpr int NSEQ = NPB + NSB;
constexpr int SSDW = 1024, HDIM = 64, NHEAD = 16, NGRP = 2, NSTATE = 128, CONVD = 1536, GMW = 1024, GMHD = 128, GMNH = 8, DFF = 8192;
constexpr int DINP = 4624, NPROJ = 4608;
constexpr int PZ = 0, PX = 1024, PU = 2560, PV = 3584;
constexpr int NMOD = 6 * DM;
constexpr float LN_EPS = 1e-5f, ALPHA = 1.189207115002721f;
constexpr size_t O_YP = 0, O_YS = 16777216, O_SSMP = 18874368, O_CONVP = 19398656, O_SSMS = 19417088, O_CONVS = 36194304, O_CV = 36784128;
constexpr size_t MiB = 1u << 20;
constexpr size_t WS_WIN = 2 * MiB, WS_WOUT = 22 * MiB, WS_WFF1 = 30 * MiB, WS_WFF2 = 62 * MiB, WS_MOD = 95 * MiB, WS_STATS = 102 * MiB, WS_DT = 103 * MiB, WS_CD = 104 * MiB;
constexpr size_t WS_XB1 = 104 * MiB + 256 * 1024, WS_XB2 = 105 * MiB;
constexpr size_t WS_H = 106 * MiB;
constexpr size_t WS_BIG = 142 * MiB;
constexpr size_t WS_ACT = WS_BIG + 81 * MiB;
constexpr size_t WS_E = 286 * MiB;
constexpr size_t WS_VN = WS_E + 36 * MiB;
constexpr size_t WS_SIN = 358 * MiB;
constexpr size_t WS_SLAB2 = 322 * MiB;
constexpr size_t WS_END = 386 * MiB;

__device__ __forceinline__ float bf2f(bf16 b) { return __uint_as_float(((unsigned)b) << 16); }
__device__ __forceinline__ bf16 f2bf(float f) { unsigned u = __float_as_uint(f); return (bf16)((u + 0x7fffu + ((u >> 16) & 1u)) >> 16); }
__device__ __forceinline__ float silu_f(float x) { return x / (1.f + expf(-x)); }
__device__ __forceinline__ float softplus_f(float x) { return fmaxf(x, 0.f) + log1pf(expf(-fabsf(x))); }
__device__ __forceinline__ float gelu_f(float x) { return 0.5f * x * (1.f + tanhf(0.7978845608028654f * (x + 0.044715f * x * x * x))); }
__device__ __forceinline__ int modrow(int r) { return r < MP ? (r >> 11) : NPB + ((r - MP) >> 3); }
__device__ __forceinline__ float wave_sum(float v) {
#pragma unroll
    for (int o = 1; o < 64; o <<= 1) v += __shfl_xor(v, o);
    return v;
}
__device__ __forceinline__ float block_sum256(float v, float* red) {
    v = wave_sum(v);
    __syncthreads();
    if ((threadIdx.x & 63) == 0) red[threadIdx.x >> 6] = v;
    __syncthreads();
    return (red[0] + red[1]) + (red[2] + red[3]);
}


#define GAS __attribute__((address_space(1)))
#define LAS __attribute__((address_space(3)))
typedef GAS unsigned gu32;
constexpr int NWAVES = 8;
constexpr int LDSCTL_OFF = 155648, MISC_OFF = LDSCTL_OFF + 320, LDS_BYTES = 163840;
constexpr size_t WS_CTL = 0, CTL_ZERO_BYTES = 64 * 1024;
constexpr int CW_BAR = 1024, CW_CSILU = 512;
#define XB_TMO      128
#define XB_XCNT(j)  (256  + 64 * (j))
#define XB_XSUB(j)  (1280 + 64 * (j))
#define XB_XGEN(j)  (2304 + 64 * (j))
#define XB_TOP      3328
#define XB_TOPGEN   3392
#define XCD_BAR_WORDS 3456
#define XB_SPIN_CAP (1u << 18)

__device__ __forceinline__ unsigned xb_ld(unsigned* p)              { return __hip_atomic_load(p, __ATOMIC_RELAXED, __HIP_MEMORY_SCOPE_AGENT); }
__device__ __forceinline__ unsigned xb_add(unsigned* p, unsigned v) { return __hip_atomic_fetch_add(p, v, __ATOMIC_RELAXED, __HIP_MEMORY_SCOPE_AGENT); }
__device__ __forceinline__ unsigned xb_xcc_id() { return (unsigned)__builtin_amdgcn_s_getreg((3 << 11) | 20) & 0xFu; }
#define XB_SPIN(cond, bar) do { unsigned _sp = 0; while (cond) { __builtin_amdgcn_s_sleep(1); \
    if ((++_sp & 255u) == 0u) { if (xb_ld(&(bar)[XB_TMO])) break; if (_sp > XB_SPIN_CAP) { atomicAdd(&(bar)[XB_TMO], 1u); break; } } } } while (0)

struct XcdBarrier {
    unsigned* bar; unsigned x;
    volatile LAS unsigned* st;
};

__device__ __forceinline__ XcdBarrier xcd_barrier_post(unsigned* bar, volatile LAS unsigned* st) {
    XcdBarrier b; b.bar = bar; b.x = xb_xcc_id(); b.st = st;
    if (threadIdx.x == 0) (void)xb_add(&bar[XB_XCNT(b.x)], 1u);
    return b;
}
__device__ __forceinline__ void xcd_barrier_complete(unsigned* bar, unsigned x, unsigned& nloc, unsigned& nx) {
    const unsigned G = gridDim.x * gridDim.y * gridDim.z;
    unsigned sum, cnt, mine, sp = 0u;
    for (;;) {
        sum = 0u; cnt = 0u; mine = 0u;
#pragma unroll
        for (unsigned j = 0; j < 16; ++j) { const unsigned c = xb_ld(&bar[XB_XCNT(j)]); sum += c; cnt += (c > 0u) ? 1u : 0u; mine = (j == x) ? c : mine; }
        if (sum == G) break;
        __builtin_amdgcn_s_sleep(1);
        if ((++sp & 255u) == 0u) { if (xb_ld(&bar[XB_TMO])) break; if (sp > XB_SPIN_CAP) { atomicAdd(&bar[XB_TMO], 1u); break; } }
    }
    nloc = mine > 0u ? mine : 1u; nx = cnt > 0u ? cnt : 1u;
}

__device__ __forceinline__ void xcd_barrier(const XcdBarrier& b) {
    asm volatile("s_waitcnt vmcnt(0)" ::: "memory");
    __syncthreads();
    if (threadIdx.x == 0) {
        unsigned* bar = b.bar;
        __builtin_amdgcn_s_waitcnt(0);
        unsigned nloc = b.st[0], nx = b.st[1];
        if (nloc == 0u) { xcd_barrier_complete(bar, b.x, nloc, nx); b.st[0] = nloc; b.st[1] = nx; }
        const unsigned old = xb_add(&bar[XB_XSUB(b.x)], 1u);
        const unsigned gen = old / nloc;
        if (old + 1u == (gen + 1u) * nloc) {
            __builtin_amdgcn_fence(__ATOMIC_RELEASE, "agent");
            asm volatile("s_waitcnt vmcnt(0)" ::: "memory");
            const unsigned og = xb_add(&bar[XB_TOP], 1u);
            const unsigned tg = og / nx;
            if (og + 1u == (tg + 1u) * nx) xb_add(&bar[XB_TOPGEN], 1u);
            else XB_SPIN(xb_ld(&bar[XB_TOPGEN]) == tg, bar);
            __builtin_amdgcn_fence(__ATOMIC_ACQUIRE, "agent");
            xb_add(&bar[XB_XGEN(b.x)], 1u);
            asm volatile("s_waitcnt vmcnt(0)" ::: "memory");
        } else {
            XB_SPIN(xb_ld(&bar[XB_XGEN(b.x)]) == gen, bar);
            __builtin_amdgcn_fence(__ATOMIC_ACQUIRE, "agent");
            asm volatile("s_waitcnt vmcnt(0)" ::: "memory");
        }
    }
    __syncthreads();
}


struct Args { const float* in[28]; float* out; unsigned char* ws; };
struct VB { int vt, id, n; LAS float* scr; };

__device__ __forceinline__ float vb_sum(float v, LAS float* red, int vt) {
    v = wave_sum(v);
    __syncthreads();
    if ((vt & 63) == 0) red[vt >> 6] = v;
    __syncthreads();
    return (red[0] + red[1]) + (red[2] + red[3]);
}


typedef short bf16x8 __attribute__((ext_vector_type(8)));
typedef unsigned u32x4 __attribute__((ext_vector_type(4)));
typedef unsigned u32x2 __attribute__((ext_vector_type(2)));
constexpr int LDT = 136;
constexpr int SSD_IMG = 128 * LDT * 2;
constexpr int SSD_XT = 256 * LDT * 2;
__device__ __forceinline__ unsigned pk_bf16(float lo, float hi) { unsigned r; asm volatile("v_cvt_pk_bf16_f32 %0, %1, %2" : "=v"(r) : "v"(lo), "v"(hi)); return r; }
__device__ __forceinline__ float fast_silu(float a) { return a * __builtin_amdgcn_rcpf(1.f + __expf(-a)); }

template <int NCH, bool TR> __device__ __forceinline__ void stage_conv(LAS bf16* dst, int chan0, int R0, bool first, const bf16* __restrict__ proj, const float* __restrict__ conv_w, const float* __restrict__ conv_b, int tid) {
    constexpr int NG = NCH / 8, TB = (NG == 32) ? 8 : 4, CGB = NG / 8;
    int cg, tb;
    if (TR) { const int wv = tid >> 6, ln = tid & 63; cg = 8 * (wv % CGB) + (ln >> 3); tb = 8 * (wv / CGB) + (ln & 7); }
    else { cg = tid % NG; tb = tid / NG; }
    const int ch = chan0 + 8 * cg, j0 = TB * tb;
    const bf16* src = proj + (size_t)R0 * NPROJ + PX + ch;
    u32x4 row[TB + 3];
#pragma unroll
    for (int i = 0; i < TB + 3; ++i) { const int jj = j0 - 3 + i; row[i] = (jj >= 0 || !first) ? *(const u32x4*)(src + (ptrdiff_t)jj * NPROJ) : (u32x4){0u, 0u, 0u, 0u}; }
    float w[4][8], bias[8];
#pragma unroll
    for (int k = 0; k < 4; ++k) { const f32x4 a = *(const f32x4*)(conv_w + k * CONVD + ch), b = *(const f32x4*)(conv_w + k * CONVD + ch + 4);
        w[k][0] = a[0]; w[k][1] = a[1]; w[k][2] = a[2]; w[k][3] = a[3]; w[k][4] = b[0]; w[k][5] = b[1]; w[k][6] = b[2]; w[k][7] = b[3]; }
    { const f32x4 a = *(const f32x4*)(conv_b + ch), b = *(const f32x4*)(conv_b + ch + 4); bias[0] = a[0]; bias[1] = a[1]; bias[2] = a[2]; bias[3] = a[3]; bias[4] = b[0]; bias[5] = b[1]; bias[6] = b[2]; bias[7] = b[3]; }
    unsigned outp[8][TB / 2];
#pragma unroll
    for (int q = 0; q < TB / 2; ++q) {
        float a0[8], a1[8];
#pragma unroll
        for (int e = 0; e < 8; ++e) { a0[e] = bias[e]; a1[e] = bias[e]; }
#pragma unroll
        for (int k = 0; k < 4; ++k) { const u32x4 v0 = row[2 * q + k], v1 = row[2 * q + 1 + k];
#pragma unroll
            for (int e = 0; e < 4; ++e) { a0[2 * e] += w[k][2 * e] * __uint_as_float(v0[e] << 16); a0[2 * e + 1] += w[k][2 * e + 1] * __uint_as_float(v0[e] & 0xffff0000u);
                                          a1[2 * e] += w[k][2 * e] * __uint_as_float(v1[e] << 16); a1[2 * e + 1] += w[k][2 * e + 1] * __uint_as_float(v1[e] & 0xffff0000u); } }
#pragma unroll
        for (int e = 0; e < 8; ++e) { a0[e] = fast_silu(a0[e]); a1[e] = fast_silu(a1[e]); }
        if (TR) {
#pragma unroll
            for (int e = 0; e < 8; ++e) outp[e][q] = pk_bf16(a0[e], a1[e]);
        } else {
            u32x4 o; o.x = pk_bf16(a0[0], a0[1]); o.y = pk_bf16(a0[2], a0[3]); o.z = pk_bf16(a0[4], a0[5]); o.w = pk_bf16(a0[6], a0[7]);
            *(LAS u32x4*)(dst + (j0 + 2 * q) * LDT + 8 * cg) = o;
            o.x = pk_bf16(a1[0], a1[1]); o.y = pk_bf16(a1[2], a1[3]); o.z = pk_bf16(a1[4], a1[5]); o.w = pk_bf16(a1[6], a1[7]);
            *(LAS u32x4*)(dst + (j0 + 2 * q + 1) * LDT + 8 * cg) = o;
        }
    }
    if (TR) {
#pragma unroll
        for (int e = 0; e < 8; ++e) {
            if (TB == 8) { u32x4 o; o.x = outp[e][0]; o.y = outp[e][1]; o.z = outp[e][TB / 2 - 2]; o.w = outp[e][TB / 2 - 1]; *(LAS u32x4*)(dst + (8 * cg + e) * LDT + j0) = o; }
            else { u32x2 o; o.x = outp[e][0]; o.y = outp[e][1]; *(LAS u32x2*)(dst + (8 * cg + e) * LDT + j0) = o; }
        }
    }
}
__device__ __forceinline__ float ssd_scalars(LAS float* dtv, LAS float* acum, int R0, int h, int wid, int lane, const float* __restrict__ dt, const float* __restrict__ a_log) {
    const float A = -__expf(a_log[h]);
    const int j0 = 2 * lane;
    const float d0 = dt[(size_t)(R0 + j0) * 16 + h], d1 = dt[(size_t)(R0 + j0 + 1) * 16 + h];
    const float a0 = d0 * A, a1 = d1 * A;
    float s = a0 + a1;
#pragma unroll
    for (int o = 1; o < 64; o <<= 1) { const float t = __shfl_up(s, o); if (lane >= o) s += t; }
    dtv[wid * 128 + j0] = d0; dtv[wid * 128 + j0 + 1] = d1;
    acum[wid * 128 + j0] = s - a1; acum[wid * 128 + j0 + 1] = s;
    return __shfl(s, 63);
}

__device__ __forceinline__ void ssd_phaseA_item(LAS unsigned char* lds, int item, const bf16* __restrict__ proj, const float* __restrict__ dt, const float* __restrict__ conv_w, const float* __restrict__ conv_b,
                                                const float* __restrict__ a_log, bf16* __restrict__ cs, float* __restrict__ cd, bf16* __restrict__ xs) {
    int tid = threadIdx.x; asm volatile("" : "+v"(tid)); const int wid = __builtin_amdgcn_readfirstlane(tid >> 6), lane = tid & 63, fr = lane & 15, fq = lane >> 4;
    const int pass = item & 1, b = item >> 6, c = (item >> 2) & 15, g = (item >> 1) & 1, R0 = b * SEQ + c * 128;
    LAS bf16* BT = (LAS bf16*)lds; LAS bf16* xT = (LAS bf16*)(lds + SSD_IMG);
    LAS float* dtv = (LAS float*)(lds + SSD_IMG + SSD_XT); LAS float* acum = dtv + 8 * 128; LAS float* wj = acum + 8 * 128;
    __syncthreads();
    { const int h = g * 8 + wid; const float tot = ssd_scalars(dtv, acum, R0, h, wid, lane, dt, a_log);
      const int j0 = 2 * lane;
      wj[wid * 128 + j0] = dtv[wid * 128 + j0] * __expf(tot - acum[wid * 128 + j0]); wj[wid * 128 + j0 + 1] = dtv[wid * 128 + j0 + 1] * __expf(tot - acum[wid * 128 + j0 + 1]);
      if (lane == 0 && pass == 0) cd[(b * 16 + c) * 16 + h] = __expf(tot); }
    stage_conv<128, true>(BT, SSDW + g * NSTATE, R0, c == 0, proj, conv_w, conv_b, tid);
    {
        stage_conv<256, true>(xT, (g * 8 + pass * 4) * HDIM, R0, c == 0, proj, conv_w, conv_b, tid);
        __syncthreads();
        {
            bf16* xd = xs + (size_t)item * (SSD_XT / 2);
#pragma unroll
            for (int i = 0; i < 9; ++i) { const int idx = tid + 512 * i; if (idx < SSD_XT / 16) *(u32x4*)(xd + 8 * idx) = *(LAS u32x4*)(xT + 8 * idx); }
        }
        const int hl = wid >> 1, nh = wid & 1, hh = pass * 4 + hl;
        f32x4 acc[4][4];
#pragma unroll
        for (int m = 0; m < 4; ++m)
#pragma unroll
            for (int n = 0; n < 4; ++n) acc[m][n] = (f32x4){0.f, 0.f, 0.f, 0.f};
#pragma unroll
        for (int ks = 0; ks < 4; ++ks) {
            const int j = 32 * ks + 8 * fq;
            const f32x4 w0 = *(LAS f32x4*)(wj + hh * 128 + j), w1 = *(LAS f32x4*)(wj + hh * 128 + j + 4);
            bf16x8 xs[4];
#pragma unroll
            for (int nt = 0; nt < 4; ++nt) { const u32x4 raw = *(LAS u32x4*)(xT + (hl * 64 + 16 * nt + fr) * LDT + j);
                u32x4 o;
                o.x = pk_bf16(__uint_as_float(raw.x << 16) * w0[0], __uint_as_float(raw.x & 0xffff0000u) * w0[1]);
                o.y = pk_bf16(__uint_as_float(raw.y << 16) * w0[2], __uint_as_float(raw.y & 0xffff0000u) * w0[3]);
                o.z = pk_bf16(__uint_as_float(raw.z << 16) * w1[0], __uint_as_float(raw.z & 0xffff0000u) * w1[1]);
                o.w = pk_bf16(__uint_as_float(raw.w << 16) * w1[2], __uint_as_float(raw.w & 0xffff0000u) * w1[3]);
                xs[nt] = __builtin_bit_cast(bf16x8, o); }
#pragma unroll
            for (int mt = 0; mt < 4; ++mt) { const bf16x8 a = *(LAS bf16x8*)(BT + (64 * nh + 32 * (mt >> 1) + 8 * (fr >> 2) + 4 * (mt & 1) + (fr & 3)) * LDT + j);
#pragma unroll
                for (int nt = 0; nt < 4; ++nt) acc[mt][nt] = __builtin_amdgcn_mfma_f32_16x16x32_bf16(a, xs[nt], acc[mt][nt], 0, 0, 0); }
        }
        bf16* dst = cs + ((size_t)((b * 16 + c) * 16 + g * 8 + hh) * HDIM) * NSTATE;
        __builtin_amdgcn_sched_barrier(0);
        asm volatile("s_nop 15\n\ts_nop 7" ::: "memory");
#pragma unroll
        for (int q = 0; q < 2; ++q)
#pragma unroll
            for (int nt = 0; nt < 4; ++nt) { u32x4 w; w.x = pk_bf16(acc[2 * q][nt][0], acc[2 * q][nt][1]); w.y = pk_bf16(acc[2 * q][nt][2], acc[2 * q][nt][3]);
                w.z = pk_bf16(acc[2 * q + 1][nt][0], acc[2 * q + 1][nt][1]); w.w = pk_bf16(acc[2 * q + 1][nt][2], acc[2 * q + 1][nt][3]);
                *(u32x4*)(dst + (size_t)(16 * nt + fr) * NSTATE + 64 * nh + 32 * q + 8 * fq) = w; }
    }
}

constexpr int PC_RC = 0, PC_RG = SSD_IMG, PC_RX = 2 * SSD_IMG, PC_SCAL = 2 * SSD_IMG + SSD_XT, PC_SQ = PC_SCAL + 2 * 8 * 128 * 4, PC_END = PC_SQ + 128 * 8 * 4;
__device__ __forceinline__ void ssd_phaseC_item(LAS unsigned char* lds, int item, const bf16* __restrict__ proj, const float* __restrict__ dt, const float* __restrict__ conv_w, const float* __restrict__ conv_b,
                                                const float* __restrict__ a_log, const float* __restrict__ d_skip, const float* __restrict__ gw, const bf16* __restrict__ s_in, const bf16* __restrict__ xs, bf16* __restrict__ A2) {
    int tid = threadIdx.x; asm volatile("" : "+v"(tid)); const int wid = __builtin_amdgcn_readfirstlane(tid >> 6), lane = tid & 63, fr = lane & 15, fq = lane >> 4;
    const int b = item >> 5, c = (item >> 1) & 15, g = item & 1, R0 = b * SEQ + c * 128;
    LAS bf16* RC = (LAS bf16*)(lds + PC_RC); LAS bf16* RG = (LAS bf16*)(lds + PC_RG); LAS bf16* RX = (LAS bf16*)(lds + PC_RX);
    LAS float* dtv = (LAS float*)(lds + PC_SCAL); LAS float* acum = dtv + 8 * 128; LAS float* sqb = (LAS float*)(lds + PC_SQ);
    __syncthreads();
    const char* xsrc = (const char*)(xs + (size_t)(item * 2) * (SSD_XT / 2)) + lane * 16;
#define PC_XLOAD(ps) do { _Pragma("unroll") for (int i_ = 0; i_ < 9; ++i_) { const int k_ = wid + 8 * i_; if (k_ < SSD_XT / 1024) \
        __builtin_amdgcn_global_load_lds((const unsigned*)(xsrc + (size_t)(ps) * SSD_XT + k_ * 1024), (LAS unsigned*)(lds + PC_RX + k_ * 1024), 16, 0, 0); } } while (0)
    PC_XLOAD(0);
    (void)ssd_scalars(dtv, acum, R0, g * 8 + wid, wid, lane, dt, a_log);
    stage_conv<128, false>(RC, SSDW + NGRP * NSTATE + g * NSTATE, R0, c == 0, proj, conv_w, conv_b, tid);
    stage_conv<128, false>(RG, SSDW + g * NSTATE, R0, c == 0, proj, conv_w, conv_b, tid);
    __syncthreads();
    {
        f32x4 ga[8];
#pragma unroll
        for (int jt = 0; jt < 8; ++jt) ga[jt] = (f32x4){0.f, 0.f, 0.f, 0.f};
#pragma unroll
        for (int ks = 0; ks < 4; ++ks) { const int n0 = 32 * ks + 8 * fq;
            const bf16x8 a = *(LAS bf16x8*)(RC + (16 * wid + fr) * LDT + n0);
#pragma unroll
            for (int jt = 0; jt < 8; ++jt) if (jt <= wid) { const bf16x8 bb = *(LAS bf16x8*)(RG + (16 * jt + fr) * LDT + n0); ga[jt] = __builtin_amdgcn_mfma_f32_16x16x32_bf16(a, bb, ga[jt], 0, 0, 0); } }
        __syncthreads();
#pragma unroll
        for (int jt = 0; jt < 8; ++jt) if (jt <= wid) {
#pragma unroll
            for (int r = 0; r < 4; ++r) RG[(16 * wid + 4 * fq + r) * LDT + 16 * jt + fr] = f2bf(ga[jt][r]); }
    }
    u32x2 hvp[2][4][4];
    const int hl = wid >> 1, rh = wid & 1;
    int irow[4];
#pragma unroll
    for (int nt = 0; nt < 4; ++nt) irow[nt] = 64 * rh + 16 * nt + fr;
    int prow[4];
#pragma unroll
    for (int mt = 0; mt < 4; ++mt) prow[mt] = 32 * (mt >> 1) + 8 * (fr >> 2) + 4 * (mt & 1) + (fr & 3);
#pragma unroll
    for (int pass = 0; pass < 2; ++pass) {
        asm volatile("s_waitcnt vmcnt(0)" ::: "memory");
        __syncthreads();
        const int hh = pass * 4 + hl, h = g * 8 + hh;
        const float Dh = d_skip[h];
        float ai[4];
#pragma unroll
        for (int nt = 0; nt < 4; ++nt) ai[nt] = acum[hh * 128 + irow[nt]];
        f32x4 hv[4][4];
#pragma unroll
        for (int m = 0; m < 4; ++m)
#pragma unroll
            for (int n = 0; n < 4; ++n) hv[m][n] = (f32x4){0.f, 0.f, 0.f, 0.f};
#pragma unroll
        for (int ks = 0; ks < 4; ++ks) {
            if (ks < 2 + 2 * rh) {
                const int j = 32 * ks + 8 * fq;
                const f32x4 aj0 = *(LAS f32x4*)(acum + hh * 128 + j), aj1 = *(LAS f32x4*)(acum + hh * 128 + j + 4);
                const f32x4 dj0 = *(LAS f32x4*)(dtv + hh * 128 + j), dj1 = *(LAS f32x4*)(dtv + hh * 128 + j + 4);
                bf16x8 sf[4];
#pragma unroll
                for (int nt = 0; nt < 4; ++nt) {
                    if (32 * ks <= 64 * rh + 16 * nt + 15) {
                        const u32x4 raw = *(LAS u32x4*)(RG + irow[nt] * LDT + j);
                        float v[8];
                        v[0] = __uint_as_float(raw.x << 16); v[1] = __uint_as_float(raw.x & 0xffff0000u); v[2] = __uint_as_float(raw.y << 16); v[3] = __uint_as_float(raw.y & 0xffff0000u);
                        v[4] = __uint_as_float(raw.z << 16); v[5] = __uint_as_float(raw.z & 0xffff0000u); v[6] = __uint_as_float(raw.w << 16); v[7] = __uint_as_float(raw.w & 0xffff0000u);
                        int dd = irow[nt] - j; asm volatile("" : "+v"(dd));
#pragma unroll
                        for (int e = 0; e < 8; ++e) { const float aj = e < 4 ? aj0[e & 3] : aj1[e & 3], dj = e < 4 ? dj0[e & 3] : dj1[e & 3];
                            v[e] = (e <= dd) ? v[e] * __expf(ai[nt] - aj) * dj : 0.f; }
                        if (ks == 2 * rh + (nt >> 1)) {
#pragma unroll
                            for (int e = 0; e < 8; ++e) v[e] += (e == dd) ? Dh : 0.f; }
                        u32x4 o; o.x = pk_bf16(v[0], v[1]); o.y = pk_bf16(v[2], v[3]); o.z = pk_bf16(v[4], v[5]); o.w = pk_bf16(v[6], v[7]);
                        sf[nt] = __builtin_bit_cast(bf16x8, o);
                    }
                }
#pragma unroll
                for (int mt = 0; mt < 4; ++mt) { const bf16x8 a = *(LAS bf16x8*)(RX + (hl * 64 + prow[mt]) * LDT + j);
#pragma unroll
                    for (int nt = 0; nt < 4; ++nt) if (32 * ks <= 64 * rh + 16 * nt + 15) hv[mt][nt] = __builtin_amdgcn_mfma_f32_16x16x32_bf16(a, sf[nt], hv[mt][nt], 0, 0, 0); }
            }
        }
        if (c > 0) {
            const bf16* sp = s_in + ((size_t)((b * 16 + c) * 16 + h) * HDIM) * NSTATE;
            float ei[4];
#pragma unroll
            for (int nt = 0; nt < 4; ++nt) ei[nt] = __expf(ai[nt]);
#pragma unroll
            for (int ks = 0; ks < 4; ++ks) { const int n0 = 32 * ks + 8 * fq;
                bf16x8 cf[4];
#pragma unroll
                for (int nt = 0; nt < 4; ++nt) { const u32x4 raw = *(LAS u32x4*)(RC + irow[nt] * LDT + n0); const float e = ei[nt];
                    u32x4 o;
                    o.x = pk_bf16(__uint_as_float(raw.x << 16) * e, __uint_as_float(raw.x & 0xffff0000u) * e); o.y = pk_bf16(__uint_as_float(raw.y << 16) * e, __uint_as_float(raw.y & 0xffff0000u) * e);
                    o.z = pk_bf16(__uint_as_float(raw.z << 16) * e, __uint_as_float(raw.z & 0xffff0000u) * e); o.w = pk_bf16(__uint_as_float(raw.w << 16) * e, __uint_as_float(raw.w & 0xffff0000u) * e);
                    cf[nt] = __builtin_bit_cast(bf16x8, o); }
#pragma unroll
                for (int mt = 0; mt < 4; ++mt) { const bf16x8 a = *(const bf16x8*)(sp + (size_t)prow[mt] * NSTATE + n0);
#pragma unroll
                    for (int nt = 0; nt < 4; ++nt) hv[mt][nt] = __builtin_amdgcn_mfma_f32_16x16x32_bf16(a, cf[nt], hv[mt][nt], 0, 0, 0); }
            }
        }
        u32x4 zr[2][4];
#pragma unroll
        for (int q = 0; q < 2; ++q)
#pragma unroll
            for (int nt = 0; nt < 4; ++nt) zr[q][nt] = *(const u32x4*)(proj + (size_t)(R0 + irow[nt]) * NPROJ + PZ + h * HDIM + 32 * q + 8 * fq);
        if (pass == 0) { __syncthreads(); PC_XLOAD(1); }
        float sq[4] = {0.f, 0.f, 0.f, 0.f};
#pragma unroll
        for (int q = 0; q < 2; ++q)
#pragma unroll
            for (int nt = 0; nt < 4; ++nt) {
#pragma unroll
                for (int hf = 0; hf < 2; ++hf) { const int mt = 2 * q + hf; const unsigned z01 = hf ? zr[q][nt].z : zr[q][nt].x, z23 = hf ? zr[q][nt].w : zr[q][nt].y;
                    const float z[4] = {__uint_as_float(z01 << 16), __uint_as_float(z01 & 0xffff0000u), __uint_as_float(z23 << 16), __uint_as_float(z23 & 0xffff0000u)};
                    float hq[4];
#pragma unroll
                    for (int r = 0; r < 4; ++r) { hq[r] = hv[mt][nt][r] * fast_silu(z[r]); sq[nt] += hq[r] * hq[r]; }
                    hvp[pass][mt][nt].x = pk_bf16(hq[0], hq[1]); hvp[pass][mt][nt].y = pk_bf16(hq[2], hq[3]); }
            }
#pragma unroll
        for (int nt = 0; nt < 4; ++nt) { float s = sq[nt]; s += __shfl_xor(s, 16); s += __shfl_xor(s, 32); if (fq == 0) sqb[irow[nt] * 8 + hh] = s; }
    }
    __syncthreads();
#pragma unroll
    for (int nt = 0; nt < 4; ++nt) {
        const f32x4 s0 = *(LAS f32x4*)(sqb + irow[nt] * 8), s1 = *(LAS f32x4*)(sqb + irow[nt] * 8 + 4);
        const float rs = 1.f / sqrtf(((s0[0] + s0[1]) + (s0[2] + s0[3]) + (s1[0] + s1[1]) + (s1[2] + s1[3])) * (1.f / 512.f) + LN_EPS);
#pragma unroll
        for (int pass = 0; pass < 2; ++pass)
#pragma unroll
            for (int q = 0; q < 2; ++q) { const int ch = (g * 8 + pass * 4 + hl) * HDIM + 32 * q + 8 * fq;
                const f32x4 g0 = *(const f32x4*)(gw + ch), g1 = *(const f32x4*)(gw + ch + 4); const u32x2 ha = hvp[pass][2 * q][nt], hb = hvp[pass][2 * q + 1][nt];
                u32x4 o;
                o.x = pk_bf16(__uint_as_float(ha.x << 16) * rs * g0[0], __uint_as_float(ha.x & 0xffff0000u) * rs * g0[1]); o.y = pk_bf16(__uint_as_float(ha.y << 16) * rs * g0[2], __uint_as_float(ha.y & 0xffff0000u) * rs * g0[3]);
                o.z = pk_bf16(__uint_as_float(hb.x << 16) * rs * g1[0], __uint_as_float(hb.x & 0xffff0000u) * rs * g1[1]); o.w = pk_bf16(__uint_as_float(hb.y << 16) * rs * g1[2], __uint_as_float(hb.y & 0xffff0000u) * rs * g1[3]);
                *(u32x4*)(A2 + (size_t)(R0 + irow[nt]) * DM + ch) = o; }
    }
}

__device__ __forceinline__ void conv_nat64(LAS bf16* dst, int chan0, int R0, int tok0, bool first, const bf16* __restrict__ proj, const float* __restrict__ conv_w, const float* __restrict__ conv_b, int tsk) {
    const int cg = tsk & 15, tb = tsk >> 4, ch = chan0 + 8 * cg, j0 = tok0 + 4 * tb;
    const bf16* src = proj + (size_t)R0 * NPROJ + PX + ch;
    u32x4 row[7];
#pragma unroll
    for (int i = 0; i < 7; ++i) { const int jj = j0 - 3 + i; row[i] = (jj >= 0 || !first) ? *(const u32x4*)(src + (ptrdiff_t)jj * NPROJ) : (u32x4){0u, 0u, 0u, 0u}; }
    float w[4][8], bias[8];
#pragma unroll
    for (int k = 0; k < 4; ++k) { const f32x4 a = *(const f32x4*)(conv_w + k * CONVD + ch), b = *(const f32x4*)(conv_w + k * CONVD + ch + 4);
        w[k][0] = a[0]; w[k][1] = a[1]; w[k][2] = a[2]; w[k][3] = a[3]; w[k][4] = b[0]; w[k][5] = b[1]; w[k][6] = b[2]; w[k][7] = b[3]; }
    { const f32x4 a = *(const f32x4*)(conv_b + ch), b = *(const f32x4*)(conv_b + ch + 4); bias[0] = a[0]; bias[1] = a[1]; bias[2] = a[2]; bias[3] = a[3]; bias[4] = b[0]; bias[5] = b[1]; bias[6] = b[2]; bias[7] = b[3]; }
#pragma unroll
    for (int q = 0; q < 2; ++q) {
        float a0[8], a1[8];
#pragma unroll
        for (int e = 0; e < 8; ++e) { a0[e] = bias[e]; a1[e] = bias[e]; }
#pragma unroll
        for (int k = 0; k < 4; ++k) { const u32x4 v0 = row[2 * q + k], v1 = row[2 * q + 1 + k];
#pragma unroll
            for (int e = 0; e < 4; ++e) { a0[2 * e] += w[k][2 * e] * __uint_as_float(v0[e] << 16); a0[2 * e + 1] += w[k][2 * e + 1] * __uint_as_float(v0[e] & 0xffff0000u);
                                          a1[2 * e] += w[k][2 * e] * __uint_as_float(v1[e] << 16); a1[2 * e + 1] += w[k][2 * e + 1] * __uint_as_float(v1[e] & 0xffff0000u); } }
#pragma unroll
        for (int e = 0; e < 8; ++e) { a0[e] = fast_silu(a0[e]); a1[e] = fast_silu(a1[e]); }
        u32x4 o; o.x = pk_bf16(a0[0], a0[1]); o.y = pk_bf16(a0[2], a0[3]); o.z = pk_bf16(a0[4], a0[5]); o.w = pk_bf16(a0[6], a0[7]);
        *(LAS u32x4*)(dst + (4 * tb + 2 * q) * LDT + 8 * cg) = o;
        o.x = pk_bf16(a1[0], a1[1]); o.y = pk_bf16(a1[2], a1[3]); o.z = pk_bf16(a1[4], a1[5]); o.w = pk_bf16(a1[6], a1[7]);
        *(LAS u32x4*)(dst + (4 * tb + 2 * q + 1) * LDT + 8 * cg) = o;
    }
}

__device__ __forceinline__ void ssd_phaseC_half(LAS unsigned char* lds, int item, const bf16* __restrict__ proj, const float* __restrict__ dt, const float* __restrict__ conv_w, const float* __restrict__ conv_b,
                                                const float* __restrict__ a_log, const float* __restrict__ d_skip, const float* __restrict__ gw, const bf16* __restrict__ s_in, const bf16* __restrict__ xs, bf16* __restrict__ A2) {
    int tid = threadIdx.x; asm volatile("" : "+v"(tid)); const int wid = __builtin_amdgcn_readfirstlane(tid >> 6), lane = tid & 63, fr = lane & 15, fq = lane >> 4;
    const int rh = item & 1, g = (item >> 1) & 1, c = (item >> 2) & 15, b = item >> 6, R0 = b * SEQ + c * 128;
    LAS bf16* RC = (LAS bf16*)(lds + PC_RC); LAS bf16* RG = (LAS bf16*)(lds + PC_RG); LAS bf16* RX = (LAS bf16*)(lds + PC_RX);
    LAS float* dtv = (LAS float*)(lds + PC_SCAL); LAS float* acum = dtv + 8 * 128; LAS float* sqb = (LAS float*)(lds + PC_SQ);
    __syncthreads();
    const char* xsrc = (const char*)(xs + (size_t)((item >> 1) * 2) * (SSD_XT / 2)) + lane * 16;
    PC_XLOAD(0);
    (void)ssd_scalars(dtv, acum, R0, g * 8 + wid, wid, lane, dt, a_log);
    {
        const int half = __builtin_amdgcn_readfirstlane(tid >> 8);
#pragma unroll 1
        for (int rd = 0; rd <= rh; ++rd) {
            if (rd == 0 || half == 0) {
                const bool isC = (rd == 0 && half == 0);
                const int tok0 = (rd == 0) ? 64 * rh : 0;
                conv_nat64(isC ? RC : RG + tok0 * LDT, isC ? SSDW + NGRP * NSTATE + g * NSTATE : SSDW + g * NSTATE, R0, tok0, c == 0, proj, conv_w, conv_b, tid & 255);
            }
        }
    }
    __syncthreads();
    {
        const int it = wid & 3, jh = wid >> 2, gi = 4 * rh + it;
        f32x4 ga[4];
#pragma unroll
        for (int jj = 0; jj < 4; ++jj) ga[jj] = (f32x4){0.f, 0.f, 0.f, 0.f};
#pragma unroll
        for (int ks = 0; ks < 4; ++ks) { const int n0 = 32 * ks + 8 * fq;
            const bf16x8 a = *(LAS bf16x8*)(RC + (16 * it + fr) * LDT + n0);
#pragma unroll
            for (int jj = 0; jj < 4; ++jj) if (4 * jh + jj <= gi) { const bf16x8 bb = *(LAS bf16x8*)(RG + (16 * (4 * jh + jj) + fr) * LDT + n0); ga[jj] = __builtin_amdgcn_mfma_f32_16x16x32_bf16(a, bb, ga[jj], 0, 0, 0); } }
        __syncthreads();
#pragma unroll
        for (int jj = 0; jj < 4; ++jj) if (4 * jh + jj <= gi) {
#pragma unroll
            for (int r = 0; r < 4; ++r) RG[(16 * it + 4 * fq + r) * LDT + 16 * (4 * jh + jj) + fr] = f2bf(ga[jj][r]); }
    }
    u32x2 hvp[2][4][2];
    const int hl = wid >> 1, nh = wid & 1, ksmax = 2 * rh + nh;
    int il[2];
#pragma unroll
    for (int n = 0; n < 2; ++n) il[n] = 32 * nh + 16 * n + fr;
    int prow[4];
#pragma unroll
    for (int mt = 0; mt < 4; ++mt) prow[mt] = 32 * (mt >> 1) + 8 * (fr >> 2) + 4 * (mt & 1) + (fr & 3);
#pragma unroll
    for (int pass = 0; pass < 2; ++pass) {
        asm volatile("s_waitcnt vmcnt(0)" ::: "memory");
        __syncthreads();
        const int hh = pass * 4 + hl, h = g * 8 + hh;
        const float Dh = d_skip[h];
        u32x4 zr[2][2];
#pragma unroll
        for (int q = 0; q < 2; ++q)
#pragma unroll
            for (int n = 0; n < 2; ++n) zr[q][n] = *(const u32x4*)(proj + (size_t)(R0 + 64 * rh + il[n]) * NPROJ + PZ + h * HDIM + 32 * q + 8 * fq);
        bf16x8 sa[4][4];
        if (c > 0) { const bf16* sp = s_in + ((size_t)((b * 16 + c) * 16 + h) * HDIM) * NSTATE;
#pragma unroll
            for (int ks = 0; ks < 4; ++ks)
#pragma unroll
                for (int mt = 0; mt < 4; ++mt) sa[ks][mt] = *(const bf16x8*)(sp + (size_t)prow[mt] * NSTATE + 32 * ks + 8 * fq); }
        float ai[2];
#pragma unroll
        for (int n = 0; n < 2; ++n) ai[n] = acum[hh * 128 + 64 * rh + il[n]];
        f32x4 hv[4][2];
#pragma unroll
        for (int m = 0; m < 4; ++m)
#pragma unroll
            for (int n = 0; n < 2; ++n) hv[m][n] = (f32x4){0.f, 0.f, 0.f, 0.f};
#pragma unroll
        for (int ks = 0; ks < 4; ++ks) {
            if (ks <= ksmax) {
                const int j = 32 * ks + 8 * fq;
                const f32x4 aj0 = *(LAS f32x4*)(acum + hh * 128 + j), aj1 = *(LAS f32x4*)(acum + hh * 128 + j + 4);
                const f32x4 dj0 = *(LAS f32x4*)(dtv + hh * 128 + j), dj1 = *(LAS f32x4*)(dtv + hh * 128 + j + 4);
                bf16x8 sf[2];
#pragma unroll
                for (int n = 0; n < 2; ++n) {
                    const u32x4 raw = *(LAS u32x4*)(RG + il[n] * LDT + j);
                    float v[8];
                    v[0] = __uint_as_float(raw.x << 16); v[1] = __uint_as_float(raw.x & 0xffff0000u); v[2] = __uint_as_float(raw.y << 16); v[3] = __uint_as_float(raw.y & 0xffff0000u);
                    v[4] = __uint_as_float(raw.z << 16); v[5] = __uint_as_float(raw.z & 0xffff0000u); v[6] = __uint_as_float(raw.w << 16); v[7] = __uint_as_float(raw.w & 0xffff0000u);
                    int dd = 64 * rh + il[n] - j; asm volatile("" : "+v"(dd));
#pragma unroll
                    for (int e = 0; e < 8; ++e) { const float aj = e < 4 ? aj0[e & 3] : aj1[e & 3], dj = e < 4 ? dj0[e & 3] : dj1[e & 3];
                        v[e] = (e <= dd) ? v[e] * __expf(ai[n] - aj) * dj : 0.f; }
                    if (ks == ksmax) {
#pragma unroll
                        for (int e = 0; e < 8; ++e) v[e] += (e == dd) ? Dh : 0.f; }
                    u32x4 o; o.x = pk_bf16(v[0], v[1]); o.y = pk_bf16(v[2], v[3]); o.z = pk_bf16(v[4], v[5]); o.w = pk_bf16(v[6], v[7]);
                    sf[n] = __builtin_bit_cast(bf16x8, o);
                }
#pragma unroll
                for (int mt = 0; mt < 4; ++mt) { const bf16x8 a = *(LAS bf16x8*)(RX + (hl * 64 + prow[mt]) * LDT + j);
#pragma unroll
                    for (int n = 0; n < 2; ++n) hv[mt][n] = __builtin_amdgcn_mfma_f32_16x16x32_bf16(a, sf[n], hv[mt][n], 0, 0, 0); }
            }
        }
        if (c > 0) {
            float ei[2];
#pragma unroll
            for (int n = 0; n < 2; ++n) ei[n] = __expf(ai[n]);
#pragma unroll
            for (int ks = 0; ks < 4; ++ks) { const int n0 = 32 * ks + 8 * fq;
                bf16x8 cf[2];
#pragma unroll
                for (int n = 0; n < 2; ++n) { const u32x4 raw = *(LAS u32x4*)(RC + il[n] * LDT + n0); const float e = ei[n];
                    u32x4 o;
                    o.x = pk_bf16(__uint_as_float(raw.x << 16) * e, __uint_as_float(raw.x & 0xffff0000u) * e); o.y = pk_bf16(__uint_as_float(raw.y << 16) * e, __uint_as_float(raw.y & 0xffff0000u) * e);
                    o.z = pk_bf16(__uint_as_float(raw.z << 16) * e, __uint_as_float(raw.z & 0xffff0000u) * e); o.w = pk_bf16(__uint_as_float(raw.w << 16) * e, __uint_as_float(raw.w & 0xffff0000u) * e);
                    cf[n] = __builtin_bit_cast(bf16x8, o); }
#pragma unroll
                for (int mt = 0; mt < 4; ++mt) {
#pragma unroll
                    for (int n = 0; n < 2; ++n) hv[mt][n] = __builtin_amdgcn_mfma_f32_16x16x32_bf16(sa[ks][mt], cf[n], hv[mt][n], 0, 0, 0); }
            }
        }
        if (pass == 0) { __syncthreads(); PC_XLOAD(1); }
        float sq[2] = {0.f, 0.f};
#pragma unroll
        for (int q = 0; q < 2; ++q)
#pragma unroll
            for (int n = 0; n < 2; ++n) {
#pragma unroll
                for (int hf = 0; hf < 2; ++hf) { const int mt = 2 * q + hf; const unsigned z01 = hf ? zr[q][n].z : zr[q][n].x, z23 = hf ? zr[q][n].w : zr[q][n].y;
                    const float z[4] = {__uint_as_float(z01 << 16), __uint_as_float(z01 & 0xffff0000u), __uint_as_float(z23 << 16), __uint_as_float(z23 & 0xffff0000u)};
                    float hq[4];
#pragma unroll
                    for (int r = 0; r < 4; ++r) { hq[r] = hv[mt][n][r] * fast_silu(z[r]); sq[n] += hq[r] * hq[r]; }
                    hvp[pass][mt][n].x = pk_bf16(hq[0], hq[1]); hvp[pass][mt][n].y = pk_bf16(hq[2], hq[3]); }
            }
#pragma unroll
        for (int n = 0; n < 2; ++n) { float s = sq[n]; s += __shfl_xor(s, 16); s += __shfl_xor(s, 32); if (fq == 0) sqb[il[n] * 8 + hh] = s; }
    }
    __syncthreads();
#pragma unroll
    for (int n = 0; n < 2; ++n) {
        const f32x4 s0 = *(LAS f32x4*)(sqb + il[n] * 8), s1 = *(LAS f32x4*)(sqb + il[n] * 8 + 4);
        const float rs = 1.f / sqrtf(((s0[0] + s0[1]) + (s0[2] + s0[3]) + (s1[0] + s1[1]) + (s1[2] + s1[3])) * (1.f / 512.f) + LN_EPS);
#pragma unroll
        for (int pass = 0; pass < 2; ++pass)
#pragma unroll
            for (int q = 0; q < 2; ++q) { const int ch = (g * 8 + pass * 4 + hl) * HDIM + 32 * q + 8 * fq;
                const f32x4 g0 = *(const f32x4*)(gw + ch), g1 = *(const f32x4*)(gw + ch + 4); const u32x2 ha = hvp[pass][2 * q][n], hb = hvp[pass][2 * q + 1][n];
                u32x4 o;
                o.x = pk_bf16(__uint_as_float(ha.x << 16) * rs * g0[0], __uint_as_float(ha.x & 0xffff0000u) * rs * g0[1]); o.y = pk_bf16(__uint_as_float(ha.y << 16) * rs * g0[2], __uint_as_float(ha.y & 0xffff0000u) * rs * g0[3]);
                o.z = pk_bf16(__uint_as_float(hb.x << 16) * rs * g1[0], __uint_as_float(hb.x & 0xffff0000u) * rs * g1[1]); o.w = pk_bf16(__uint_as_float(hb.y << 16) * rs * g1[2], __uint_as_float(hb.y & 0xffff0000u) * rs * g1[3]);
                *(u32x4*)(A2 + (size_t)(R0 + 64 * rh + il[n]) * DM + ch) = o; }
    }
}


__device__ __forceinline__ void ld_row8(const float* __restrict__ p, int lane, f32x4 (&v)[8]) {
#pragma unroll
    for (int k = 0; k < 8; ++k) v[k] = __builtin_nontemporal_load((const f32x4*)(p + 4 * lane + 256 * k));
}
__device__ __forceinline__ void row_stats8(const f32x4 (&v)[8], float& mean, float& rstd) {
    float s = 0.f;
#pragma unroll
    for (int k = 0; k < 8; ++k) s += (v[k][0] + v[k][1]) + (v[k][2] + v[k][3]);
    mean = wave_sum(s) * (1.f / DM);
    float q = 0.f;
#pragma unroll
    for (int k = 0; k < 8; ++k) { const f32x4 d = v[k] - mean; q += (d[0] * d[0] + d[1] * d[1]) + (d[2] * d[2] + d[3] * d[3]); }
    rstd = 1.f / sqrtf(wave_sum(q) * (1.f / DM) + LN_EPS);
}
__device__ __forceinline__ void w_ln_h1_row(int r, int lane, const float* __restrict__ x_prompt, const float* __restrict__ x_sample, const float* __restrict__ g, const float* __restrict__ b,
                                            const float* __restrict__ mod, float* __restrict__ stats, bf16* __restrict__ h1, bf16* __restrict__ xna) {
    const float* xr = r < MP ? x_prompt + (size_t)r * DM : x_sample + (size_t)(r - MP) * DM;
    f32x4 v[8]; ld_row8(xr, lane, v);
    float mean, rstd; row_stats8(v, mean, rstd);
    if (lane == 0) { stats[2 * r] = mean; stats[2 * r + 1] = rstd; }
    const float* mr = mod + (size_t)modrow(r) * NMOD;
#pragma unroll
    for (int k = 0; k < 8; ++k) { const int c = 4 * lane + 256 * k;
        const f32x4 gg = *(const f32x4*)(g + c), bb = *(const f32x4*)(b + c), sc = *(const f32x4*)(mr + DM + c), sh = *(const f32x4*)(mr + c);
        const f32x4 xn = (v[k] - mean) * rstd * gg + bb; const f32x4 o = xn * (sc + 1.f) + sh;
        u32x2 w; w.x = pk_bf16(o[0], o[1]); w.y = pk_bf16(o[2], o[3]); *(u32x2*)(h1 + (size_t)r * DM + c) = w;
        if (xna) { const f32x4 xa = xn * ALPHA; u32x2 w2; w2.x = pk_bf16(xa[0], xa[1]); w2.y = pk_bf16(xa[2], xa[3]); *(u32x2*)(xna + (size_t)r * DM + c) = w2; } }
}
__device__ __forceinline__ void w_ln_mix_row(int r, int lane, const float* __restrict__ x_prompt, const float* __restrict__ x_sample, const float* __restrict__ stats, const float* __restrict__ lg, const float* __restrict__ lb,
                                             const float* __restrict__ mod, const float* __restrict__ mix, const float* __restrict__ slab, const float* __restrict__ g2, const float* __restrict__ b2, float* __restrict__ x1, bf16* __restrict__ h2) {
    const float* xr = r < MP ? x_prompt + (size_t)r * DM : x_sample + (size_t)(r - MP) * DM;
    const float mean0 = stats[2 * r], rstd0 = stats[2 * r + 1];
    const float* mr = mod + (size_t)modrow(r) * NMOD;
    f32x4 v[8];
#pragma unroll
    for (int k = 0; k < 8; ++k) { const int c = 4 * lane + 256 * k;
        const f32x4 xv = *(const f32x4*)(xr + c), gg = *(const f32x4*)(lg + c), bb = *(const f32x4*)(lb + c), gm = *(const f32x4*)(mr + 2 * DM + c); f32x4 mx;
        if (slab && r >= MP) { mx = *(const f32x4*)(slab + (size_t)(r - MP) * DM + c);
#pragma unroll
            for (int s = 1; s < 8; ++s) mx += *(const f32x4*)(slab + (size_t)s * (MS * DM) + (size_t)(r - MP) * DM + c); }
        else mx = *(const f32x4*)(mix + (size_t)r * DM + c);
        const f32x4 xn = (xv - mean0) * rstd0 * gg + bb; v[k] = xn * ALPHA + (gm + 1.f) * mx; }
    float mean, rstd; row_stats8(v, mean, rstd);
#pragma unroll
    for (int k = 0; k < 8; ++k) { const int c = 4 * lane + 256 * k;
        const f32x4 gg = *(const f32x4*)(g2 + c), bb = *(const f32x4*)(b2 + c), sc = *(const f32x4*)(mr + 4 * DM + c), sh = *(const f32x4*)(mr + 3 * DM + c);
        const f32x4 o = (v[k] - mean) * rstd * gg + bb; *(f32x4*)(x1 + (size_t)r * DM + c) = o;
        const f32x4 hh = o * (sc + 1.f) + sh; u32x2 w; w.x = pk_bf16(hh[0], hh[1]); w.y = pk_bf16(hh[2], hh[3]); *(u32x2*)(h2 + (size_t)r * DM + c) = w; }
}
__device__ __forceinline__ void w_ln_out_row(int r, int lane, const float* __restrict__ mod, const float* __restrict__ f, const float* __restrict__ slab, const float* __restrict__ g3, const float* __restrict__ b3, float* __restrict__ xy) {
    const float* mr = mod + (size_t)modrow(r) * NMOD;
    f32x4 v[8];
#pragma unroll
    for (int k = 0; k < 8; ++k) { const int c = 4 * lane + 256 * k;
        const f32x4 xv = *(const f32x4*)(xy + (size_t)r * DM + c), gf = *(const f32x4*)(mr + 5 * DM + c); f32x4 fv;
        if (slab && r >= MP) { fv = *(const f32x4*)(slab + (size_t)(r - MP) * DM + c);
#pragma unroll
            for (int s = 1; s < 8; ++s) fv += *(const f32x4*)(slab + (size_t)s * (MS * DM) + (size_t)(r - MP) * DM + c); }
        else fv = *(const f32x4*)(f + (size_t)r * DM + c);
        v[k] = xv * ALPHA + (gf + 1.f) * fv; }
    float mean, rstd; row_stats8(v, mean, rstd);
#pragma unroll
    for (int k = 0; k < 8; ++k) { const int c = 4 * lane + 256 * k;
        const f32x4 gg = *(const f32x4*)(g3 + c), bb = *(const f32x4*)(b3 + c);
        *(f32x4*)(xy + (size_t)r * DM + c) = (v[k] - mean) * rstd * gg + bb; }
}
__device__ __forceinline__ float fast_gelu(float x) { const float u = 0.7978845608028654f * (x + 0.044715f * x * x * x); const float e = __expf(2.f * u); return x - x * __builtin_amdgcn_rcpf(e + 1.f); }
__device__ __forceinline__ void w_vn_row(int r, int lane, const bf16* __restrict__ proj, const float* __restrict__ g, const float* __restrict__ b, float* __restrict__ vn, float* __restrict__ out) {
    float v[16];
#pragma unroll
    for (int k = 0; k < 2; ++k) { const u32x4 raw = *(const u32x4*)(proj + (size_t)r * NPROJ + PV + 8 * lane + 512 * k);
#pragma unroll
        for (int e = 0; e < 4; ++e) { v[8 * k + 2 * e] = fast_gelu(__uint_as_float(raw[e] << 16)); v[8 * k + 2 * e + 1] = fast_gelu(__uint_as_float(raw[e] & 0xffff0000u)); } }
    float s = 0.f;
#pragma unroll
    for (int e = 0; e < 16; ++e) s += v[e];
    const float mean = wave_sum(s) * (1.f / GMW);
    float q = 0.f;
#pragma unroll
    for (int e = 0; e < 16; ++e) { const float d = v[e] - mean; q += d * d; }
    const float rstd = 1.f / sqrtf(wave_sum(q) * (1.f / GMW) + LN_EPS);
#pragma unroll
    for (int k = 0; k < 2; ++k)
#pragma unroll
        for (int hq = 0; hq < 2; ++hq) { const int c = 8 * lane + 512 * k + 4 * hq;
            const f32x4 gg = *(const f32x4*)(g + c), bb = *(const f32x4*)(b + c);
            f32x4 o;
#pragma unroll
            for (int e = 0; e < 4; ++e) o[e] = (v[8 * k + 4 * hq + e] - mean) * rstd * gg[e] + bb[e];
            *(f32x4*)(vn + (size_t)r * GMW + c) = o; if (r >= MP) *(f32x4*)(out + O_CV + (size_t)(r - MP) * GMW + c) = o; }
}

__device__ __forceinline__ void ld_row_f32x8(const float* __restrict__ p, int lane, float (&v)[4][8]) {
#pragma unroll
    for (int k = 0; k < 4; ++k) { const f32x4 a = __builtin_nontemporal_load((const f32x4*)(p + 8 * lane + 512 * k)), b = __builtin_nontemporal_load((const f32x4*)(p + 8 * lane + 512 * k + 4));
        v[k][0] = a[0]; v[k][1] = a[1]; v[k][2] = a[2]; v[k][3] = a[3]; v[k][4] = b[0]; v[k][5] = b[1]; v[k][6] = b[2]; v[k][7] = b[3]; }
}
__device__ __forceinline__ void ld_row_bf16x8(const bf16* __restrict__ p, int lane, float (&v)[4][8]) {
#pragma unroll
    for (int k = 0; k < 4; ++k) { const u32x4 raw = __builtin_nontemporal_load((const u32x4*)(p + 8 * lane + 512 * k));
#pragma unroll
        for (int e = 0; e < 4; ++e) { v[k][2 * e] = __uint_as_float(raw[e] << 16); v[k][2 * e + 1] = __uint_as_float(raw[e] & 0xffff0000u); } }
}
__device__ __forceinline__ void row_stats48(const float (&v)[4][8], float& mean, float& rstd) {
    float s = 0.f;
#pragma unroll
    for (int k = 0; k < 4; ++k)
#pragma unroll
        for (int e = 0; e < 8; ++e) s += v[k][e];
    mean = wave_sum(s) * (1.f / DM);
    float q = 0.f;
#pragma unroll
    for (int k = 0; k < 4; ++k)
#pragma unroll
        for (int e = 0; e < 8; ++e) { const float d = v[k][e] - mean; q += d * d; }
    rstd = 1.f / sqrtf(wave_sum(q) * (1.f / DM) + LN_EPS);
}
__device__ __forceinline__ void st_row_bf16x8(bf16* __restrict__ p, int lane, int k, const float (&o)[8]) {
    u32x4 w; w.x = pk_bf16(o[0], o[1]); w.y = pk_bf16(o[2], o[3]); w.z = pk_bf16(o[4], o[5]); w.w = pk_bf16(o[6], o[7]); *(u32x4*)(p + 8 * lane + 512 * k) = w;
}
__device__ __forceinline__ void sum_slabs8(const bf16* __restrict__ slab, int rs, int lane, float (&mx)[4][8]) {
#pragma unroll
    for (int k = 0; k < 4; ++k)
#pragma unroll
        for (int e = 0; e < 8; ++e) mx[k][e] = 0.f;
#pragma unroll 1
    for (int s = 0; s < 8; s += 4) {
        u32x4 raw[4][4];
#pragma unroll
        for (int q = 0; q < 4; ++q)
#pragma unroll
            for (int k = 0; k < 4; ++k) raw[q][k] = __builtin_nontemporal_load((const u32x4*)(slab + (size_t)(s + q) * (MS * DM) + (size_t)rs * DM + 8 * lane + 512 * k));
#pragma unroll
        for (int q = 0; q < 4; ++q)
#pragma unroll
            for (int k = 0; k < 4; ++k)
#pragma unroll
                for (int e = 0; e < 4; ++e) { mx[k][2 * e] += __uint_as_float(raw[q][k][e] << 16); mx[k][2 * e + 1] += __uint_as_float(raw[q][k][e] & 0xffff0000u); } }
}
__device__ __forceinline__ void w_ln_mix3_row(int r, int lane, const float* __restrict__ x_prompt, const float* __restrict__ x_sample, const float* __restrict__ stats, const float* __restrict__ lg, const float* __restrict__ lb,
                                              const float* __restrict__ mod, const bf16* __restrict__ mixb, const bf16* __restrict__ slab, const float* __restrict__ g2, const float* __restrict__ b2,
                                              bf16* __restrict__ X1, int x1_pitch, bf16* __restrict__ h2) {
    const float* xr = r < MP ? x_prompt + (size_t)r * DM : x_sample + (size_t)(r - MP) * DM;
    const float mean0 = stats[2 * r], rstd0 = stats[2 * r + 1];
    const float* mr = mod + (size_t)modrow(r) * NMOD;
    float v[4][8], mx[4][8];
    if (slab && r >= MP) sum_slabs8(slab, r - MP, lane, mx); else ld_row_bf16x8(mixb + (size_t)r * DM, lane, mx);
    ld_row_f32x8(xr, lane, v);
#pragma unroll
    for (int k = 0; k < 4; ++k) { const int c = 8 * lane + 512 * k;
#pragma unroll
        for (int hq = 0; hq < 2; ++hq) { const f32x4 gg = *(const f32x4*)(lg + c + 4 * hq), bb = *(const f32x4*)(lb + c + 4 * hq), gm = *(const f32x4*)(mr + 2 * DM + c + 4 * hq);
#pragma unroll
            for (int e = 0; e < 4; ++e) { const float xn = (v[k][4 * hq + e] - mean0) * rstd0 * gg[e] + bb[e]; v[k][4 * hq + e] = ALPHA * xn + (1.f + gm[e]) * mx[k][4 * hq + e]; } } }
    float mean, rstd; row_stats48(v, mean, rstd);
#pragma unroll
    for (int k = 0; k < 4; ++k) { const int c = 8 * lane + 512 * k; float o[8], hh[8];
#pragma unroll
        for (int hq = 0; hq < 2; ++hq) { const f32x4 gg = *(const f32x4*)(g2 + c + 4 * hq), bb = *(const f32x4*)(b2 + c + 4 * hq), sc = *(const f32x4*)(mr + 4 * DM + c + 4 * hq), sh = *(const f32x4*)(mr + 3 * DM + c + 4 * hq);
#pragma unroll
            for (int e = 0; e < 4; ++e) { o[4 * hq + e] = (v[k][4 * hq + e] - mean) * rstd * gg[e] + bb[e]; hh[4 * hq + e] = o[4 * hq + e] * (1.f + sc[e]) + sh[e]; } }
        st_row_bf16x8(X1 + (size_t)r * x1_pitch, lane, k, o); st_row_bf16x8(h2 + (size_t)r * DM, lane, k, hh); }
}
__device__ __forceinline__ void w_ln_out3_row(int r, int lane, const float* __restrict__ mod, const bf16* X1, int x1_pitch, const bf16* __restrict__ fb, const bf16* __restrict__ slab,
                                              const float* __restrict__ g3, const float* __restrict__ b3, float* y) {
    const float* mr = mod + (size_t)modrow(r) * NMOD;
    float v[4][8], fv[4][8];
    if (slab && r >= MP) sum_slabs8(slab, r - MP, lane, fv); else ld_row_bf16x8(fb + (size_t)r * DM, lane, fv);
    ld_row_bf16x8(X1 + (size_t)r * x1_pitch, lane, v);
#pragma unroll
    for (int k = 0; k < 4; ++k) { const int c = 8 * lane + 512 * k;
#pragma unroll
        for (int hq = 0; hq < 2; ++hq) { const f32x4 gf = *(const f32x4*)(mr + 5 * DM + c + 4 * hq);
#pragma unroll
            for (int e = 0; e < 4; ++e) v[k][4 * hq + e] = ALPHA * v[k][4 * hq + e] + (1.f + gf[e]) * fv[k][4 * hq + e]; } }
    float mean, rstd; row_stats48(v, mean, rstd);
    asm volatile("" ::: "memory");
#pragma unroll
    for (int k = 0; k < 4; ++k) { const int c = 8 * lane + 512 * k;
#pragma unroll
        for (int hq = 0; hq < 2; ++hq) { const f32x4 gg = *(const f32x4*)(g3 + c + 4 * hq), bb = *(const f32x4*)(b3 + c + 4 * hq); f32x4 o;
#pragma unroll
            for (int e = 0; e < 4; ++e) o[e] = (v[k][4 * hq + e] - mean) * rstd * gg[e] + bb[e];
            *(f32x4*)(y + (size_t)r * DM + c + 4 * hq) = o; } }
}

__device__ __forceinline__ void w_ln_h1_proc(int r, int lane, const f32x4 (&v)[8], const float* __restrict__ g, const float* __restrict__ b, const float* __restrict__ mod, float* __restrict__ stats, bf16* __restrict__ h1) {
    float mean, rstd; row_stats8(v, mean, rstd);
    if (lane == 0) { stats[2 * r] = mean; stats[2 * r + 1] = rstd; }
    const float* mr = mod + (size_t)modrow(r) * NMOD;
#pragma unroll
    for (int k = 0; k < 8; ++k) { const int c = 4 * lane + 256 * k;
        const f32x4 gg = *(const f32x4*)(g + c), bb = *(const f32x4*)(b + c), sc = *(const f32x4*)(mr + DM + c), sh = *(const f32x4*)(mr + c);
        const f32x4 xn = (v[k] - mean) * rstd * gg + bb; const f32x4 o = xn * (sc + 1.f) + sh;
        u32x2 w; w.x = pk_bf16(o[0], o[1]); w.y = pk_bf16(o[2], o[3]); *(u32x2*)(h1 + (size_t)r * DM + c) = w; }
}
__device__ __forceinline__ void ld_raw_bf16x8(const bf16* __restrict__ p, int lane, u32x4 (&raw)[4]) {
#pragma unroll
    for (int k = 0; k < 4; ++k) raw[k] = *(const u32x4*)(p + 8 * lane + 512 * k);
}
__device__ __forceinline__ void ld_raw_f32x8(const float* __restrict__ p, int lane, f32x4 (&raw)[8]) {
#pragma unroll
    for (int k = 0; k < 4; ++k) { raw[2 * k] = *(const f32x4*)(p + 8 * lane + 512 * k); raw[2 * k + 1] = *(const f32x4*)(p + 8 * lane + 512 * k + 4); }
}
__device__ __forceinline__ void unpack_bf16x8(const u32x4 (&raw)[4], float (&v)[4][8]) {
#pragma unroll
    for (int k = 0; k < 4; ++k)
#pragma unroll
        for (int e = 0; e < 4; ++e) { v[k][2 * e] = __uint_as_float(raw[k][e] << 16); v[k][2 * e + 1] = __uint_as_float(raw[k][e] & 0xffff0000u); }
}
__device__ __forceinline__ void w_ln_mix3_proc(int r, int lane, const f32x4 (&xraw)[8], const u32x4 (&mraw)[4], const float* __restrict__ stats, const float* __restrict__ lg, const float* __restrict__ lb,
                                               const float* __restrict__ mod, const bf16* __restrict__ slab, const float* __restrict__ g2, const float* __restrict__ b2, bf16* __restrict__ X1, int x1_pitch, bf16* __restrict__ h2) {
    const float mean0 = stats[2 * r], rstd0 = stats[2 * r + 1];
    const float* mr = mod + (size_t)modrow(r) * NMOD;
    float v[4][8], mx[4][8];
    if (slab && r >= MP) sum_slabs8(slab, r - MP, lane, mx); else unpack_bf16x8(mraw, mx);
#pragma unroll
    for (int k = 0; k < 4; ++k) { const int c = 8 * lane + 512 * k;
#pragma unroll
        for (int hq = 0; hq < 2; ++hq) { const f32x4 gg = *(const f32x4*)(lg + c + 4 * hq), bb = *(const f32x4*)(lb + c + 4 * hq), gm = *(const f32x4*)(mr + 2 * DM + c + 4 * hq); const f32x4 xv = xraw[2 * k + hq];
#pragma unroll
            for (int e = 0; e < 4; ++e) { const float xn = (xv[e] - mean0) * rstd0 * gg[e] + bb[e]; v[k][4 * hq + e] = ALPHA * xn + (1.f + gm[e]) * mx[k][4 * hq + e]; } } }
    float mean, rstd; row_stats48(v, mean, rstd);
#pragma unroll
    for (int k = 0; k < 4; ++k) { const int c = 8 * lane + 512 * k; float o[8], hh[8];
#pragma unroll
        for (int hq = 0; hq < 2; ++hq) { const f32x4 gg = *(const f32x4*)(g2 + c + 4 * hq), bb = *(const f32x4*)(b2 + c + 4 * hq), sc = *(const f32x4*)(mr + 4 * DM + c + 4 * hq), sh = *(const f32x4*)(mr + 3 * DM + c + 4 * hq);
#pragma unroll
            for (int e = 0; e < 4; ++e) { o[4 * hq + e] = (v[k][4 * hq + e] - mean) * rstd * gg[e] + bb[e]; hh[4 * hq + e] = o[4 * hq + e] * (1.f + sc[e]) + sh[e]; } }
        st_row_bf16x8(X1 + (size_t)r * x1_pitch, lane, k, o); st_row_bf16x8(h2 + (size_t)r * DM, lane, k, hh); }
}
__device__ __forceinline__ void w_ln_out3_proc(int r, int lane, const u32x4 (&xraw)[4], const u32x4 (&fraw)[4], const float* __restrict__ mod, const bf16* __restrict__ slab,
                                               const float* __restrict__ g3, const float* __restrict__ b3, float* y) {
    const float* mr = mod + (size_t)modrow(r) * NMOD;
    float v[4][8], fv[4][8];
    if (slab && r >= MP) sum_slabs8(slab, r - MP, lane, fv); else unpack_bf16x8(fraw, fv);
    unpack_bf16x8(xraw, v);
#pragma unroll
    for (int k = 0; k < 4; ++k) { const int c = 8 * lane + 512 * k;
#pragma unroll
        for (int hq = 0; hq < 2; ++hq) { const f32x4 gf = *(const f32x4*)(mr + 5 * DM + c + 4 * hq);
#pragma unroll
            for (int e = 0; e < 4; ++e) v[k][4 * hq + e] = ALPHA * v[k][4 * hq + e] + (1.f + gf[e]) * fv[k][4 * hq + e]; } }
    float mean, rstd; row_stats48(v, mean, rstd);
#pragma unroll
    for (int k = 0; k < 4; ++k) { const int c = 8 * lane + 512 * k;
#pragma unroll
        for (int hq = 0; hq < 2; ++hq) { const f32x4 gg = *(const f32x4*)(g3 + c + 4 * hq), bb = *(const f32x4*)(b3 + c + 4 * hq); f32x4 o;
#pragma unroll
            for (int e = 0; e < 4; ++e) o[e] = (v[k][4 * hq + e] - mean) * rstd * gg[e] + bb[e];
            *(f32x4*)(y + (size_t)r * DM + c + 4 * hq) = o; } }
}

__device__ __forceinline__ void w_ln_h1_lds(int r, int lane, const float* __restrict__ xrow, LAS const float* UV, float* __restrict__ stats, bf16* __restrict__ h1) {
    f32x4 v[8]; ld_row8(xrow, lane, v);
    float mean, rstd; row_stats8(v, mean, rstd);
    if (lane == 0) { stats[2 * r] = mean; stats[2 * r + 1] = rstd; }
#pragma unroll
    for (int k = 0; k < 8; ++k) { const int c = 4 * lane + 256 * k;
        const f32x4 U = *(LAS const f32x4*)(UV + c), V = *(LAS const f32x4*)(UV + DM + c);
        const f32x4 o = (v[k] - mean) * rstd * U + V;
        u32x2 w; w.x = pk_bf16(o[0], o[1]); w.y = pk_bf16(o[2], o[3]); *(u32x2*)(h1 + (size_t)r * DM + c) = w; }
}
__device__ __forceinline__ void w_ln_mix3_lds(int r, int lane, const float* __restrict__ xrow, const bf16* __restrict__ mixrow, const float* __restrict__ stats, LAS const float* C, LAS const float* Bt,
                                              bf16* __restrict__ X1row, bf16* __restrict__ h2row) {
    const float mean0 = stats[2 * r], rstd0 = stats[2 * r + 1];
    float v[4][8], mx[4][8];
    ld_row_bf16x8(mixrow, lane, mx);
    ld_row_f32x8(xrow, lane, v);
#pragma unroll
    for (int k = 0; k < 4; ++k) { const int c = 8 * lane + 512 * k;
#pragma unroll
        for (int hq = 0; hq < 2; ++hq) { const f32x4 a1 = *(LAS const f32x4*)(C + c + 4 * hq), b1 = *(LAS const f32x4*)(C + DM + c + 4 * hq), gm = *(LAS const f32x4*)(Bt + c + 4 * hq);
#pragma unroll
            for (int e = 0; e < 4; ++e) v[k][4 * hq + e] = (v[k][4 * hq + e] - mean0) * rstd0 * a1[e] + b1[e] + gm[e] * mx[k][4 * hq + e]; } }
    float mean, rstd; row_stats48(v, mean, rstd);
#pragma unroll
    for (int k = 0; k < 4; ++k) { const int c = 8 * lane + 512 * k; float o[8], hh[8];
#pragma unroll
        for (int hq = 0; hq < 2; ++hq) { const f32x4 gg = *(LAS const f32x4*)(C + 2 * DM + c + 4 * hq), bb = *(LAS const f32x4*)(C + 3 * DM + c + 4 * hq), u2 = *(LAS const f32x4*)(Bt + DM + c + 4 * hq), v2 = *(LAS const f32x4*)(Bt + 2 * DM + c + 4 * hq);
#pragma unroll
            for (int e = 0; e < 4; ++e) { const float t = (v[k][4 * hq + e] - mean) * rstd; o[4 * hq + e] = t * gg[e] + bb[e]; hh[4 * hq + e] = t * u2[e] + v2[e]; } }
        st_row_bf16x8(X1row, lane, k, o); st_row_bf16x8(h2row, lane, k, hh); }
}
__device__ __forceinline__ void w_ln_out3_lds(int r, int lane, const bf16* X1row, const bf16* __restrict__ frow, LAS const float* C, LAS const float* GF, float* yrow, LAS float* tr) {
    float v[4][8], fv[4][8];
    ld_row_bf16x8(frow, lane, fv);
    ld_row_bf16x8(X1row, lane, v);
#pragma unroll
    for (int k = 0; k < 4; ++k) { const int c = 8 * lane + 512 * k;
#pragma unroll
        for (int hq = 0; hq < 2; ++hq) { const f32x4 gf = *(LAS const f32x4*)(GF + c + 4 * hq);
#pragma unroll
            for (int e = 0; e < 4; ++e) v[k][4 * hq + e] = ALPHA * v[k][4 * hq + e] + gf[e] * fv[k][4 * hq + e]; } }
    float mean, rstd; row_stats48(v, mean, rstd);
    asm volatile("" ::: "memory");
#pragma unroll
    for (int k = 0; k < 4; ++k) { const int c = 8 * lane + 512 * k;
        *(LAS f32x4*)(tr + c) = (f32x4){(v[k][0] - mean) * rstd, (v[k][1] - mean) * rstd, (v[k][2] - mean) * rstd, (v[k][3] - mean) * rstd};
        *(LAS f32x4*)(tr + c + 4) = (f32x4){(v[k][4] - mean) * rstd, (v[k][5] - mean) * rstd, (v[k][6] - mean) * rstd, (v[k][7] - mean) * rstd}; }
#pragma unroll
    for (int k = 0; k < 8; ++k) { const int c = 4 * lane + 256 * k;
        const f32x4 t = *(LAS const f32x4*)(tr + c), gg = *(LAS const f32x4*)(C + c), bb = *(LAS const f32x4*)(C + DM + c);
        __builtin_nontemporal_store(t * gg + bb, (f32x4*)(yrow + c)); }
}

typedef float f32x2r __attribute__((ext_vector_type(2)));
__device__ __forceinline__ void wg_row_stats(const f32x4 (&v)[8], LAS f32x2r* red, int wid, int lane, float (&mean)[8], float (&rstd)[8]) {
#pragma unroll
    for (int i = 0; i < 8; ++i) { float s = (v[i][0] + v[i][1]) + (v[i][2] + v[i][3]), q = (v[i][0] * v[i][0] + v[i][1] * v[i][1]) + (v[i][2] * v[i][2] + v[i][3] * v[i][3]);
        s = wave_sum(s); q = wave_sum(q); if (lane == 0) red[i * 8 + wid] = (f32x2r){s, q}; }
    __syncthreads();
#pragma unroll
    for (int i = 0; i < 8; ++i) { float s = 0.f, q = 0.f;
#pragma unroll
        for (int w = 0; w < 8; ++w) { const f32x2r t = red[i * 8 + w]; s += t.x; q += t.y; }
        mean[i] = s * (1.f / DM); rstd[i] = 1.f / sqrtf(fmaxf(q * (1.f / DM) - mean[i] * mean[i], 0.f) + LN_EPS); }
}
__device__ __forceinline__ void wg_ln_h1(int r0, int wid, int lane, const float* __restrict__ x, LAS const float* UV, LAS f32x2r* red, float* __restrict__ stats, bf16* __restrict__ h1) {
    const int c = 256 * wid + 4 * lane;
    const f32x4 U = *(LAS const f32x4*)(UV + c), V = *(LAS const f32x4*)(UV + DM + c);
#pragma unroll 1
    for (int grp = 0; grp < 4; ++grp) { const int rb = r0 + 8 * grp;
        f32x4 v[8];
#pragma unroll
        for (int i = 0; i < 8; ++i) v[i] = *(const f32x4*)(x + (size_t)(rb + i) * DM + c);
        float mean[8], rstd[8]; wg_row_stats(v, red + (grp & 1) * 64, wid, lane, mean, rstd);
        if (wid == 0 && lane < 8) { float m = 0.f, rs = 0.f;
#pragma unroll
            for (int i = 0; i < 8; ++i) { m = lane == i ? mean[i] : m; rs = lane == i ? rstd[i] : rs; }
            stats[2 * (rb + lane)] = m; stats[2 * (rb + lane) + 1] = rs; }
#pragma unroll
        for (int i = 0; i < 8; ++i) { const f32x4 o = (v[i] - mean[i]) * rstd[i] * U + V; u32x2 w; w.x = pk_bf16(o[0], o[1]); w.y = pk_bf16(o[2], o[3]); *(u32x2*)(h1 + (size_t)(rb + i) * DM + c) = w; } }
}
__device__ __forceinline__ void wg_ln_mix(int r0, int wid, int lane, const float* __restrict__ x, const bf16* __restrict__ mixb, const float* __restrict__ stats, LAS const float* Cc, LAS const float* Bt, LAS f32x2r* red,
                                          bf16* __restrict__ X1, int x1_pitch, bf16* __restrict__ h2) {
    const int c = 256 * wid + 4 * lane;
    const f32x4 A1 = *(LAS const f32x4*)(Cc + c), B1 = *(LAS const f32x4*)(Cc + DM + c), G2 = *(LAS const f32x4*)(Cc + 2 * DM + c), B2 = *(LAS const f32x4*)(Cc + 3 * DM + c);
    const f32x4 GM = *(LAS const f32x4*)(Bt + c), U2 = *(LAS const f32x4*)(Bt + DM + c), V2 = *(LAS const f32x4*)(Bt + 2 * DM + c);
#pragma unroll 1
    for (int grp = 0; grp < 4; ++grp) { const int rb = r0 + 8 * grp;
        f32x4 v[8]; u32x2 mr[8];
#pragma unroll
        for (int i = 0; i < 8; ++i) { v[i] = *(const f32x4*)(x + (size_t)(rb + i) * DM + c); mr[i] = *(const u32x2*)(mixb + (size_t)(rb + i) * DM + c); }
#pragma unroll
        for (int i = 0; i < 8; ++i) { const float m0 = stats[2 * (rb + i)], s0 = stats[2 * (rb + i) + 1];
            const f32x4 mx = (f32x4){__uint_as_float(mr[i].x << 16), __uint_as_float(mr[i].x & 0xffff0000u), __uint_as_float(mr[i].y << 16), __uint_as_float(mr[i].y & 0xffff0000u)};
            v[i] = (v[i] - m0) * s0 * A1 + B1 + GM * mx; }
        float mean[8], rstd[8]; wg_row_stats(v, red + (grp & 1) * 64, wid, lane, mean, rstd);
#pragma unroll
        for (int i = 0; i < 8; ++i) { const f32x4 t = (v[i] - mean[i]) * rstd[i]; const f32x4 o = t * G2 + B2, hh = t * U2 + V2;
            u32x2 w; w.x = pk_bf16(o[0], o[1]); w.y = pk_bf16(o[2], o[3]); *(u32x2*)(X1 + (size_t)(rb + i) * x1_pitch + c) = w;
            u32x2 w2; w2.x = pk_bf16(hh[0], hh[1]); w2.y = pk_bf16(hh[2], hh[3]); *(u32x2*)(h2 + (size_t)(rb + i) * DM + c) = w2; } }
}
__device__ __forceinline__ void wg_ln_out(int r0, int wid, int lane, const bf16* X1, int x1_pitch, const bf16* __restrict__ fb, LAS const float* Cc, LAS const float* GFp, LAS f32x2r* red, float* y) {
    const int c = 256 * wid + 4 * lane;
    const f32x4 G3 = *(LAS const f32x4*)(Cc + c), B3 = *(LAS const f32x4*)(Cc + DM + c), GF = *(LAS const f32x4*)(GFp + c);
#pragma unroll 1
    for (int grp = 0; grp < 4; ++grp) { const int rb = r0 + 8 * grp;
        f32x4 v[8]; u32x2 xr[8], fr[8];
#pragma unroll
        for (int i = 0; i < 8; ++i) { xr[i] = *(const u32x2*)(X1 + (size_t)(rb + i) * x1_pitch + c); fr[i] = *(const u32x2*)(fb + (size_t)(rb + i) * DM + c); }
#pragma unroll
        for (int i = 0; i < 8; ++i) { const f32x4 x1 = (f32x4){__uint_as_float(xr[i].x << 16), __uint_as_float(xr[i].x & 0xffff0000u), __uint_as_float(xr[i].y << 16), __uint_as_float(xr[i].y & 0xffff0000u)};
            const f32x4 fv = (f32x4){__uint_as_float(fr[i].x << 16), __uint_as_float(fr[i].x & 0xffff0000u), __uint_as_float(fr[i].y << 16), __uint_as_float(fr[i].y & 0xffff0000u)};
            v[i] = x1 * ALPHA + GF * fv; }
        float mean[8], rstd[8]; wg_row_stats(v, red + (grp & 1) * 64, wid, lane, mean, rstd);
#pragma unroll
        for (int i = 0; i < 8; ++i) *(f32x4*)(y + (size_t)(rb + i) * DM + c) = (v[i] - mean[i]) * rstd[i] * G3 + B3; }
}


__device__ __forceinline__ void w_vstats_row(int r, int lane, const bf16* __restrict__ proj, const float* __restrict__ g, const float* __restrict__ b, float* __restrict__ vstats, float* __restrict__ out) {
    float v[16];
#pragma unroll
    for (int k = 0; k < 2; ++k) { const u32x4 raw = *(const u32x4*)(proj + (size_t)r * NPROJ + PV + 8 * lane + 512 * k);
#pragma unroll
        for (int e = 0; e < 4; ++e) { v[8 * k + 2 * e] = fast_gelu(__uint_as_float(raw[e] << 16)); v[8 * k + 2 * e + 1] = fast_gelu(__uint_as_float(raw[e] & 0xffff0000u)); } }
    float s = 0.f;
#pragma unroll
    for (int e = 0; e < 16; ++e) s += v[e];
    const float mean = wave_sum(s) * (1.f / GMW);
    float q = 0.f;
#pragma unroll
    for (int e = 0; e < 16; ++e) { const float d = v[e] - mean; q += d * d; }
    const float rstd = 1.f / sqrtf(wave_sum(q) * (1.f / GMW) + LN_EPS);
    if (lane == 0) { vstats[2 * r] = mean; vstats[2 * r + 1] = rstd; }
    if (r >= MP) {
#pragma unroll
        for (int k = 0; k < 2; ++k)
#pragma unroll
            for (int hq = 0; hq < 2; ++hq) { const int c = 8 * lane + 512 * k + 4 * hq;
                const f32x4 gg = *(const f32x4*)(g + c), bb = *(const f32x4*)(b + c);
                f32x4 o;
#pragma unroll
                for (int e = 0; e < 4; ++e) o[e] = (v[8 * k + 4 * hq + e] - mean) * rstd * gg[e] + bb[e];
                *(f32x4*)(out + O_CV + (size_t)(r - MP) * GMW + c) = o; }
    }
}
__device__ __forceinline__ void w_gmlp_ln_row(int r, int lane, bf16* proj, const float* __restrict__ g, const float* __restrict__ b, float* __restrict__ out) {
    float v[16];
#pragma unroll
    for (int k = 0; k < 2; ++k) { const u32x4 raw = __builtin_nontemporal_load((const u32x4*)(proj + (size_t)r * NPROJ + PV + 8 * lane + 512 * k));
#pragma unroll
        for (int e = 0; e < 4; ++e) { v[8 * k + 2 * e] = fast_gelu(__uint_as_float(raw[e] << 16)); v[8 * k + 2 * e + 1] = fast_gelu(__uint_as_float(raw[e] & 0xffff0000u)); } }
    float s = 0.f;
#pragma unroll
    for (int e = 0; e < 16; ++e) s += v[e];
    const float mean = wave_sum(s) * (1.f / GMW);
    float q = 0.f;
#pragma unroll
    for (int e = 0; e < 16; ++e) { const float d = v[e] - mean; q += d * d; }
    const float rstd = 1.f / sqrtf(wave_sum(q) * (1.f / GMW) + LN_EPS);
#pragma unroll
    for (int k = 0; k < 2; ++k) { const int c = 8 * lane + 512 * k;
        const f32x4 g0 = *(const f32x4*)(g + c), g1 = *(const f32x4*)(g + c + 4), b0 = *(const f32x4*)(b + c), b1 = *(const f32x4*)(b + c + 4);
        f32x4 o0, o1;
#pragma unroll
        for (int e = 0; e < 4; ++e) { o0[e] = (v[8 * k + e] - mean) * rstd * g0[e] + b0[e]; o1[e] = (v[8 * k + 4 + e] - mean) * rstd * g1[e] + b1[e]; }
        if (r >= MP) { *(f32x4*)(out + O_CV + (size_t)(r - MP) * GMW + c) = o0; *(f32x4*)(out + O_CV + (size_t)(r - MP) * GMW + c + 4) = o1; }
        else { u32x4 w; w.x = pk_bf16(o0[0], o0[1]); w.y = pk_bf16(o0[2], o0[3]); w.z = pk_bf16(o1[0], o1[1]); w.w = pk_bf16(o1[2], o1[3]); *(u32x4*)(proj + (size_t)r * NPROJ + PV + c) = w; } }
}
__device__ __forceinline__ void gmlp_group(LAS unsigned char* lds, int hd, int bc0, int bcs, int cnt, const bf16* __restrict__ proj, const float* __restrict__ w_s, const float* __restrict__ b_s, bf16* __restrict__ A2) {
    int tid = threadIdx.x; asm volatile("" : "+v"(tid)); const int wid = __builtin_amdgcn_readfirstlane(tid >> 6), lane = tid & 63, fr = lane & 15, fq = lane >> 4;
    LAS bf16* Wl = (LAS bf16*)(lds + 2 * SSD_IMG);
    const int dq = wid & 3, ih = wid >> 2, dg = tid >> 5, tb = tid & 31;
    const bf16* vsrc = proj + (size_t)(4 * tb) * NPROJ + PV + hd * GMHD + 8 * dg;
    u32x4 raw[4];
#pragma unroll
    for (int t = 0; t < 4; ++t) raw[t] = *(const u32x4*)(vsrc + (size_t)(bc0 * 128 + t) * NPROJ);
    float bs[4];
#pragma unroll
    for (int n = 0; n < 4; ++n) bs[n] = b_s[hd * 128 + 16 * (2 * n + ih) + fr];
    __syncthreads();
    {
        const int i = tid >> 2, j0 = (tid & 3) * 32; const float* wp = w_s + ((size_t)hd * 128 + i) * 128 + j0;
#pragma unroll
        for (int q = 0; q < 4; ++q) { const f32x4 a = *(const f32x4*)(wp + 8 * q), c = *(const f32x4*)(wp + 8 * q + 4); const int j = j0 + 8 * q;
            u32x4 w; w.x = pk_bf16(j <= i ? a[0] : 0.f, j + 1 <= i ? a[1] : 0.f); w.y = pk_bf16(j + 2 <= i ? a[2] : 0.f, j + 3 <= i ? a[3] : 0.f);
            w.z = pk_bf16(j + 4 <= i ? c[0] : 0.f, j + 5 <= i ? c[1] : 0.f); w.w = pk_bf16(j + 6 <= i ? c[2] : 0.f, j + 7 <= i ? c[3] : 0.f);
            *(LAS u32x4*)(Wl + i * LDT + j) = w; }
    }
    int prow[2];
#pragma unroll
    for (int mt = 0; mt < 2; ++mt) prow[mt] = 32 * dq + 8 * (fr >> 2) + 4 * mt + (fr & 3);
    const bf16* usrc = proj + (size_t)(16 * ih + fr) * NPROJ + PU + hd * GMHD + 32 * dq + 8 * fq;
    bf16* dsto = A2 + (size_t)(16 * ih + fr) * DM + SSDW + hd * GMHD + 32 * dq + 8 * fq;
#pragma unroll 1
    for (int k = 0; k < cnt; ++k) {
        const int R0 = (bc0 + k * bcs) * 128;
        LAS bf16* vT = (LAS bf16*)(lds + (k & 1) * SSD_IMG);
#pragma unroll
        for (int e = 0; e < 4; ++e) { u32x2 w;
            w.x = __builtin_amdgcn_perm(raw[1][e], raw[0][e], 0x05040100u); w.y = __builtin_amdgcn_perm(raw[3][e], raw[2][e], 0x05040100u); *(LAS u32x2*)(vT + (8 * dg + 2 * e) * LDT + 4 * tb) = w;
            w.x = __builtin_amdgcn_perm(raw[1][e], raw[0][e], 0x07060302u); w.y = __builtin_amdgcn_perm(raw[3][e], raw[2][e], 0x07060302u); *(LAS u32x2*)(vT + (8 * dg + 2 * e + 1) * LDT + 4 * tb) = w; }
        if (k + 1 < cnt) {
#pragma unroll
            for (int t = 0; t < 4; ++t) raw[t] = *(const u32x4*)(vsrc + (size_t)(R0 + bcs * 128 + t) * NPROJ); }
        u32x4 ur[4];
#pragma unroll
        for (int n = 0; n < 4; ++n) ur[n] = *(const u32x4*)(usrc + (size_t)(R0 + 32 * n) * NPROJ);
        __syncthreads();
        f32x4 acc[2][4];
#pragma unroll
        for (int mt = 0; mt < 2; ++mt)
#pragma unroll
            for (int n = 0; n < 4; ++n) acc[mt][n] = (f32x4){0.f, 0.f, 0.f, 0.f};
#pragma unroll
        for (int ks = 0; ks < 4; ++ks) { const int j = 32 * ks + 8 * fq;
            const bf16x8 a0 = *(LAS bf16x8*)(vT + prow[0] * LDT + j), a1 = *(LAS bf16x8*)(vT + prow[1] * LDT + j);
#pragma unroll
            for (int n = 0; n < 4; ++n) if (32 * ks <= 16 * (2 * n + 1) + 15 && (32 * ks <= 16 * (2 * n) + 15 || ih == 1)) { const bf16x8 bw = *(LAS bf16x8*)(Wl + (16 * (2 * n + ih) + fr) * LDT + j);
                acc[0][n] = __builtin_amdgcn_mfma_f32_16x16x32_bf16(a0, bw, acc[0][n], 0, 0, 0); acc[1][n] = __builtin_amdgcn_mfma_f32_16x16x32_bf16(a1, bw, acc[1][n], 0, 0, 0); } }
#pragma unroll
        for (int n = 0; n < 4; ++n) {
            const float u0 = fast_gelu(__uint_as_float(ur[n].x << 16)), u1 = fast_gelu(__uint_as_float(ur[n].x & 0xffff0000u)), u2 = fast_gelu(__uint_as_float(ur[n].y << 16)), u3 = fast_gelu(__uint_as_float(ur[n].y & 0xffff0000u));
            const float u4 = fast_gelu(__uint_as_float(ur[n].z << 16)), u5 = fast_gelu(__uint_as_float(ur[n].z & 0xffff0000u)), u6 = fast_gelu(__uint_as_float(ur[n].w << 16)), u7 = fast_gelu(__uint_as_float(ur[n].w & 0xffff0000u));
            u32x4 o; o.x = pk_bf16(u0 * (acc[0][n][0] + bs[n]), u1 * (acc[0][n][1] + bs[n])); o.y = pk_bf16(u2 * (acc[0][n][2] + bs[n]), u3 * (acc[0][n][3] + bs[n]));
            o.z = pk_bf16(u4 * (acc[1][n][0] + bs[n]), u5 * (acc[1][n][1] + bs[n])); o.w = pk_bf16(u6 * (acc[1][n][2] + bs[n]), u7 * (acc[1][n][3] + bs[n]));
            *(u32x4*)(dsto + (size_t)(R0 + 32 * n) * DM) = o; }
    }
}
__device__ __forceinline__ void gmlp_sample_item(int bs, const bf16* __restrict__ proj, const float* __restrict__ vn_s, const float* __restrict__ w_s, const float* __restrict__ b_s, bf16* __restrict__ A2) {
    int tid = threadIdx.x; asm volatile("" : "+v"(tid));
    const int c0 = 2 * tid, hd = c0 >> 7, R0 = MP + bs * DSEQ;
    float v[8][2];
#pragma unroll
    for (int j = 0; j < 8; ++j) { const float2 t = *(const float2*)(vn_s + (size_t)(bs * DSEQ + j) * GMW + c0); v[j][0] = t.x; v[j][1] = t.y; }
#pragma unroll
    for (int i = 0; i < 8; ++i) { float a0 = 0.f, a1 = 0.f;
#pragma unroll
        for (int j = 0; j <= i; ++j) { const float w = w_s[((size_t)hd * 128 + i) * 128 + j]; a0 += w * v[j][0]; a1 += w * v[j][1]; }
        const float bsv = b_s[hd * 128 + i];
        const unsigned ur = *(const unsigned*)(proj + (size_t)(R0 + i) * NPROJ + PU + c0);
        const float u0 = fast_gelu(__uint_as_float(ur << 16)), u1 = fast_gelu(__uint_as_float(ur & 0xffff0000u));
        *(unsigned*)(A2 + (size_t)(R0 + i) * DM + SSDW + c0) = pk_bf16(u0 * (a0 + bsv), u1 * (a1 + bsv)); }
}


__device__ __forceinline__ void p0_transpose_item(const float* __restrict__ W, int K, int ld, int nblk, bf16* __restrict__ WT, LAS float* scr, int item, int lane) {
    const int kb = item / nblk, nb = item % nblk, k0 = 64 * kb, n0 = 32 * nb;
    float tv[32];
#pragma unroll
    for (int i = 0; i < 32; ++i) { const int kk = 2 * i + (lane >> 5); tv[i] = __builtin_nontemporal_load(W + (size_t)(k0 + kk) * ld + n0 + (lane & 31)); }
#pragma unroll
    for (int i = 0; i < 32; ++i) { const int kk = 2 * i + (lane >> 5); scr[kk * 33 + (lane & 31)] = tv[i]; }
    asm volatile("s_waitcnt lgkmcnt(0)" ::: "memory");
    const int c = lane & 7;
#pragma unroll
    for (int j = 0; j < 4; ++j) { const int n = (lane >> 3) + 8 * j; const LAS float* s = scr + (8 * c) * 33 + n;
        u32x4 o; o.x = pk_bf16(s[0 * 33], s[1 * 33]); o.y = pk_bf16(s[2 * 33], s[3 * 33]); o.z = pk_bf16(s[4 * 33], s[5 * 33]); o.w = pk_bf16(s[6 * 33], s[7 * 33]);
        *(u32x4*)(WT + (size_t)(n0 + n) * K + k0 + 8 * c) = o; }
    asm volatile("s_waitcnt lgkmcnt(0)" ::: "memory");
}
constexpr int MOD_LDW = 136, MOD_WBUF = 48 * MOD_LDW * 2;
__device__ __forceinline__ void mod_item(LAS unsigned char* lds, int item, const bf16* __restrict__ csilu, const float* __restrict__ w_mod, const float* __restrict__ b_mod, float* __restrict__ mod) {
    int tid = threadIdx.x; asm volatile("" : "+v"(tid)); const int wid = __builtin_amdgcn_readfirstlane(tid >> 6), lane = tid & 63, fr = lane & 15, fq = lane >> 4;
    const int n0 = 48 * item;
    __syncthreads();
    const bool stg = tid < 384;
    const int sn4 = tid % 12, skq = tid / 12;
    const float* wsrc = w_mod + (size_t)(4 * skq) * NMOD + n0 + 4 * sn4;
    f32x4 pre[4][4];
    if (stg) {
#pragma unroll
        for (int u = 0; u < 4; ++u)
#pragma unroll
            for (int j = 0; j < 4; ++j) pre[u][j] = __builtin_nontemporal_load((const f32x4*)(wsrc + (size_t)(128 * u + j) * NMOD)); }
    constexpr int ALD = 136, ABUF = 132 * ALD * 2;
    LAS unsigned char* abase = lds + 2 * MOD_WBUF;
    u32x4 areg[5];
#define MOD_ALOAD(kcn) do { _Pragma("unroll") for (int i_ = 0; i_ < 5; ++i_) { const int p_ = tid + 512 * i_; if (p_ < 132 * 16) areg[i_] = *(const u32x4*)(csilu + (size_t)(p_ >> 4) * DM + 128 * (kcn) + 8 * (p_ & 15)); } } while (0)
    MOD_ALOAD(0);
    f32x4 acc[3], acc9[3];
#pragma unroll
    for (int nt = 0; nt < 3; ++nt) { acc[nt] = (f32x4){0.f, 0.f, 0.f, 0.f}; acc9[nt] = (f32x4){0.f, 0.f, 0.f, 0.f}; }
#pragma unroll 1
    for (int kc4 = 0; kc4 < 16; kc4 += 4) {
#pragma unroll
      for (int u = 0; u < 4; ++u) { const int kc = kc4 + u;
        LAS bf16* Wb = (LAS bf16*)(lds + (u & 1) * MOD_WBUF); LAS bf16* Ab = (LAS bf16*)(abase + (u & 1) * ABUF);
#pragma unroll
        for (int i_ = 0; i_ < 5; ++i_) { const int p_ = tid + 512 * i_; if (p_ < 132 * 16) *(LAS u32x4*)(Ab + (p_ >> 4) * ALD + 8 * (p_ & 15)) = areg[i_]; }
        if (kc < 15) MOD_ALOAD(kc + 1);
        if (stg) {
#pragma unroll
            for (int e = 0; e < 4; ++e) { u32x2 w; w.x = pk_bf16(pre[u][0][e], pre[u][1][e]); w.y = pk_bf16(pre[u][2][e], pre[u][3][e]); *(LAS u32x2*)(Wb + (4 * sn4 + e) * MOD_LDW + 4 * skq) = w; }
            if (kc < 12) {
#pragma unroll
                for (int j = 0; j < 4; ++j) pre[u][j] = __builtin_nontemporal_load((const f32x4*)(wsrc + (size_t)(128 * (kc + 4) + j) * NMOD)); }
        }
        __syncthreads();
#pragma unroll
        for (int ks = 0; ks < 4; ++ks) {
            const int kk = 32 * ks + 8 * fq;
            const bf16x8 afr = *(LAS bf16x8*)(Ab + (16 * wid + fr) * ALD + kk);
            bf16x8 bfr[3];
#pragma unroll
            for (int nt = 0; nt < 3; ++nt) bfr[nt] = *(LAS bf16x8*)(Wb + (16 * nt + fr) * MOD_LDW + kk);
#pragma unroll
            for (int nt = 0; nt < 3; ++nt) acc[nt] = __builtin_amdgcn_mfma_f32_16x16x32_bf16(afr, bfr[nt], acc[nt], 0, 0, 0);
            if (((4 * kc + ks) & 7) == wid) {
                u32x4 ep = (u32x4){0u, 0u, 0u, 0u};
                if (fr < 4) ep = *(LAS u32x4*)(Ab + (128 + fr) * ALD + kk);
                const bf16x8 ef = __builtin_bit_cast(bf16x8, ep);
#pragma unroll
                for (int nt = 0; nt < 3; ++nt) acc9[nt] = __builtin_amdgcn_mfma_f32_16x16x32_bf16(ef, bfr[nt], acc9[nt], 0, 0, 0);
            }
        }
      }
    }
#undef MOD_ALOAD
#pragma unroll
    for (int nt = 0; nt < 3; ++nt) { const int n = n0 + 16 * nt + fr; const float bb = b_mod[n];
#pragma unroll
        for (int r = 0; r < 4; ++r) mod[(size_t)(16 * wid + 4 * fq + r) * NMOD + n] = acc[nt][r] + bb; }
    __syncthreads();
    LAS float* red = (LAS float*)(lds + 2 * MOD_WBUF + 2 * ABUF);
    if (fq == 0) {
#pragma unroll
        for (int nt = 0; nt < 3; ++nt) *(LAS f32x4*)(red + ((wid * 3 + nt) * 16 + fr) * 4) = acc9[nt]; }
    __syncthreads();
    if (tid < 192) { const int nt = tid >> 6, f = (tid >> 2) & 15, r = tid & 3; float s = 0.f;
#pragma unroll
        for (int w = 0; w < 8; ++w) s += red[((w * 3 + nt) * 16 + f) * 4 + r];
        const int n = n0 + 16 * nt + f; mod[(size_t)(128 + r) * NMOD + n] = s + b_mod[n]; }
}


constexpr int SM_XS = 0, SM_BS = 16384, SM_CS = 20480, SM_G = 24576, SM_SQ = 24832, SM_END = 25088;
__device__ __forceinline__ void sample_ssd_item(LAS unsigned char* lds, int item, const bf16* __restrict__ proj, const float* __restrict__ dt, const float* __restrict__ state_conv, const float* __restrict__ conv_w,
                                                const float* __restrict__ conv_b, const float* __restrict__ a_log, const float* __restrict__ d_skip, const float* __restrict__ gw, const float* __restrict__ state_ssm,
                                                bf16* __restrict__ A2, float* __restrict__ out) {
    int tid = threadIdx.x; asm volatile("" : "+v"(tid)); const int wid = __builtin_amdgcn_readfirstlane(tid >> 6), lane = tid & 63, fr = lane & 15, fq = lane >> 4;
    const int bs = item >> 1, g = item & 1, R0 = MP + bs * DSEQ, h = g * 8 + wid;
    LAS float* xs = (LAS float*)(lds + SM_XS); LAS float* Bs = (LAS float*)(lds + SM_BS); LAS float* Cs = (LAS float*)(lds + SM_CS); LAS float* Gl = (LAS float*)(lds + SM_G); LAS float* sqb = (LAS float*)(lds + SM_SQ);
    __syncthreads();
#define SM_LOAD_XP_ROW(dstv, pos, chn) do { if ((pos) < 3) { const float* sp_ = state_conv + ((size_t)bs * 3 + (pos)) * CONVD + (chn); const f32x4 a_ = *(const f32x4*)sp_, b_ = *(const f32x4*)(sp_ + 4); \
            dstv[0] = a_[0]; dstv[1] = a_[1]; dstv[2] = a_[2]; dstv[3] = a_[3]; dstv[4] = b_[0]; dstv[5] = b_[1]; dstv[6] = b_[2]; dstv[7] = b_[3]; } \
        else { const u32x4 q_ = *(const u32x4*)(proj + (size_t)(R0 + (pos) - 3) * NPROJ + PX + (chn)); \
            _Pragma("unroll") for (int e_ = 0; e_ < 4; ++e_) { dstv[2 * e_] = __uint_as_float(q_[e_] << 16); dstv[2 * e_ + 1] = __uint_as_float(q_[e_] & 0xffff0000u); } } } while (0)
#define SM_CONV_TASK(chn, dstp) do { const int ch_ = (chn); float r_[4][8]; \
        _Pragma("unroll") for (int k = 0; k < 4; ++k) SM_LOAD_XP_ROW(r_[k], wid + k, ch_); \
        float o_[8]; { const f32x4 a_ = *(const f32x4*)(conv_b + ch_), b_ = *(const f32x4*)(conv_b + ch_ + 4); o_[0] = a_[0]; o_[1] = a_[1]; o_[2] = a_[2]; o_[3] = a_[3]; o_[4] = b_[0]; o_[5] = b_[1]; o_[6] = b_[2]; o_[7] = b_[3]; } \
        _Pragma("unroll") for (int k = 0; k < 4; ++k) { const f32x4 a_ = *(const f32x4*)(conv_w + k * CONVD + ch_), b_ = *(const f32x4*)(conv_w + k * CONVD + ch_ + 4); \
            o_[0] += a_[0] * r_[k][0]; o_[1] += a_[1] * r_[k][1]; o_[2] += a_[2] * r_[k][2]; o_[3] += a_[3] * r_[k][3]; o_[4] += b_[0] * r_[k][4]; o_[5] += b_[1] * r_[k][5]; o_[6] += b_[2] * r_[k][6]; o_[7] += b_[3] * r_[k][7]; } \
        LAS float* d_ = (dstp); *(LAS f32x4*)d_ = (f32x4){fast_silu(o_[0]), fast_silu(o_[1]), fast_silu(o_[2]), fast_silu(o_[3])}; *(LAS f32x4*)(d_ + 4) = (f32x4){fast_silu(o_[4]), fast_silu(o_[5]), fast_silu(o_[6]), fast_silu(o_[7])}; \
        if (wid >= 5) { float* c_ = out + O_CONVS + ((size_t)bs * 3 + (wid - 5)) * CONVD + ch_; *(f32x4*)c_ = (f32x4){r_[3][0], r_[3][1], r_[3][2], r_[3][3]}; *(f32x4*)(c_ + 4) = (f32x4){r_[3][4], r_[3][5], r_[3][6], r_[3][7]}; } } while (0)
    SM_CONV_TASK(g * 512 + 8 * lane, xs + wid * 512 + 8 * lane);
    { const int cg = lane & 31;
      SM_CONV_TASK(cg < 16 ? SSDW + g * NSTATE + 8 * cg : SSDW + NGRP * NSTATE + g * NSTATE + 8 * (cg - 16), (cg < 16 ? Bs + 8 * cg : Cs + 8 * (cg - 16)) + wid * 128); }
#undef SM_CONV_TASK
#undef SM_LOAD_XP_ROW
    const float* sp = state_ssm + ((size_t)(bs * NHEAD + h) * HDIM) * NSTATE;
    f32x4 S[4][4][2];
#pragma unroll
    for (int mt = 0; mt < 4; ++mt)
#pragma unroll
        for (int ks = 0; ks < 4; ++ks) { const float* q = sp + (size_t)(16 * mt + fr) * NSTATE + 32 * ks + 8 * fq; S[mt][ks][0] = __builtin_nontemporal_load((const f32x4*)q); S[mt][ks][1] = __builtin_nontemporal_load((const f32x4*)(q + 4)); }
    const float A = -__expf(a_log[h]), Dh = d_skip[h];
    float dtv[8], ac[8];
    { float run = 0.f;
#pragma unroll
      for (int t = 0; t < 8; ++t) { dtv[t] = dt[(size_t)(R0 + t) * 16 + h]; run += dtv[t] * A; ac[t] = run; } }
    __syncthreads();
    if (tid < 64) { const int t = tid >> 3, s = tid & 7; float a = 0.f;
        for (int n = 0; n < NSTATE; n += 4) { const f32x4 cv = *(LAS f32x4*)(Cs + t * 128 + n), bv = *(LAS f32x4*)(Bs + s * 128 + n); a += (cv[0] * bv[0] + cv[1] * bv[1]) + (cv[2] * bv[2] + cv[3] * bv[3]); }
        Gl[t * 8 + s] = a; }
    __syncthreads();
    f32x4 yacc[4];
#pragma unroll
    for (int mt = 0; mt < 4; ++mt) yacc[mt] = (f32x4){0.f, 0.f, 0.f, 0.f};
    float act_ = 0.f;
#pragma unroll
    for (int t = 0; t < 8; ++t) act_ = fr == t ? ac[t] : act_;
    const float et = __expf(act_);
#pragma unroll
    for (int ks = 0; ks < 4; ++ks) {
        u32x4 cp = (u32x4){0u, 0u, 0u, 0u};
        if (fr < 8) { const f32x4 c0 = *(LAS f32x4*)(Cs + fr * 128 + 32 * ks + 8 * fq), c1 = *(LAS f32x4*)(Cs + fr * 128 + 32 * ks + 8 * fq + 4);
            cp.x = pk_bf16(c0[0] * et, c0[1] * et); cp.y = pk_bf16(c0[2] * et, c0[3] * et); cp.z = pk_bf16(c1[0] * et, c1[1] * et); cp.w = pk_bf16(c1[2] * et, c1[3] * et); }
        const bf16x8 cf = __builtin_bit_cast(bf16x8, cp);
#pragma unroll
        for (int mt = 0; mt < 4; ++mt) { u32x4 sp4; sp4.x = pk_bf16(S[mt][ks][0][0], S[mt][ks][0][1]); sp4.y = pk_bf16(S[mt][ks][0][2], S[mt][ks][0][3]); sp4.z = pk_bf16(S[mt][ks][1][0], S[mt][ks][1][1]); sp4.w = pk_bf16(S[mt][ks][1][2], S[mt][ks][1][3]);
            yacc[mt] = __builtin_amdgcn_mfma_f32_16x16x32_bf16(__builtin_bit_cast(bf16x8, sp4), cf, yacc[mt], 0, 0, 0); }
    }
    {
        u32x4 gp = (u32x4){0u, 0u, 0u, 0u};
        if (fq == 0 && fr < 8) { float gd[8];
#pragma unroll
            for (int s = 0; s < 8; ++s) gd[s] = s <= fr ? Gl[fr * 8 + s] * __expf(act_ - ac[s]) * dtv[s] : 0.f;
            gp.x = pk_bf16(gd[0], gd[1]); gp.y = pk_bf16(gd[2], gd[3]); gp.z = pk_bf16(gd[4], gd[5]); gp.w = pk_bf16(gd[6], gd[7]); }
        const bf16x8 gf = __builtin_bit_cast(bf16x8, gp);
#pragma unroll
        for (int mt = 0; mt < 4; ++mt) { u32x4 xp = (u32x4){0u, 0u, 0u, 0u};
            if (fq == 0) { const LAS float* xq = xs + wid * 64 + 16 * mt + fr;
                xp.x = pk_bf16(xq[0], xq[512]); xp.y = pk_bf16(xq[1024], xq[1536]); xp.z = pk_bf16(xq[2048], xq[2560]); xp.w = pk_bf16(xq[3072], xq[3584]); }
            yacc[mt] = __builtin_amdgcn_mfma_f32_16x16x32_bf16(__builtin_bit_cast(bf16x8, xp), gf, yacc[mt], 0, 0, 0); }
    }
    { const float dc = __expf(ac[7]);
#pragma unroll
      for (int mt = 0; mt < 4; ++mt)
#pragma unroll
          for (int ks = 0; ks < 4; ++ks) { S[mt][ks][0] = S[mt][ks][0] * dc; S[mt][ks][1] = S[mt][ks][1] * dc; }
#pragma unroll
      for (int t = 0; t < 8; ++t) { const float wt = dtv[t] * __expf(ac[7] - ac[t]);
          float xw[4];
#pragma unroll
          for (int mt = 0; mt < 4; ++mt) xw[mt] = wt * xs[t * 512 + wid * 64 + 16 * mt + fr];
#pragma unroll
          for (int ks = 0; ks < 4; ++ks) { const f32x4 b0 = *(LAS f32x4*)(Bs + t * 128 + 32 * ks + 8 * fq), b1 = *(LAS f32x4*)(Bs + t * 128 + 32 * ks + 8 * fq + 4);
#pragma unroll
              for (int mt = 0; mt < 4; ++mt) { S[mt][ks][0] = S[mt][ks][0] + b0 * xw[mt]; S[mt][ks][1] = S[mt][ks][1] + b1 * xw[mt]; } } }
      float* so = out + O_SSMS + ((size_t)(bs * NHEAD + h) * HDIM) * NSTATE;
#pragma unroll
      for (int mt = 0; mt < 4; ++mt)
#pragma unroll
          for (int ks = 0; ks < 4; ++ks) { float* q = so + (size_t)(16 * mt + fr) * NSTATE + 32 * ks + 8 * fq; __builtin_nontemporal_store(S[mt][ks][0], (f32x4*)q); __builtin_nontemporal_store(S[mt][ks][1], (f32x4*)(q + 4)); } }
    float hq[4][4]; float sq = 0.f;
    if (fr < 8) {
#pragma unroll
        for (int mt = 0; mt < 4; ++mt) { const int p0 = 16 * mt + 4 * fq;
            const u32x2 zr = *(const u32x2*)(proj + (size_t)(R0 + fr) * NPROJ + PZ + h * HDIM + p0);
            const float z[4] = {__uint_as_float(zr.x << 16), __uint_as_float(zr.x & 0xffff0000u), __uint_as_float(zr.y << 16), __uint_as_float(zr.y & 0xffff0000u)};
            const f32x4 xv = *(LAS f32x4*)(xs + fr * 512 + wid * 64 + p0);
#pragma unroll
            for (int r = 0; r < 4; ++r) { hq[mt][r] = (yacc[mt][r] + Dh * xv[r]) * fast_silu(z[r]); sq += hq[mt][r] * hq[mt][r]; } }
    }
    sq += __shfl_xor(sq, 16); sq += __shfl_xor(sq, 32);
    if (lane < 8) sqb[lane * 8 + wid] = sq;
    __syncthreads();
    if (fr < 8) { const f32x4 s0 = *(LAS f32x4*)(sqb + fr * 8), s1 = *(LAS f32x4*)(sqb + fr * 8 + 4);
        const float rs = 1.f / sqrtf(((s0[0] + s0[1]) + (s0[2] + s0[3]) + (s1[0] + s1[1]) + (s1[2] + s1[3])) * (1.f / 512.f) + LN_EPS);
#pragma unroll
        for (int mt = 0; mt < 4; ++mt) { const int ch = h * HDIM + 16 * mt + 4 * fq; const f32x4 gv = *(const f32x4*)(gw + ch);
            u32x2 o; o.x = pk_bf16(hq[mt][0] * rs * gv[0], hq[mt][1] * rs * gv[1]); o.y = pk_bf16(hq[mt][2] * rs * gv[2], hq[mt][3] * rs * gv[3]);
            *(u32x2*)(A2 + (size_t)(R0 + fr) * DM + ch) = o; } }
}

__device__ __forceinline__ void p_transpose_tile(const VB& v, bool on, const float* __restrict__ W, int K, int ld, int col0, int N, bf16* __restrict__ WT, int item) {
    LAS float* tile = v.scr;
    const int nb = N / 64, kb = item / nb, nbi = item % nb, k0 = kb * 64, n0 = nbi * 64, tid = v.vt;
    if (on) {
#pragma unroll
        for (int i = 0; i < 16; ++i) { const int kk = i * 4 + (tid >> 6), nn = tid & 63; tile[kk * 65 + nn] = W[(size_t)(k0 + kk) * ld + col0 + n0 + nn]; }
    }
    __syncthreads();
    if (on) {
#pragma unroll
        for (int i = 0; i < 16; ++i) { const int nn = i * 4 + (tid >> 6), kk = tid & 63; WT[(size_t)(n0 + nn) * K + k0 + kk] = f2bf(tile[kk * 65 + nn]); }
    }
    __syncthreads();
}
__device__ __forceinline__ void p_mod_item(const VB& v, bool on, int item, const float* __restrict__ c_prompt, const float* __restrict__ c_sample, const float* __restrict__ w_mod, const float* __restrict__ b_mod, float* __restrict__ mod) {
    LAS float* sc = v.scr;
    const int tid = v.vt, bx = item % (NMOD / 256), by = item / (NMOD / 256), n = bx * 256 + tid, r0 = by * 12;
    float acc[12];
#pragma unroll
    for (int i = 0; i < 12; ++i) acc[i] = 0.f;
    for (int k0 = 0; k0 < DM; k0 += 256) {
        __syncthreads();
        if (on) {
#pragma unroll
            for (int i = 0; i < 12; ++i) { const int r = r0 + i; const float* c = r < NPB ? c_prompt + (size_t)r * DM : c_sample + (size_t)(r - NPB) * DM; sc[i * 256 + tid] = silu_f(c[k0 + tid]); }
        }
        __syncthreads();
        if (on) {
            for (int kk = 0; kk < 256; ++kk) { const float w = w_mod[(size_t)(k0 + kk) * NMOD + n];
#pragma unroll
                for (int i = 0; i < 12; ++i) acc[i] += sc[i * 256 + kk] * w; }
        }
    }
    if (on) { const float bb = b_mod[n];
#pragma unroll
        for (int i = 0; i < 12; ++i) mod[(size_t)(r0 + i) * NMOD + n] = acc[i] + bb; }
}
__device__ __forceinline__ void p_ln_h1_row(const VB& vb, int r, const float* __restrict__ x_prompt, const float* __restrict__ x_sample, const float* __restrict__ g, const float* __restrict__ b,
                                            const float* __restrict__ mod, float* __restrict__ stats, bf16* __restrict__ h1) {
    const int tid = vb.vt;
    const float* xr = r < MP ? x_prompt + (size_t)r * DM : x_sample + (size_t)(r - MP) * DM;
    float v[8];
    { const f32x4 a = *(const f32x4*)(xr + tid * 4), c = *(const f32x4*)(xr + 1024 + tid * 4); v[0] = a[0]; v[1] = a[1]; v[2] = a[2]; v[3] = a[3]; v[4] = c[0]; v[5] = c[1]; v[6] = c[2]; v[7] = c[3]; }
    float s = 0.f;
#pragma unroll
    for (int j = 0; j < 8; ++j) s += v[j];
    const float mean = vb_sum(s, vb.scr, tid) * (1.f / DM);
    float q = 0.f;
#pragma unroll
    for (int j = 0; j < 8; ++j) { const float d = v[j] - mean; q += d * d; }
    const float rstd = 1.f / sqrtf(vb_sum(q, vb.scr, tid) * (1.f / DM) + LN_EPS);
    if (tid == 0) { stats[2 * r] = mean; stats[2 * r + 1] = rstd; }
    const float* mr = mod + (size_t)modrow(r) * NMOD;
#pragma unroll
    for (int j = 0; j < 8; ++j) { const int c = (j < 4 ? 0 : 1024) + tid * 4 + (j & 3);
        const float xn = (v[j] - mean) * rstd * g[c] + b[c];
        h1[(size_t)r * DM + c] = f2bf(xn * (1.f + mr[DM + c]) + mr[c]); }
}
__device__ __forceinline__ void p_dt_item(int vt, int item, const bf16* __restrict__ h1, const float* __restrict__ wdt, const float* __restrict__ dt_bias, float* __restrict__ dt) {
    const int r = item * 16 + (vt >> 4), h = vt & 15;
    const bf16* hr = h1 + (size_t)r * DM; const float* w = wdt + (size_t)h * DM;
    float a = 0.f;
    for (int k = 0; k < DM; ++k) a += bf2f(hr[k]) * w[k];
    dt[r * 16 + h] = softplus_f(a + dt_bias[h]);
}
__device__ __forceinline__ void p_conv_item(int vt, int item, const bf16* __restrict__ proj, const float* __restrict__ state_conv, const float* __restrict__ conv_w, const float* __restrict__ conv_b,
                                            float* __restrict__ act, float* __restrict__ out) {
    const int r = item / 6, c = (item % 6) * 256 + vt;
    int t, rowbase; const float* sc = nullptr;
    if (r < MP) { t = r & (SEQ - 1); rowbase = r - t; } else { const int bs = (r - MP) >> 3; t = (r - MP) & 7; rowbase = r - t; sc = state_conv + (size_t)bs * 3 * CONVD; }
    float a = conv_b[c];
#pragma unroll
    for (int k = 0; k < 4; ++k) { const int tp = t - 3 + k; float xv;
        if (tp >= 0) xv = bf2f(proj[(size_t)(rowbase + tp) * NPROJ + PX + c]); else xv = sc ? sc[(size_t)(tp + 3) * CONVD + c] : 0.f;
        a += conv_w[k * CONVD + c] * xv; }
    act[(size_t)r * CONVD + c] = silu_f(a);
    const float pre = bf2f(proj[(size_t)r * NPROJ + PX + c]);
    if (r < MP) { if (t >= SEQ - 3) out[O_CONVP + ((size_t)(r >> 11) * 3 + (t - (SEQ - 3))) * CONVD + c] = pre; }
    else { if (t >= DSEQ - 3) out[O_CONVS + ((size_t)((r - MP) >> 3) * 3 + (t - (DSEQ - 3))) * CONVD + c] = pre; }
}
__device__ __forceinline__ void p_ssd_seq_item(int tid, int item, const float* __restrict__ act, const float* __restrict__ dt, const float* __restrict__ a_log, const float* __restrict__ d_skip,
                                               const float* __restrict__ state_ssm, float* __restrict__ y, float* __restrict__ out) {
    const int seq = item >> 4, h = item & 15, p = tid >> 2, q = tid & 3, g = h >> 3;
    const float A = -expf(a_log[h]), D = d_skip[h];
    int row0, L; float* sout;
    float S[32];
    if (seq < NPB) { row0 = seq * SEQ; L = SEQ; sout = out + O_SSMP + ((size_t)(seq * NHEAD + h) * HDIM + p) * NSTATE + q * 32;
#pragma unroll
        for (int n = 0; n < 32; ++n) S[n] = 0.f; }
    else { const int bs = seq - NPB; row0 = MP + bs * DSEQ; L = DSEQ; sout = out + O_SSMS + ((size_t)(bs * NHEAD + h) * HDIM + p) * NSTATE + q * 32;
        const float* s0 = state_ssm + ((size_t)(bs * NHEAD + h) * HDIM + p) * NSTATE + q * 32;
#pragma unroll
        for (int n = 0; n < 32; ++n) S[n] = s0[n]; }
    for (int t = 0; t < L; ++t) {
        const int r = row0 + t; const float* ar = act + (size_t)r * CONVD;
        const float dtv = dt[r * 16 + h], dA = expf(dtv * A), xv = ar[h * HDIM + p], xd = dtv * xv;
        const float* Bp = ar + SSDW + g * NSTATE + q * 32; const float* Cp = ar + SSDW + NGRP * NSTATE + g * NSTATE + q * 32;
        float part = 0.f;
#pragma unroll
        for (int n = 0; n < 32; ++n) { S[n] = dA * S[n] + xd * Bp[n]; part += S[n] * Cp[n]; }
        part += __shfl_xor(part, 1); part += __shfl_xor(part, 2);
        if (q == 0) y[(size_t)r * SSDW + h * HDIM + p] = part + D * xv;
    }
#pragma unroll
    for (int n = 0; n < 32; ++n) sout[n] = S[n];
}
__device__ __forceinline__ void p_gated_norm_row(const VB& vb, int r, const float* __restrict__ y, const bf16* __restrict__ proj, const float* __restrict__ gw, bf16* __restrict__ A2) {
    LAS float* red = vb.scr; const int tid = vb.vt, c0 = tid * 4;
    float hv[4]; float q = 0.f;
#pragma unroll
    for (int j = 0; j < 4; ++j) { const float z = bf2f(proj[(size_t)r * NPROJ + PZ + c0 + j]); hv[j] = y[(size_t)r * SSDW + c0 + j] * silu_f(z); q += hv[j] * hv[j]; }
    q = wave_sum(q);
    __syncthreads();
    if ((tid & 63) == 0) red[tid >> 6] = q;
    __syncthreads();
    const float ms = (tid < 128 ? red[0] + red[1] : red[2] + red[3]) * (1.f / 512.f);
    const float rs = 1.f / sqrtf(ms + LN_EPS);
#pragma unroll
    for (int j = 0; j < 4; ++j) A2[(size_t)r * DM + c0 + j] = f2bf(hv[j] * rs * gw[c0 + j]);
}
__device__ __forceinline__ void p_vn_row(const VB& vb, int r, const bf16* __restrict__ proj, const float* __restrict__ g, const float* __restrict__ b, float* __restrict__ vn, float* __restrict__ out) {
    const int tid = vb.vt, c0 = tid * 4;
    float v[4]; float s = 0.f;
#pragma unroll
    for (int j = 0; j < 4; ++j) { v[j] = gelu_f(bf2f(proj[(size_t)r * NPROJ + PV + c0 + j])); s += v[j]; }
    const float mean = vb_sum(s, vb.scr, tid) * (1.f / GMW);
    float q = 0.f;
#pragma unroll
    for (int j = 0; j < 4; ++j) { const float d = v[j] - mean; q += d * d; }
    const float rstd = 1.f / sqrtf(vb_sum(q, vb.scr, tid) * (1.f / GMW) + LN_EPS);
#pragma unroll
    for (int j = 0; j < 4; ++j) { const float o = (v[j] - mean) * rstd * g[c0 + j] + b[c0 + j]; vn[(size_t)r * GMW + c0 + j] = o; if (r >= MP) out[O_CV + (size_t)(r - MP) * GMW + c0 + j] = o; }
}
__device__ __forceinline__ void p_gmlp_mix_row(int tid, int r, const bf16* __restrict__ proj, const float* __restrict__ vn, const float* __restrict__ w_s, const float* __restrict__ b_s, bf16* __restrict__ A2) {
    const int c0 = tid * 4, hd = c0 >> 7;
    const int i = r < MP ? (r & 127) : ((r - MP) & 7), base = r - i;
    const float* wrow = w_s + ((size_t)hd * 128 + i) * 128;
    float a[4] = {0.f, 0.f, 0.f, 0.f};
    for (int j = 0; j <= i; ++j) { const float w = wrow[j]; const f32x4 vv = *(const f32x4*)(vn + (size_t)(base + j) * GMW + c0);
#pragma unroll
        for (int e = 0; e < 4; ++e) a[e] += w * vv[e]; }
    const float bs = b_s[hd * 128 + i];
#pragma unroll
    for (int e = 0; e < 4; ++e) { const float u = gelu_f(bf2f(proj[(size_t)r * NPROJ + PU + c0 + e])); A2[(size_t)r * DM + SSDW + c0 + e] = f2bf(u * (a[e] + bs)); }
}
__device__ __forceinline__ void p_ln_mix_row(const VB& vb, int r, const float* __restrict__ x_prompt, const float* __restrict__ x_sample, const float* __restrict__ stats, const float* __restrict__ lg, const float* __restrict__ lb,
                                             const float* __restrict__ mod, const float* __restrict__ mix, const float* __restrict__ g2, const float* __restrict__ b2, float* __restrict__ x1, bf16* __restrict__ h2) {
    const int tid = vb.vt;
    const float* xr = r < MP ? x_prompt + (size_t)r * DM : x_sample + (size_t)(r - MP) * DM;
    const float mean0 = stats[2 * r], rstd0 = stats[2 * r + 1];
    const float* mr = mod + (size_t)modrow(r) * NMOD;
    float v[8]; float s = 0.f;
#pragma unroll
    for (int j = 0; j < 8; ++j) { const int c = (j < 4 ? 0 : 1024) + tid * 4 + (j & 3);
        const float xn = (xr[c] - mean0) * rstd0 * lg[c] + lb[c];
        v[j] = ALPHA * xn + (1.f + mr[2 * DM + c]) * mix[(size_t)r * DM + c]; s += v[j]; }
    const float mean = vb_sum(s, vb.scr, tid) * (1.f / DM);
    float q = 0.f;
#pragma unroll
    for (int j = 0; j < 8; ++j) { const float d = v[j] - mean; q += d * d; }
    const float rstd = 1.f / sqrtf(vb_sum(q, vb.scr, tid) * (1.f / DM) + LN_EPS);
#pragma unroll
    for (int j = 0; j < 8; ++j) { const int c = (j < 4 ? 0 : 1024) + tid * 4 + (j & 3);
        const float o = (v[j] - mean) * rstd * g2[c] + b2[c];
        x1[(size_t)r * DM + c] = o;
        h2[(size_t)r * DM + c] = f2bf(o * (1.f + mr[4 * DM + c]) + mr[3 * DM + c]); }
}
__device__ __forceinline__ void p_ln_out_row(const VB& vb, int r, const float* __restrict__ mod, const float* __restrict__ f, const float* __restrict__ g3, const float* __restrict__ b3, float* __restrict__ xy) {
    const int tid = vb.vt;
    const float* mr = mod + (size_t)modrow(r) * NMOD;
    float v[8]; float s = 0.f;
#pragma unroll
    for (int j = 0; j < 8; ++j) { const int c = (j < 4 ? 0 : 1024) + tid * 4 + (j & 3);
        v[j] = ALPHA * xy[(size_t)r * DM + c] + (1.f + mr[5 * DM + c]) * f[(size_t)r * DM + c]; s += v[j]; }
    const float mean = vb_sum(s, vb.scr, tid) * (1.f / DM);
    float q = 0.f;
#pragma unroll
    for (int j = 0; j < 8; ++j) { const float d = v[j] - mean; q += d * d; }
    const float rstd = 1.f / sqrtf(vb_sum(q, vb.scr, tid) * (1.f / DM) + LN_EPS);
#pragma unroll
    for (int j = 0; j < 8; ++j) { const int c = (j < 4 ? 0 : 1024) + tid * 4 + (j & 3); xy[(size_t)r * DM + c] = (v[j] - mean) * rstd * g3[c] + b3[c]; }
}

__global__ void __launch_bounds__(NWAVES * 64, 2) mega_fwd(Args args) {
    extern __shared__ __attribute__((aligned(16))) unsigned char lds_raw[];
    LAS unsigned char* lds = (LAS unsigned char*)lds_raw;
    volatile LAS unsigned* MISC = (volatile LAS unsigned*)(lds + MISC_OFF);
    const int tid = threadIdx.x, G = gridDim.x;
    for (int u = tid; u < (LDS_BYTES - LDSCTL_OFF) / 4; u += NWAVES * 64) ((LAS unsigned*)(lds + LDSCTL_OFF))[u] = 0u;
    __syncthreads();
    unsigned char* ws = args.ws;
    XcdBarrier bar = xcd_barrier_post((unsigned*)(ws + WS_CTL) + CW_BAR, MISC + 8);
    unsigned* ctlw = (unsigned*)(ws + WS_CTL);

    const float* x_prompt = args.in[0]; const float* x_sample = args.in[1]; const float* state_ssm = args.in[2]; const float* state_conv = args.in[3];
    const float* c_prompt = args.in[4]; const float* c_sample = args.in[5]; const float* ln_in_g = args.in[6]; const float* ln_in_b = args.in[7];
    const float* w_mod = args.in[8]; const float* b_mod = args.in[9]; const float* w_in = args.in[10]; const float* conv_w = args.in[11];
    const float* conv_b = args.in[12]; const float* dt_bias = args.in[13]; const float* a_log = args.in[14]; const float* d_skip = args.in[15];
    const float* ssd_norm_g = args.in[16]; const float* gm_ln_g = args.in[17]; const float* gm_ln_b = args.in[18]; const float* gm_w_s = args.in[19];
    const float* gm_b_s = args.in[20]; const float* w_out = args.in[21]; const float* ln_mix_g = args.in[22]; const float* ln_mix_b = args.in[23];
    const float* w_ff1 = args.in[24]; const float* w_ff2 = args.in[25]; const float* ln_ffn_g = args.in[26]; const float* ln_ffn_b = args.in[27];
    float* out = args.out;
    bf16* Wt_in = (bf16*)(ws + WS_WIN); bf16* Wt_out = (bf16*)(ws + WS_WOUT); bf16* Wt_ff1 = (bf16*)(ws + WS_WFF1); bf16* Wt_ff2 = (bf16*)(ws + WS_WFF2);
    float* mod = (float*)(ws + WS_MOD); float* stats = (float*)(ws + WS_STATS); float* vstats = (float*)(ws + WS_STATS + 512 * 1024); float* dt = (float*)(ws + WS_DT);
    bf16* hbuf = (bf16*)(ws + WS_H); bf16* proj = (bf16*)(ws + WS_BIG); float* act = (float*)(ws + WS_ACT); bf16* hid = (bf16*)(ws + WS_BIG);
    bf16* mixb = (bf16*)(ws + WS_E); bf16* csilu = (bf16*)(ws + WS_STATS + 256 * 1024); bf16* slab1 = (bf16*)(ws + WS_BIG); bf16* slab2 = (bf16*)(ws + WS_SLAB2); bf16* xsb = (bf16*)(ws + WS_SLAB2);   float* ybuf = (float*)(ws + WS_E); bf16* cs = (bf16*)(ws + WS_E); float* cd = (float*)(ws + WS_CD); bf16* s_in = (bf16*)(ws + WS_SIN); float* vn = (float*)(ws + WS_VN); float* mix = (float*)(ws + WS_E); float* fbuf = (float*)(ws + WS_E);

    #define MAKE_VB() VB vb; { int t_ = threadIdx.x; asm volatile("" : "+v"(t_)); const int half_ = __builtin_amdgcn_readfirstlane(t_ >> 8); vb.vt = t_ & 255; vb.id = (int)blockIdx.x * 2 + half_; vb.n = 2 * (int)gridDim.x; vb.scr = (LAS float*)(lds + half_ * 32768); }

    { int t_ = threadIdx.x; asm volatile("" : "+v"(t_)); const int lane = t_ & 63, wv = __builtin_amdgcn_readfirstlane(t_ >> 6), gw = (int)blockIdx.x * NWAVES + wv, NGW = G * NWAVES;
      for (int i = (int)blockIdx.x * 512 + t_; i < NSEQ * DM / 4; i += G * 512) { const int r = i / (DM / 4), k4 = i % (DM / 4);
          const f32x4 cv = *(const f32x4*)((r < NPB ? c_prompt + (size_t)r * DM : c_sample + (size_t)(r - NPB) * DM) + 4 * k4);
          u32x2 w; w.x = pk_bf16(fast_silu(cv[0]), fast_silu(cv[1])); w.y = pk_bf16(fast_silu(cv[2]), fast_silu(cv[3])); *(u32x2*)(csilu + (size_t)r * DM + 4 * k4) = w; }
      asm volatile("s_waitcnt vmcnt(0)" ::: "memory");
      __syncthreads();
      if (t_ == 0) { __builtin_amdgcn_fence(__ATOMIC_RELEASE, "agent"); asm volatile("s_waitcnt vmcnt(0)" ::: "memory"); (void)xb_add(ctlw + CW_CSILU, 1u); }
      LAS float* scr = (LAS float*)(lds + wv * 8448);
      constexpr int I1 = 32 * 80, I2 = 32 * 64, I3 = 32 * 64, I4 = 32 * 256, I5 = 128 * 64;
      const int IT = (G == 256) ? I1 + I2 : I1 + I2 + I3 + I4 + I5;
      for (int it = gw; it < IT; it += NGW) { int r = it;
          if (r < I1) { p0_transpose_item(w_in, DM, DINP, 80, Wt_in, scr, r, lane); continue; } r -= I1;
          if (r < I2) { p0_transpose_item(w_in + 2576, DM, DINP, 64, Wt_in + (size_t)2560 * DM, scr, r, lane); continue; } r -= I2;
          if (r < I3) { p0_transpose_item(w_out, DM, DM, 64, Wt_out, scr, r, lane); continue; } r -= I3;
          if (r < I4) { p0_transpose_item(w_ff1, DM, DFF, 256, Wt_ff1, scr, r, lane); continue; } r -= I4;
          p0_transpose_item(w_ff2, DFF, DM, 64, Wt_ff2, scr, r, lane); }
      for (int i = (int)blockIdx.x * 512 + t_; i < 256 * DM; i += G * 512) { const int h = i / DM, k = i % DM; Wt_in[(size_t)(NPROJ + h) * DM + k] = h < 16 ? f2bf(w_in[(size_t)k * DINP + 2560 + h]) : (bf16)0; }
    }
    { int t_ = threadIdx.x; asm volatile("" : "+v"(t_));
      if (t_ == 0) { unsigned* tmo = ctlw + CW_BAR; XB_SPIN(xb_ld(ctlw + CW_CSILU) < (unsigned)G, tmo); __builtin_amdgcn_fence(__ATOMIC_ACQUIRE, "agent"); asm volatile("s_waitcnt vmcnt(0)" ::: "memory"); }
      __syncthreads(); }
    if (G == 256) mod_item(lds, ((int)blockIdx.x & 7) * 32 + ((int)blockIdx.x >> 3), csilu, w_mod, b_mod, mod);
    else for (int it = blockIdx.x; it < NMOD / 48; it += G) mod_item(lds, it, csilu, w_mod, b_mod, mod);
    xcd_barrier(bar);
    { int t_ = threadIdx.x; asm volatile("" : "+v"(t_)); const int lane = t_ & 63, gw = (int)blockIdx.x * NWAVES + __builtin_amdgcn_readfirstlane(t_ >> 6), NGW = G * NWAVES;
      LAS float* UV = (LAS float*)lds;
      __syncthreads();
      for (int i = t_; i < NPB * DM; i += NWAVES * 64) { const int bb = i / DM, c = i % DM; const float* mr = mod + (size_t)bb * NMOD; const float sc1 = 1.f + mr[DM + c];
          UV[bb * 2 * DM + c] = ln_in_g[c] * sc1; UV[bb * 2 * DM + DM + c] = ln_in_b[c] * sc1 + mr[c]; }
      __syncthreads();
      const int rs_odd = gw & 1, rs_j = gw >> 1, rs_n = (G == 256) ? (rs_odd ? 5 : 4) : (MROWS - gw + NGW - 1) / NGW;
#pragma unroll 1
      for (int rs_k = 0; rs_k < rs_n; ++rs_k) { const int r = (G != 256) ? gw + rs_k * NGW : rs_odd ? 3072 + rs_j + 1024 * rs_k : (rs_k == 0 ? MP + rs_j : rs_j + 1024 * (rs_k - 1));
          if (r < MP) w_ln_h1_lds(r, lane, x_prompt + (size_t)r * DM, UV + (r >> 11) * 2 * DM, stats, hbuf);
          else w_ln_h1_row(r, lane, x_prompt, x_sample, ln_in_g, ln_in_b, mod, stats, hbuf, nullptr); } }
    xcd_barrier(bar);
    { pg8::Gemm g{hbuf, Wt_in, MROWS, NPROJ + 256, DM, 0}; pg8::StaticOrder S; S.init(MROWS, NPROJ + 256, G, (int)blockIdx.x, DM); pg8::EpiProj E{proj, dt, dt_bias};
      pg8::gemm_phase<pg8::EpiProj, pg8::StaticOrder, true, true>(lds, g, S, E); }
    if (G == 256 && blockIdx.x >= 172) {
        int t_ = threadIdx.x; asm volatile("" : "+v"(t_)); const int lane = t_ & 63, wv = __builtin_amdgcn_readfirstlane(t_ >> 6); LAS float* scr = (LAS float*)(lds + wv * 8448);
        for (int it = ((int)blockIdx.x - 172) * NWAVES + wv; it < 32 * 256 + 32 * 64; it += 84 * NWAVES) {
            if (it < 32 * 256) p0_transpose_item(w_ff1, DM, DFF, 256, Wt_ff1, scr, it, lane); else p0_transpose_item(w_out, DM, DM, 64, Wt_out, scr, it - 32 * 256, lane); } }
    xcd_barrier(bar);
    { const bool sample_first = (((int)blockIdx.x >> 3) & 1) != 0;
#pragma unroll 1
      for (int step = 0; step < 3; ++step) {
        const int what = (step == 1) ? 0 : (((step == 0) == sample_first) ? 1 : 2);
        if (what == 0) {
    { MAKE_VB();
    for (int i = vb.id * 256 + vb.vt; i < NPB * 3 * CONVD; i += vb.n * 256) { const int bb = i / (3 * CONVD), jj = (i / CONVD) % 3, cc = i % CONVD; out[O_CONVP + i] = bf2f(proj[(size_t)(bb * SEQ + SEQ - 3 + jj) * NPROJ + PX + cc]); }
    }
    { int t_ = threadIdx.x; asm volatile("" : "+v"(t_)); const int lane = t_ & 63, gw = (int)blockIdx.x * NWAVES + __builtin_amdgcn_readfirstlane(t_ >> 6), NGW = G * NWAVES;
      for (int r = gw; r < MROWS; r += NGW) w_gmlp_ln_row(r, lane, proj, gm_ln_g, gm_ln_b, out); }
        } else if (what == 1) { for (int it = blockIdx.x; it < NSB * NGRP; it += G) sample_ssd_item(lds, it, proj, dt, state_conv, conv_w, conv_b, a_log, d_skip, ssd_norm_g, state_ssm, hbuf, out); }
        else { for (int it = blockIdx.x; it < NPB * 16 * NGRP * 2; it += G) ssd_phaseA_item(lds, it, proj, dt, conv_w, conv_b, a_log, cs, cd, xsb); }
      } }
    xcd_barrier(bar);
    { MAKE_VB();
    if ((int)threadIdx.x < 256)
    for (int e = (int)blockIdx.x * 256 + (int)threadIdx.x; e < NPB * NHEAD * HDIM * NSTATE / 8; e += G * 256) {
        const int bh = e / (HDIM * NSTATE / 8), rem = e % (HDIM * NSTATE / 8), bb = bh >> 4, hh = bh & 15;
        u32x4 cv[16]; float dc[16];
#pragma unroll
        for (int cc = 0; cc < 16; ++cc) { cv[cc] = __builtin_nontemporal_load((const u32x4*)(cs + ((size_t)((bb * 16 + cc) * 16 + hh) * (HDIM * NSTATE / 8) + rem) * 8)); dc[cc] = cd[(bb * 16 + cc) * 16 + hh]; }
        float sv[8];
#pragma unroll
        for (int k = 0; k < 8; ++k) sv[k] = 0.f;
#pragma unroll
        for (int cc = 0; cc < 16; ++cc) {
            u32x4 w; w.x = pk_bf16(sv[0], sv[1]); w.y = pk_bf16(sv[2], sv[3]); w.z = pk_bf16(sv[4], sv[5]); w.w = pk_bf16(sv[6], sv[7]);
            *(u32x4*)(s_in + ((size_t)((bb * 16 + cc) * 16 + hh) * (HDIM * NSTATE / 8) + rem) * 8) = w;
#pragma unroll
            for (int k = 0; k < 4; ++k) { sv[2 * k] = sv[2 * k] * dc[cc] + __uint_as_float(cv[cc][k] << 16); sv[2 * k + 1] = sv[2 * k + 1] * dc[cc] + __uint_as_float(cv[cc][k] & 0xffff0000u); } }
        *(f32x4*)(out + O_SSMP + (size_t)e * 8) = (f32x4){sv[0], sv[1], sv[2], sv[3]}; *(f32x4*)(out + O_SSMP + (size_t)e * 8 + 4) = (f32x4){sv[4], sv[5], sv[6], sv[7]}; }
    }
    xcd_barrier(bar);
    { MAKE_VB();
    }
    if (G == 256) {
        const int bx = (int)blockIdx.x, rh = (bx >> 3) & 1, w = (bx & 7) + 8 * (bx >> 4);
        ssd_phaseC_half(lds, 2 * w + rh, proj, dt, conv_w, conv_b, a_log, d_skip, ssd_norm_g, s_in, xsb, hbuf);
        if (rh == 0) gmlp_group(lds, w & 7, w >> 3, 16, 3, proj, gm_w_s, gm_b_s, hbuf);
        else { gmlp_group(lds, w & 7, 48 + (w >> 3), 0, 1, proj, gm_w_s, gm_b_s, hbuf); gmlp_sample_item(w, proj, out + O_CV, gm_w_s, gm_b_s, hbuf); }
    } else {
        for (int it = blockIdx.x; it < NPB * 16 * NGRP * 2; it += G) ssd_phaseC_half(lds, it, proj, dt, conv_w, conv_b, a_log, d_skip, ssd_norm_g, s_in, xsb, hbuf);
        for (int it = blockIdx.x; it < NPB * 16 * GMNH; it += G) gmlp_group(lds, it & 7, it >> 3, 0, 1, proj, gm_w_s, gm_b_s, hbuf);
        for (int bs = blockIdx.x; bs < NSB; bs += G) gmlp_sample_item(bs, proj, out + O_CV, gm_w_s, gm_b_s, hbuf);
    }
    xcd_barrier(bar);
    { pg8::Gemm g{hbuf, Wt_out, MROWS, DM, DM, 0}; pg8::EpiBf16S E{mixb, slab1, DM, 0};
      if (G == 256) { pg8::SplitOrder S; S.init((int)blockIdx.x, DM); pg8::gemm_phase<pg8::EpiBf16S, pg8::SplitOrder, true, true>(lds, g, S, E); }
      else { pg8::StaticOrder S; S.init(MROWS, DM, G, (int)blockIdx.x, DM); pg8::gemm_phase<pg8::EpiBf16S, pg8::StaticOrder, true, true>(lds, g, S, E); } }
    xcd_barrier(bar);
    { int t_ = threadIdx.x; asm volatile("" : "+v"(t_)); const int lane = t_ & 63, gw = (int)blockIdx.x * NWAVES + __builtin_amdgcn_readfirstlane(t_ >> 6), NGW = G * NWAVES;
      LAS float* Cc = (LAS float*)lds; LAS float* Bt = Cc + 4 * DM;
      __syncthreads();
      for (int c = t_; c < DM; c += NWAVES * 64) { Cc[c] = ALPHA * ln_in_g[c]; Cc[DM + c] = ALPHA * ln_in_b[c]; Cc[2 * DM + c] = ln_mix_g[c]; Cc[3 * DM + c] = ln_mix_b[c]; }
      for (int i = t_; i < NPB * DM; i += NWAVES * 64) { const int bb = i / DM, c = i % DM; const float* mr = mod + (size_t)bb * NMOD; const float sc1 = 1.f + mr[4 * DM + c];
          Bt[bb * 3 * DM + c] = 1.f + mr[2 * DM + c]; Bt[bb * 3 * DM + DM + c] = ln_mix_g[c] * sc1; Bt[bb * 3 * DM + 2 * DM + c] = ln_mix_b[c] * sc1 + mr[3 * DM + c]; }
      __syncthreads();
      const int rs_odd = gw & 1, rs_j = gw >> 1, rs_n = (G == 256) ? (rs_odd ? 5 : 4) : (MROWS - gw + NGW - 1) / NGW;
#pragma unroll 1
      for (int rs_k = 0; rs_k < rs_n; ++rs_k) { const int r = (G != 256) ? gw + rs_k * NGW : rs_odd ? 3072 + rs_j + 1024 * rs_k : (rs_k == 0 ? MP + rs_j : rs_j + 1024 * (rs_k - 1));
          if (r < MP) w_ln_mix3_lds(r, lane, x_prompt + (size_t)r * DM, mixb + (size_t)r * DM, stats, Cc, Bt + (r >> 11) * 3 * DM, (bf16*)(out + O_YP) + (size_t)r * 2 * DM, hbuf + (size_t)r * DM);
          else w_ln_mix3_row(r, lane, x_prompt, x_sample, stats, ln_in_g, ln_in_b, mod, mixb, G == 256 ? slab1 : nullptr, ln_mix_g, ln_mix_b, (bf16*)(out + O_YP), 2 * DM, hbuf); } }
    xcd_barrier(bar);
    { pg8::Gemm g{hbuf, Wt_ff1, MROWS, DFF, DM, 0}; pg8::StaticOrder S; S.init(MROWS, DFF, G, (int)blockIdx.x, DM); pg8::EpiBf16P<2> E{hid, DFF, 0};
      pg8::gemm_phase<pg8::EpiBf16P<2>, pg8::StaticOrder, true, true>(lds, g, S, E); }
    if (G == 256 && blockIdx.x >= 128) {
        int t_ = threadIdx.x; asm volatile("" : "+v"(t_)); const int lane = t_ & 63, wv = __builtin_amdgcn_readfirstlane(t_ >> 6); LAS float* scr = (LAS float*)(lds + wv * 8448);
        for (int it = ((int)blockIdx.x - 128) * NWAVES + wv; it < 128 * 64; it += 128 * NWAVES) p0_transpose_item(w_ff2, DFF, DM, 64, Wt_ff2, scr, it, lane); }
    xcd_barrier(bar);
    { pg8::Gemm g{hid, Wt_ff2, MROWS, DM, DFF, 0}; pg8::EpiBf16S E{mixb, slab2, DM, 0};
      if (G == 256) { pg8::SplitOrder S; S.init((int)blockIdx.x, DFF); pg8::gemm_phase<pg8::EpiBf16S, pg8::SplitOrder, true, true>(lds, g, S, E); }
      else { pg8::StaticOrder S; S.init(MROWS, DM, G, (int)blockIdx.x, DFF); pg8::gemm_phase<pg8::EpiBf16S, pg8::StaticOrder, true, true>(lds, g, S, E); } }
    xcd_barrier(bar);
    { int t_ = threadIdx.x; asm volatile("" : "+v"(t_)); const int lane = t_ & 63, gw = (int)blockIdx.x * NWAVES + __builtin_amdgcn_readfirstlane(t_ >> 6), NGW = G * NWAVES;
      LAS float* Cc = (LAS float*)lds; LAS float* GF = Cc + 2 * DM;
      __syncthreads();
      for (int c = t_; c < DM; c += NWAVES * 64) { Cc[c] = ln_ffn_g[c]; Cc[DM + c] = ln_ffn_b[c]; }
      for (int i = t_; i < NPB * DM; i += NWAVES * 64) { const int bb = i / DM, c = i % DM; GF[i] = 1.f + mod[(size_t)bb * NMOD + 5 * DM + c]; }
      __syncthreads();
      const int rs_odd = gw & 1, rs_j = gw >> 1, rs_n = (G == 256) ? (rs_odd ? 5 : 4) : (MROWS - gw + NGW - 1) / NGW;
#pragma unroll 1
      for (int rs_k = 0; rs_k < rs_n; ++rs_k) { const int r = (G != 256) ? gw + rs_k * NGW : rs_odd ? 3072 + rs_j + 1024 * rs_k : (rs_k == 0 ? MP + rs_j : rs_j + 1024 * (rs_k - 1));
          if (r < MP) w_ln_out3_lds(r, lane, (const bf16*)(out + O_YP) + (size_t)r * 2 * DM, mixb + (size_t)r * DM, Cc, GF + (r >> 11) * DM, out + O_YP + (size_t)r * DM, GF + NPB * DM + (gw & 7) * DM);
          else w_ln_out3_row(r, lane, mod, (const bf16*)(out + O_YP), 2 * DM, mixb, G == 256 ? slab2 : nullptr, ln_ffn_g, ln_ffn_b, out + O_YP); } }
}

extern "C" void kernel_launch(void* const* d_in, const int* in_sizes, int n_in, void* d_out, int out_size, void* d_ws, size_t ws_size, hipStream_t stream) {
    static int grid = 0;
    if (grid == 0) {
        if (n_in != 28 || ws_size < WS_END) { fprintf(stderr, "kernel_launch: unexpected n_in %d / ws_size %zu\n", n_in, ws_size); grid = -1; return; }
        int dev = 0, cus = 0;
        if (hipGetDevice(&dev) != hipSuccess || hipDeviceGetAttribute(&cus, hipDeviceAttributeMultiprocessorCount, dev) != hipSuccess) { grid = -1; return; }
        if (hipFuncSetAttribute((const void*)mega_fwd, hipFuncAttributeMaxDynamicSharedMemorySize, LDS_BYTES) != hipSuccess) { fprintf(stderr, "kernel_launch: hipFuncSetAttribute failed\n"); grid = -1; return; }
        int per_cu = 0; (void)hipOccupancyMaxActiveBlocksPerMultiprocessor(&per_cu, (const void*)mega_fwd, NWAVES * 64, LDS_BYTES); (void)hipGetLastError();
        if (per_cu < 1) fprintf(stderr, "kernel_launch: occupancy query reports %d blocks per CU\n", per_cu);
        grid = cus;
    }
    if (grid < 0) return;
    (void)hipMemsetAsync((char*)d_ws + WS_CTL, 0, CTL_ZERO_BYTES, stream);
    Args a{};
    for (int i = 0; i < 28; ++i) a.in[i] = (const float*)d_in[i];
    a.out = (float*)d_out; a.ws = (unsigned char*)d_ws;
    hipLaunchKernelGGL(mega_fwd, dim3(grid), dim3(NWAVES * 64), LDS_BYTES, stream, a);
}
```

```cpp
#include <hip/hip_runtime.h>
#include <cstdio>
#include <cstdint>
namespace pg8 {
#define PG8_LAS __attribute__((address_space(3)))
typedef unsigned short bf16_t;
typedef short bf16x8 __attribute__((ext_vector_type(8)));
typedef float f32x4 __attribute__((ext_vector_type(4)));
typedef unsigned u32x4 __attribute__((ext_vector_type(4)));
constexpr int BM = 256, BK = 64, HALF = 128, HTB = HALF * BK * 2  , STAGE_BYTES = 8 * HTB, NXCD = 8, WGM = 8;

__host__ __device__ __forceinline__ int lds_byte(int r, int c) { const int st = (r >> 4) * 2 + (c >> 5), rr = r & 15, cc = c & 31, ob = rr * 64 + cc * 2; return st * 1024 + (ob ^ (((ob >> 9) & 1) << 5)); }
__host__ __device__ __forceinline__ void stage_rc(int b, int& R, int& C) { const int st = b / 1024, sb = b % 1024, swz = sb ^ (((sb >> 9) & 1) << 5); R = (st >> 1) * 16 + swz / 64; C = (st & 1) * 32 + (swz % 64) / 2; }
__host__ __device__ __forceinline__ int perm32(int rho) { const int n = rho >> 4, i = rho & 15; return 8 * (i >> 2) + 4 * n + (i & 3); }

struct Unit { int pm, pn, kt0, nkt, slab; };
struct Gemm { const bf16_t* A; const bf16_t* Bt; int M, N, K, pad; };

struct StaticOrder {
    int nM, nN, nwg, G, c, nktf;
    __host__ __device__ void init(int M, int N, int G_, int c_, int K) { nM = M / BM; nN = N / BM; nwg = nM * nN; G = G_; c = c_; nktf = K / BK; }
    __host__ __device__ bool next(int i, Unit& u) const {
        const long L = (long)i * G + c; if (L >= nwg) return false;
        int wgid = (int)L; { const int q = nwg / NXCD, r = nwg % NXCD, xcd = wgid % NXCD, off = wgid / NXCD; wgid = (xcd < r ? xcd * (q + 1) : r * (q + 1) + (xcd - r) * q) + off; }
        const int nig = WGM * nN, gid = wgid / nig, fm = gid * WGM, gsz = (nM - fm) < WGM ? (nM - fm) : WGM;
        u.pm = fm + ((wgid % nig) % gsz); u.pn = (wgid % nig) / gsz; u.kt0 = 0; u.nkt = nktf; u.slab = -1; return true;
    }
    __device__ __forceinline__ void a_ready(const Unit&) const {}
    __device__ __forceinline__ void done(const Unit&) const {}
};

struct SplitOrder {
    int c, nktf;
    __host__ __device__ void init(int c_, int K) { c = c_; nktf = K / BK; }
    __host__ __device__ bool next(int i, Unit& u) const {
        if (i > 1) return false;
        const bool sl = (i == 0);
        const int hi = c >> 3, lo = c & 7, nks = nktf / 8;
        u.pm = sl ? 32 + (hi >> 3) : 4 * lo + (hi >> 3); u.pn = hi & 7; u.nkt = sl ? nks : nktf; u.kt0 = sl ? lo * nks : 0; u.slab = sl ? lo : -1;
        return true;
    }
    __device__ __forceinline__ void a_ready(const Unit&) const {}
    __device__ __forceinline__ void done(const Unit&) const {}
};

__device__ __forceinline__ void st_wt16(void* p, u32x4 v) { asm volatile("global_store_dwordx4 %0, %1, off sc1\n\ts_nop 1" :: "v"(p), "v"(v) : "memory"); }
__device__ __forceinline__ unsigned cvt_pk_bf16(float lo, float hi) { unsigned r; asm volatile("v_cvt_pk_bf16_f32 %0, %1, %2" : "=v"(r) : "v"(lo), "v"(hi)); return r; }

template <int ACT  > struct EpiBf16P {
    static constexpr bool PERM = true, AFTER_DRAIN = false;
    bf16_t* O; int ldc, pad;
    __device__ __forceinline__ void operator()(const f32x4 (&acc)[2][2][4][2], const Unit& u, int wr, int wc, int fr, int fq) const {
        const int row0 = u.pm * BM + wr * 64 + fr; const int col0 = u.pn * BM + wc * 32 + 8 * fq;
#pragma unroll
        for (int ai = 0; ai < 2; ++ai)
#pragma unroll
            for (int m = 0; m < 4; ++m) { bf16_t* rowp = O + (size_t)(row0 + ai * HALF + m * 16) * ldc + col0;
#pragma unroll
                for (int bj = 0; bj < 2; ++bj) { f32x4 v0 = acc[ai][bj][m][0], v1 = acc[ai][bj][m][1];
                    if (ACT == 2) {
#pragma unroll
                        for (int j = 0; j < 4; ++j) { const float a = fmaxf(v0[j], 0.f), b = fmaxf(v1[j], 0.f); v0[j] = a * a; v1[j] = b * b; } }
                    u32x4 w; w.x = cvt_pk_bf16(v0[0], v0[1]); w.y = cvt_pk_bf16(v0[2], v0[3]); w.z = cvt_pk_bf16(v1[0], v1[1]); w.w = cvt_pk_bf16(v1[2], v1[3]);
                    st_wt16(rowp + bj * HALF, w); } }
    }
};
struct EpiF32P {
    static constexpr bool PERM = false, AFTER_DRAIN = false;
    float* C; int ldc, pad;
    __device__ __forceinline__ void operator()(const f32x4 (&acc)[2][2][4][2], const Unit& u, int wr, int wc, int fr, int fq) const {
        const int row0 = u.pm * BM + wr * 64 + fr, col0 = u.pn * BM + wc * 32 + 4 * fq;
#pragma unroll
        for (int ai = 0; ai < 2; ++ai)
#pragma unroll
            for (int m = 0; m < 4; ++m) { float* rowp = C + (size_t)(row0 + ai * HALF + m * 16) * ldc + col0;
#pragma unroll
                for (int bj = 0; bj < 2; ++bj)
#pragma unroll
                    for (int n = 0; n < 2; ++n) *(f32x4*)(rowp + bj * HALF + n * 16) = acc[ai][bj][m][n]; }
    }
};

__device__ __forceinline__ float softplus_e(float x) { return fmaxf(x, 0.f) + __logf(1.f + __expf(-fabsf(x))); }
struct EpiProj {
    static constexpr bool PERM = true, AFTER_DRAIN = false;
    bf16_t* O; float* dt; const float* dt_bias;
    __device__ __forceinline__ void operator()(const f32x4 (&acc)[2][2][4][2], const Unit& u, int wr, int wc, int fr, int fq) const {
        const int row0 = u.pm * BM + wr * 64 + fr;
        if (u.pn < 18) {
            const int col0 = u.pn * BM + wc * 32 + 8 * fq;
#pragma unroll
            for (int ai = 0; ai < 2; ++ai)
#pragma unroll
                for (int m = 0; m < 4; ++m) { bf16_t* rowp = O + (size_t)(row0 + ai * HALF + m * 16) * 4608 + col0;
#pragma unroll
                    for (int bj = 0; bj < 2; ++bj) { const f32x4 v0 = acc[ai][bj][m][0], v1 = acc[ai][bj][m][1];
                        u32x4 w; w.x = cvt_pk_bf16(v0[0], v0[1]); w.y = cvt_pk_bf16(v0[2], v0[3]); w.z = cvt_pk_bf16(v1[0], v1[1]); w.w = cvt_pk_bf16(v1[2], v1[3]);
                        *(u32x4*)(rowp + bj * HALF) = w; } }
        } else if (wc == 0 && fq < 2) {
#pragma unroll
            for (int ai = 0; ai < 2; ++ai)
#pragma unroll
                for (int m = 0; m < 4; ++m) { float* rowp = dt + (size_t)(row0 + ai * HALF + m * 16) * 16 + 8 * fq;
#pragma unroll
                    for (int n = 0; n < 2; ++n) { f32x4 v = acc[ai][0][m][n];
#pragma unroll
                        for (int j = 0; j < 4; ++j) v[j] = softplus_e(v[j] + dt_bias[8 * fq + 4 * n + j]);
                        *(f32x4*)(rowp + 4 * n) = v; } }
        }
    }
};

struct EpiF32S {
    static constexpr bool PERM = false, AFTER_DRAIN = false;
    float* C; float* slab; int ldc, pad;
    __device__ __forceinline__ void operator()(const f32x4 (&acc)[2][2][4][2], const Unit& u, int wr, int wc, int fr, int fq) const {
        const int row0 = u.pm * BM + wr * 64 + fr, col0 = u.pn * BM + wc * 32 + 4 * fq;
        float* base = u.slab < 0 ? C + (size_t)row0 * ldc : slab + (size_t)u.slab * (1024 * 2048) + (size_t)(row0 - 8192) * ldc;
#pragma unroll
        for (int ai = 0; ai < 2; ++ai)
#pragma unroll
            for (int m = 0; m < 4; ++m) { float* rowp = base + (size_t)(ai * HALF + m * 16) * ldc + col0;
#pragma unroll
                for (int bj = 0; bj < 2; ++bj)
#pragma unroll
                    for (int n = 0; n < 2; ++n) *(f32x4*)(rowp + bj * HALF + n * 16) = acc[ai][bj][m][n]; }
    }
};

struct EpiBf16S {
    static constexpr bool PERM = true, AFTER_DRAIN = false;
    bf16_t* O; bf16_t* slab; int ldc, pad;
    __device__ __forceinline__ void operator()(const f32x4 (&acc)[2][2][4][2], const Unit& u, int wr, int wc, int fr, int fq) const {
        const int row0 = u.pm * BM + wr * 64 + fr, col0 = u.pn * BM + wc * 32 + 8 * fq;
        bf16_t* base = u.slab < 0 ? O + (size_t)row0 * ldc + col0 : slab + (size_t)u.slab * (1024 * 2048) + (size_t)(row0 - 8192) * ldc + col0;
#pragma unroll
        for (int ai = 0; ai < 2; ++ai)
#pragma unroll
            for (int m = 0; m < 4; ++m) { bf16_t* rowp = base + (size_t)(ai * HALF + m * 16) * ldc;
#pragma unroll
                for (int bj = 0; bj < 2; ++bj) { const f32x4 v0 = acc[ai][bj][m][0], v1 = acc[ai][bj][m][1];
                    u32x4 w; w.x = cvt_pk_bf16(v0[0], v0[1]); w.y = cvt_pk_bf16(v0[2], v0[3]); w.z = cvt_pk_bf16(v1[0], v1[1]); w.w = cvt_pk_bf16(v1[2], v1[3]);
                    *(u32x4*)(rowp + bj * HALF) = w; } }
    }
};
template <class Epi, class Sched, bool ALIGN_EPI = false, bool SP2 = false>
__device__ __forceinline__ void gemm_phase(PG8_LAS unsigned char* lds, const Gemm g, const Sched& S, const Epi& E) {
    int tid = threadIdx.x; asm volatile("" : "+v"(tid)); const int wid = __builtin_amdgcn_readfirstlane(tid >> 6), lane = tid & 63, wr = wid >> 2, wc = wid & 3, fr = lane & 15, fq = lane >> 4;
    const int K = g.K; int nt;
    unsigned voffA[2], voffB[2];
#pragma unroll
    for (int i = 0; i < 2; ++i) { int R, C; stage_rc(tid * 16 + i * 8192, R, C); const int Rb = Epi::PERM ? ((R & ~31) + perm32(R & 31)) : R;
        voffA[i] = (unsigned)(R * K + C) * 2u; voffB[i] = (unsigned)(Rb * K + C) * 2u; }
    const size_t kstep = (size_t)(BK * 2);
    const size_t hstep = (size_t)HALF * K * 2;
    const size_t tstep = 2 * hstep;
    const unsigned ldsw = (unsigned)wid * 1024u;
    const int aoff = lds_byte(wr * 64 + fr, fq * 8), boff = lds_byte(wc * 32 + fr, fq * 8);
#define PG8_SA(b, h) (((b) * 2 + (h)) * HTB)
#define PG8_SB(b, h) ((4 + (b) * 2 + (h)) * HTB)
#define PG8_STAGE(bufoff, gbase, voff) do { _Pragma("unroll") for (int _i = 0; _i < 2; ++_i) \
        __builtin_amdgcn_global_load_lds((const unsigned*)((const char*)(gbase) + (voff)[_i]), (PG8_LAS unsigned*)(lds + (bufoff) + ldsw + _i * 8192), 16, 0, 0); } while (0)
#define PG8_LDA(dst, b, h) do { _Pragma("unroll") for (int m = 0; m < 4; ++m) _Pragma("unroll") for (int k = 0; k < 2; ++k) dst[m][k] = *(const PG8_LAS bf16x8*)(lds + PG8_SA(b, h) + aoff + m * 2048 + k * 1024); } while (0)
#define PG8_LDB(dst, b, h) do { _Pragma("unroll") for (int n = 0; n < 2; ++n) _Pragma("unroll") for (int k = 0; k < 2; ++k) dst[n][k] = *(const PG8_LAS bf16x8*)(lds + PG8_SB(b, h) + boff + n * 2048 + k * 1024); } while (0)
#define PG8_MMA(ai, bj, At, Bt) do { __builtin_amdgcn_s_setprio(1); _Pragma("unroll") for (int m = 0; m < 4; ++m) _Pragma("unroll") for (int n = 0; n < 2; ++n) _Pragma("unroll") for (int k = 0; k < 2; ++k) \
        acc[ai][bj][m][n] = __builtin_amdgcn_mfma_f32_16x16x32_bf16(Bt[n][k], At[m][k], acc[ai][bj][m][n], 0, 0, 0); __builtin_amdgcn_s_setprio(0); } while (0)
#define PG8_WAIT_V(n) asm volatile("s_waitcnt vmcnt(" #n ")" ::: "memory")
#define PG8_WAIT_L(n) asm volatile("s_waitcnt lgkmcnt(" #n ")" ::: "memory")
#define PG8_BAR __builtin_amdgcn_s_barrier()
#define PG8_SCHED __builtin_amdgcn_sched_barrier(0)
    Unit cur, nxt; int ui = 0;
    if (!S.next(0, cur)) return;
    f32x4 acc[2][2][4][2];
#pragma unroll
    for (int a = 0; a < 2; ++a)
#pragma unroll
        for (int b = 0; b < 2; ++b)
#pragma unroll
            for (int m = 0; m < 4; ++m)
#pragma unroll
                for (int n = 0; n < 2; ++n) acc[a][b][m][n] = (f32x4){0.f, 0.f, 0.f, 0.f};
    bf16x8 At[4][2], B0[2][2], B1[2][2];
    const char* cA = (const char*)g.A + (size_t)cur.pm * tstep + (size_t)cur.kt0 * kstep; const char* cB = (const char*)g.Bt + (size_t)cur.pn * tstep + (size_t)cur.kt0 * kstep; nt = cur.nkt;
    S.a_ready(cur);
    if constexpr (SP2) {
        PG8_STAGE(PG8_SB(0, 0), cB, voffB); PG8_STAGE(PG8_SB(0, 1), cB + hstep, voffB); PG8_STAGE(PG8_SA(0, 0), cA, voffA); PG8_STAGE(PG8_SA(0, 1), cA + hstep, voffA);
        if (wr == 1) PG8_BAR;
        PG8_WAIT_V(2); PG8_BAR;
        PG8_STAGE(PG8_SB(1, 0), cB + kstep, voffB); PG8_STAGE(PG8_SA(1, 0), cA + kstep, voffA); PG8_STAGE(PG8_SB(1, 1), cB + hstep + kstep, voffB);
        PG8_WAIT_V(6); PG8_BAR;
    } else {
        PG8_STAGE(PG8_SB(0, 0), cB, voffB); PG8_STAGE(PG8_SA(0, 0), cA, voffA); PG8_STAGE(PG8_SB(0, 1), cB + hstep, voffB); PG8_STAGE(PG8_SA(0, 1), cA + hstep, voffA);
        if (wr == 1) PG8_BAR;
        PG8_WAIT_V(4); PG8_BAR;
        PG8_STAGE(PG8_SB(1, 0), cB + kstep, voffB); PG8_STAGE(PG8_SA(1, 0), cA + kstep, voffA); PG8_STAGE(PG8_SB(1, 1), cB + hstep + kstep, voffB);
        PG8_WAIT_V(6); PG8_BAR;
    }
    for (;;) {
        const bool has_next = S.next(ui + 1, nxt);
        const char* nA = has_next ? (const char*)g.A + (size_t)nxt.pm * tstep + (size_t)nxt.kt0 * kstep : cA; const char* nB = has_next ? (const char*)g.Bt + (size_t)nxt.pn * tstep + (size_t)nxt.kt0 * kstep : cB;
        for (int t = 0; t < nt; t += 2) {
            const bool last = (t == nt - 2);
            const char* a1 = cA + (size_t)(t + 1) * kstep;
            const char* a2 = last ? nA : cA + (size_t)(t + 2) * kstep; const char* b2 = last ? nB : cB + (size_t)(t + 2) * kstep;
            const char* a3 = a2 + kstep; const char* b3 = b2 + kstep;
            if (last && has_next) S.a_ready(nxt);
            if constexpr (SP2) {
            PG8_LDB(B0, 0, 0); PG8_LDB(B1, 0, 1); PG8_SCHED; PG8_LDA(At, 0, 0); PG8_STAGE(PG8_SA(1, 1), a1 + hstep, voffA);
            PG8_WAIT_V(8); PG8_WAIT_L(0); PG8_BAR; PG8_MMA(0, 0, At, B0); PG8_MMA(0, 1, At, B1); PG8_BAR; PG8_SCHED;
            PG8_LDA(At, 0, 1); PG8_STAGE(PG8_SB(0, 0), b2, voffB); PG8_STAGE(PG8_SB(0, 1), b2 + hstep, voffB); PG8_STAGE(PG8_SA(0, 0), a2, voffA);
            PG8_WAIT_V(8); PG8_WAIT_L(0); PG8_BAR; PG8_MMA(1, 0, At, B0); PG8_MMA(1, 1, At, B1); PG8_BAR; PG8_SCHED;
            PG8_LDB(B0, 1, 0); PG8_LDB(B1, 1, 1); PG8_SCHED; PG8_LDA(At, 1, 0); PG8_STAGE(PG8_SA(0, 1), a2 + hstep, voffA);
            PG8_WAIT_V(8); PG8_WAIT_L(0); PG8_BAR; PG8_MMA(0, 0, At, B0); PG8_MMA(0, 1, At, B1); PG8_BAR; PG8_SCHED;
            PG8_LDA(At, 1, 1); PG8_STAGE(PG8_SB(1, 0), b3, voffB); PG8_STAGE(PG8_SB(1, 1), b3 + hstep, voffB); PG8_STAGE(PG8_SA(1, 0), a3, voffA);
            PG8_WAIT_V(8); PG8_WAIT_L(0); PG8_BAR; PG8_MMA(1, 0, At, B0); PG8_MMA(1, 1, At, B1); PG8_BAR; PG8_SCHED;
            } else {
            PG8_LDB(B0, 0, 0); PG8_SCHED; PG8_LDA(At, 0, 0); PG8_STAGE(PG8_SA(1, 1), a1 + hstep, voffA);
            PG8_WAIT_L(8); PG8_BAR; PG8_WAIT_L(0); PG8_MMA(0, 0, At, B0); PG8_BAR; PG8_SCHED;
            PG8_LDB(B1, 0, 1); PG8_STAGE(PG8_SB(0, 0), b2, voffB);
            PG8_BAR; PG8_WAIT_L(0); PG8_MMA(0, 1, At, B1); PG8_BAR;
            PG8_LDA(At, 0, 1); PG8_STAGE(PG8_SA(0, 0), a2, voffA);
            PG8_BAR; PG8_WAIT_L(0); PG8_MMA(1, 0, At, B0); PG8_BAR; PG8_SCHED;
            PG8_STAGE(PG8_SB(0, 1), b2 + hstep, voffB);
            PG8_WAIT_V(6); PG8_BAR; PG8_MMA(1, 1, At, B1); PG8_BAR;
            PG8_LDB(B0, 1, 0); PG8_SCHED; PG8_LDA(At, 1, 0); PG8_STAGE(PG8_SA(0, 1), a2 + hstep, voffA);
            PG8_WAIT_L(8); PG8_BAR; PG8_WAIT_L(0); PG8_MMA(0, 0, At, B0); PG8_BAR; PG8_SCHED;
            PG8_LDB(B1, 1, 1); PG8_STAGE(PG8_SB(1, 0), b3, voffB);
            PG8_BAR; PG8_WAIT_L(0); PG8_MMA(0, 1, At, B1); PG8_BAR;
            PG8_LDA(At, 1, 1); PG8_STAGE(PG8_SA(1, 0), a3, voffA);
            PG8_BAR; PG8_WAIT_L(0); PG8_MMA(1, 0, At, B0); PG8_BAR; PG8_SCHED;
            PG8_STAGE(PG8_SB(1, 1), b3 + hstep, voffB);
            PG8_WAIT_V(6); PG8_BAR; PG8_MMA(1, 1, At, B1); PG8_BAR;
            }
        }
        if constexpr (ALIGN_EPI) { if (wr == 0) PG8_BAR; }
        if (!Epi::AFTER_DRAIN || has_next) { E(acc, cur, wr, wc, fr, fq); S.done(cur); }
        if (!has_next) break;
#pragma unroll
        for (int a = 0; a < 2; ++a)
#pragma unroll
            for (int b = 0; b < 2; ++b)
#pragma unroll
                for (int m = 0; m < 4; ++m)
#pragma unroll
                    for (int n = 0; n < 2; ++n) acc[a][b][m][n] = (f32x4){0.f, 0.f, 0.f, 0.f};
        cur = nxt; cA = nA; cB = nB; ++ui; nt = cur.nkt;
        if constexpr (ALIGN_EPI) { if (wr == 1) PG8_BAR; }
    }
    PG8_WAIT_V(0);
    if constexpr (!ALIGN_EPI) { if (wr == 0) PG8_BAR; }
    PG8_BAR;
    if constexpr (Epi::AFTER_DRAIN) { E.fused(acc, cur, wr, wc, fr, fq, lds, wid, lane); S.done(cur); }
#undef PG8_SA
#undef PG8_SB
#undef PG8_STAGE
#undef PG8_LDA
#undef PG8_LDB
#undef PG8_MMA
#undef PG8_WAIT_V
#undef PG8_WAIT_L
#undef PG8_BAR
#undef PG8_SCHED
}
}

typedef unsigned short bf16;
typedef float f32x4 __attribute__((ext_vector_type(4)));
constexpr int DM = 2048, NPB = 4, SEQ = 2048, NSB = 128, DSEQ = 8;
constexpr int MP = NPB * SEQ, MS = NSB * DSEQ, MROWS = MP + MS;
constexpr int NSEQ = NPB + NSB;
constexpr int SSDW = 1024, HDIM = 64, NHEAD = 16, NGRP = 2, NSTATE = 128, CONVD = 1536, GMW = 1024, GMHD = 128, GMNH = 8, DFF = 8192;
constexpr int DINP = 4624, NPROJ = 4608;
constexpr int PZ = 0, PX = 1024, PU = 2560, PV = 3584;
constexpr int NMOD = 6 * DM;
constexpr float LN_EPS = 1e-5f, ALPHA = 1.189207115002721f;
constexpr size_t O_YP = 0, O_YS = 16777216, O_SSMP = 18874368, O_CONVP = 19398656, O_SSMS = 19417088, O_CONVS = 36194304, O_CV = 36784128;
constexpr size_t MiB = 1u << 20;
constexpr size_t WS_WIN = 2 * MiB, WS_WOUT = 22 * MiB, WS_WFF1 = 30 * MiB, WS_WFF2 = 62 * MiB, WS_MOD = 95 * MiB, WS_STATS = 102 * MiB, WS_DT = 103 * MiB, WS_CD = 104 * MiB;
constexpr size_t WS_XB1 = 104 * MiB + 256 * 1024, WS_XB2 = 105 * MiB;
constexpr size_t WS_H = 106 * MiB;
constexpr size_t WS_BIG = 142 * MiB;
constexpr size_t WS_ACT = WS_BIG + 81 * MiB;
constexpr size_t WS_E = 286 * MiB;
constexpr size_t WS_VN = WS_E + 36 * MiB;
constexpr size_t WS_SIN = 358 * MiB;
constexpr size_t WS_SLAB2 = 322 * MiB;
constexpr size_t WS_END = 386 * MiB;

__device__ __forceinline__ float bf2f(bf16 b) { return __uint_as_float(((unsigned)b) << 16); }
__device__ __forceinline__ bf16 f2bf(float f) { unsigned u = __float_as_uint(f); return (bf16)((u + 0x7fffu + ((u >> 16) & 1u)) >> 16); }
__device__ __forceinline__ float silu_f(float x) { return x / (1.f + expf(-x)); }
__device__ __forceinline__ float softplus_f(float x) { return fmaxf(x, 0.f) + log1pf(expf(-fabsf(x))); }
__device__ __forceinline__ float gelu_f(float x) { return 0.5f * x * (1.f + tanhf(0.7978845608028654f * (x + 0.044715f * x * x * x))); }
__device__ __forceinline__ int modrow(int r) { return r < MP ? (r >> 11) : NPB + ((r - MP) >> 3); }
__device__ __forceinline__ float wave_sum(float v) {
#pragma unroll
    for (int o = 1; o < 64; o <<= 1) v += __shfl_xor(v, o);
    return v;
}
__device__ __forceinline__ float block_sum256(float v, float* red) {
    v = wave_sum(v);
    __syncthreads();
    if ((threadIdx.x & 63) == 0) red[threadIdx.x >> 6] = v;
    __syncthreads();
    return (red[0] + red[1]) + (red[2] + red[3]);
}


#define GAS __attribute__((address_space(1)))
#define LAS __attribute__((address_space(3)))
typedef GAS unsigned gu32;
constexpr int NWAVES = 8;
constexpr int LDSCTL_OFF = 155648, MISC_OFF = LDSCTL_OFF + 320, LDS_BYTES = 163840;
constexpr size_t WS_CTL = 0, CTL_ZERO_BYTES = 64 * 1024;
constexpr int CW_BAR = 1024, CW_CSILU = 512;
#define XB_TMO      128
#define XB_XCNT(j)  (256  + 64 * (j))
#define XB_XSUB(j)  (1280 + 64 * (j))
#define XB_XGEN(j)  (2304 + 64 * (j))
#define XB_TOP      3328
#define XB_TOPGEN   3392
#define XCD_BAR_WORDS 3456
#define XB_SPIN_CAP (1u << 18)

__device__ __forceinline__ unsigned xb_ld(unsigned* p)              { return __hip_atomic_load(p, __ATOMIC_RELAXED, __HIP_MEMORY_SCOPE_AGENT); }
__device__ __forceinline__ unsigned xb_add(unsigned* p, unsigned v) { return __hip_atomic_fetch_add(p, v, __ATOMIC_RELAXED, __HIP_MEMORY_SCOPE_AGENT); }
__device__ __forceinline__ unsigned xb_xcc_id() { return (unsigned)__builtin_amdgcn_s_getreg((3 << 11) | 20) & 0xFu; }
#define XB_SPIN(cond, bar) do { unsigned _sp = 0; while (cond) { __builtin_amdgcn_s_sleep(1); \
    if ((++_sp & 255u) == 0u) { if (xb_ld(&(bar)[XB_TMO])) break; if (_sp > XB_SPIN_CAP) { atomicAdd(&(bar)[XB_TMO], 1u); break; } } } } while (0)

struct XcdBarrier {
    unsigned* bar; unsigned x;
    volatile LAS unsigned* st;
};

__device__ __forceinline__ XcdBarrier xcd_barrier_post(unsigned* bar, volatile LAS unsigned* st) {
    XcdBarrier b; b.bar = bar; b.x = xb_xcc_id(); b.st = st;
    if (threadIdx.x == 0) (void)xb_add(&bar[XB_XCNT(b.x)], 1u);
    return b;
}
__device__ __forceinline__ void xcd_barrier_complete(unsigned* bar, unsigned x, unsigned& nloc, unsigned& nx) {
    const unsigned G = gridDim.x * gridDim.y * gridDim.z;
    unsigned sum, cnt, mine, sp = 0u;
    for (;;) {
        sum = 0u; cnt = 0u; mine = 0u;
#pragma unroll
        for (unsigned j = 0; j < 16; ++j) { const unsigned c = xb_ld(&bar[XB_XCNT(j)]); sum += c; cnt += (c > 0u) ? 1u : 0u; mine = (j == x) ? c : mine; }
        if (sum == G) break;
        __builtin_amdgcn_s_sleep(1);
        if ((++sp & 255u) == 0u) { if (xb_ld(&bar[XB_TMO])) break; if (sp > XB_SPIN_CAP) { atomicAdd(&bar[XB_TMO], 1u); break; } }
    }
    nloc = mine > 0u ? mine : 1u; nx = cnt > 0u ? cnt : 1u;
}

__device__ __forceinline__ void xcd_barrier(const XcdBarrier& b) {
    asm volatile("s_waitcnt vmcnt(0)" ::: "memory");
    __syncthreads();
    if (threadIdx.x == 0) {
        unsigned* bar = b.bar;
        __builtin_amdgcn_s_waitcnt(0);
        unsigned nloc = b.st[0], nx = b.st[1];
        if (nloc == 0u) { xcd_barrier_complete(bar, b.x, nloc, nx); b.st[0] = nloc; b.st[1] = nx; }
        const unsigned old = xb_add(&bar[XB_XSUB(b.x)], 1u);
        const unsigned gen = old / nloc;
        if (old + 1u == (gen + 1u) * nloc) {
            __builtin_amdgcn_fence(__ATOMIC_RELEASE, "agent");
            asm volatile("s_waitcnt vmcnt(0)" ::: "memory");
            const unsigned og = xb_add(&bar[XB_TOP], 1u);
            const unsigned tg = og / nx;
            if (og + 1u == (tg + 1u) * nx) xb_add(&bar[XB_TOPGEN], 1u);
            else XB_SPIN(xb_ld(&bar[XB_TOPGEN]) == tg, bar);
            __builtin_amdgcn_fence(__ATOMIC_ACQUIRE, "agent");
            xb_add(&bar[XB_XGEN(b.x)], 1u);
            asm volatile("s_waitcnt vmcnt(0)" ::: "memory");
        } else {
            XB_SPIN(xb_ld(&bar[XB_XGEN(b.x)]) == gen, bar);
            __builtin_amdgcn_fence(__ATOMIC_ACQUIRE, "agent");
            asm volatile("s_waitcnt vmcnt(0)" ::: "memory");
        }
    }
    __syncthreads();
}


struct Args { const float* in[28]; float* out; unsigned char* ws; };
struct VB { int vt, id, n; LAS float* scr; };

__device__ __forceinline__ float vb_sum(float v, LAS float* red, int vt) {
    v = wave_sum(v);
    __syncthreads();
    if ((vt & 63) == 0) red[vt >> 6] = v;
    __syncthreads();
    return (red[0] + red[1]) + (red[2] + red[3]);
}


typedef short bf16x8 __attribute__((ext_vector_type(8)));
typedef unsigned u32x4 __attribute__((ext_vector_type(4)));
typedef unsigned u32x2 __attribute__((ext_vector_type(2)));
constexpr int LDT = 136;
constexpr int SSD_IMG = 128 * LDT * 2;
constexpr int SSD_XT = 256 * LDT * 2;
__device__ __forceinline__ unsigned pk_bf16(float lo, float hi) { unsigned r; asm volatile("v_cvt_pk_bf16_f32 %0, %1, %2" : "=v"(r) : "v"(lo), "v"(hi)); return r; }
__device__ __forceinline__ float fast_silu(float a) { return a * __builtin_amdgcn_rcpf(1.f + __expf(-a)); }

template <int NCH, bool TR> __device__ __forceinline__ void stage_conv(LAS bf16* dst, int chan0, int R0, bool first, const bf16* __restrict__ proj, const float* __restrict__ conv_w, const float* __restrict__ conv_b, int tid) {
    constexpr int NG = NCH / 8, TB = (NG == 32) ? 8 : 4, CGB = NG / 8;
    int cg, tb;
    if (TR) { const int wv = tid >> 6, ln = tid & 63; cg = 8 * (wv % CGB) + (ln >> 3); tb = 8 * (wv / CGB) + (ln & 7); }
    else { cg = tid % NG; tb = tid / NG; }
    const int ch = chan0 + 8 * cg, j0 = TB * tb;
    const bf16* src = proj + (size_t)R0 * NPROJ + PX + ch;
    u32x4 row[TB + 3];
#pragma unroll
    for (int i = 0; i < TB + 3; ++i) { const int jj = j0 - 3 + i; row[i] = (jj >= 0 || !first) ? *(const u32x4*)(src + (ptrdiff_t)jj * NPROJ) : (u32x4){0u, 0u, 0u, 0u}; }
    float w[4][8], bias[8];
#pragma unroll
    for (int k = 0; k < 4; ++k) { const f32x4 a = *(const f32x4*)(conv_w + k * CONVD + ch), b = *(const f32x4*)(conv_w + k * CONVD + ch + 4);
        w[k][0] = a[0]; w[k][1] = a[1]; w[k][2] = a[2]; w[k][3] = a[3]; w[k][4] = b[0]; w[k][5] = b[1]; w[k][6] = b[2]; w[k][7] = b[3]; }
    { const f32x4 a = *(const f32x4*)(conv_b + ch), b = *(const f32x4*)(conv_b + ch + 4); bias[0] = a[0]; bias[1] = a[1]; bias[2] = a[2]; bias[3] = a[3]; bias[4] = b[0]; bias[5] = b[1]; bias[6] = b[2]; bias[7] = b[3]; }
    unsigned outp[8][TB / 2];
#pragma unroll
    for (int q = 0; q < TB / 2; ++q) {
        float a0[8], a1[8];
#pragma unroll
        for (int e = 0; e < 8; ++e) { a0[e] = bias[e]; a1[e] = bias[e]; }
#pragma unroll
        for (int k = 0; k < 4; ++k) { const u32x4 v0 = row[2 * q + k], v1 = row[2 * q + 1 + k];
#pragma unroll
            for (int e = 0; e < 4; ++e) { a0[2 * e] += w[k][2 * e] * __uint_as_float(v0[e] << 16); a0[2 * e + 1] += w[k][2 * e + 1] * __uint_as_float(v0[e] & 0xffff0000u);
                                          a1[2 * e] += w[k][2 * e] * __uint_as_float(v1[e] << 16); a1[2 * e + 1] += w[k][2 * e + 1] * __uint_as_float(v1[e] & 0xffff0000u); } }
#pragma unroll
        for (int e = 0; e < 8; ++e) { a0[e] = fast_silu(a0[e]); a1[e] = fast_silu(a1[e]); }
        if (TR) {
#pragma unroll
            for (int e = 0; e < 8; ++e) outp[e][q] = pk_bf16(a0[e], a1[e]);
        } else {
            u32x4 o; o.x = pk_bf16(a0[0], a0[1]); o.y = pk_bf16(a0[2], a0[3]); o.z = pk_bf16(a0[4], a0[5]); o.w = pk_bf16(a0[6], a0[7]);
            *(LAS u32x4*)(dst + (j0 + 2 * q) * LDT + 8 * cg) = o;
            o.x = pk_bf16(a1[0], a1[1]); o.y = pk_bf16(a1[2], a1[3]); o.z = pk_bf16(a1[4], a1[5]); o.w = pk_bf16(a1[6], a1[7]);
            *(LAS u32x4*)(dst + (j0 + 2 * q + 1) * LDT + 8 * cg) = o;
        }
    }
    if (TR) {
#pragma unroll
        for (int e = 0; e < 8; ++e) {
            if (TB == 8) { u32x4 o; o.x = outp[e][0]; o.y = outp[e][1]; o.z = outp[e][TB / 2 - 2]; o.w = outp[e][TB / 2 - 1]; *(LAS u32x4*)(dst + (8 * cg + e) * LDT + j0) = o; }
            else { u32x2 o; o.x = outp[e][0]; o.y = outp[e][1]; *(LAS u32x2*)(dst + (8 * cg + e) * LDT + j0) = o; }
        }
    }
}
__device__ __forceinline__ float ssd_scalars(LAS float* dtv, LAS float* acum, int R0, int h, int wid, int lane, const float* __restrict__ dt, const float* __restrict__ a_log) {
    const float A = -__expf(a_log[h]);
    const int j0 = 2 * lane;
    const float d0 = dt[(size_t)(R0 + j0) * 16 + h], d1 = dt[(size_t)(R0 + j0 + 1) * 16 + h];
    const float a0 = d0 * A, a1 = d1 * A;
    float s = a0 + a1;
#pragma unroll
    for (int o = 1; o < 64; o <<= 1) { const float t = __shfl_up(s, o); if (lane >= o) s += t; }
    dtv[wid * 128 + j0] = d0; dtv[wid * 128 + j0 + 1] = d1;
    acum[wid * 128 + j0] = s - a1; acum[wid * 128 + j0 + 1] = s;
    return __shfl(s, 63);
}

__device__ __forceinline__ void ssd_phaseA_item(LAS unsigned char* lds, int item, const bf16* __restrict__ proj, const float* __restrict__ dt, const float* __restrict__ conv_w, const float* __restrict__ conv_b,
                                                const float* __restrict__ a_log, bf16* __restrict__ cs, float* __restrict__ cd, bf16* __restrict__ xs) {
    int tid = threadIdx.x; asm volatile("" : "+v"(tid)); const int wid = __builtin_amdgcn_readfirstlane(tid >> 6), lane = tid & 63, fr = lane & 15, fq = lane >> 4;
    const int pass = item & 1, b = item >> 6, c = (item >> 2) & 15, g = (item >> 1) & 1, R0 = b * SEQ + c * 128;
    LAS bf16* BT = (LAS bf16*)lds; LAS bf16* xT = (LAS bf16*)(lds + SSD_IMG);
    LAS float* dtv = (LAS float*)(lds + SSD_IMG + SSD_XT); LAS float* acum = dtv + 8 * 128; LAS float* wj = acum + 8 * 128;
    __syncthreads();
    { const int h = g * 8 + wid; const float tot = ssd_scalars(dtv, acum, R0, h, wid, lane, dt, a_log);
      const int j0 = 2 * lane;
      wj[wid * 128 + j0] = dtv[wid * 128 + j0] * __expf(tot - acum[wid * 128 + j0]); wj[wid * 128 + j0 + 1] = dtv[wid * 128 + j0 + 1] * __expf(tot - acum[wid * 128 + j0 + 1]);
      if (lane == 0 && pass == 0) cd[(b * 16 + c) * 16 + h] = __expf(tot); }
    stage_conv<128, true>(BT, SSDW + g * NSTATE, R0, c == 0, proj, conv_w, conv_b, tid);
    {
        stage_conv<256, true>(xT, (g * 8 + pass * 4) * HDIM, R0, c == 0, proj, conv_w, conv_b, tid);
        __syncthreads();
        {
            bf16* xd = xs + (size_t)item * (SSD_XT / 2);
#pragma unroll
            for (int i = 0; i < 9; ++i) { const int idx = tid + 512 * i; if (idx < SSD_XT / 16) *(u32x4*)(xd + 8 * idx) = *(LAS u32x4*)(xT + 8 * idx); }
        }
        const int hl = wid >> 1, nh = wid & 1, hh = pass * 4 + hl;
        f32x4 acc[4][4];
#pragma unroll
        for (int m = 0; m < 4; ++m)
#pragma unroll
            for (int n = 0; n < 4; ++n) acc[m][n] = (f32x4){0.f, 0.f, 0.f, 0.f};
#pragma unroll
        for (int ks = 0; ks < 4; ++ks) {
            const int j = 32 * ks + 8 * fq;
            const f32x4 w0 = *(LAS f32x4*)(wj + hh * 128 + j), w1 = *(LAS f32x4*)(wj + hh * 128 + j + 4);
            bf16x8 xs[4];
#pragma unroll
            for (int nt = 0; nt < 4; ++nt) { const u32x4 raw = *(LAS u32x4*)(xT + (hl * 64 + 16 * nt + fr) * LDT + j);
                u32x4 o;
                o.x = pk_bf16(__uint_as_float(raw.x << 16) * w0[0], __uint_as_float(raw.x & 0xffff0000u) * w0[1]);
                o.y = pk_bf16(__uint_as_float(raw.y << 16) * w0[2], __uint_as_float(raw.y & 0xffff0000u) * w0[3]);
                o.z = pk_bf16(__uint_as_float(raw.z << 16) * w1[0], __uint_as_float(raw.z & 0xffff0000u) * w1[1]);
                o.w = pk_bf16(__uint_as_float(raw.w << 16) * w1[2], __uint_as_float(raw.w & 0xffff0000u) * w1[3]);
                xs[nt] = __builtin_bit_cast(bf16x8, o); }
#pragma unroll
            for (int mt = 0; mt < 4; ++mt) { const bf16x8 a = *(LAS bf16x8*)(BT + (64 * nh + 32 * (mt >> 1) + 8 * (fr >> 2) + 4 * (mt & 1) + (fr & 3)) * LDT + j);
#pragma unroll
                for (int nt = 0; nt < 4; ++nt) acc[mt][nt] = __builtin_amdgcn_mfma_f32_16x16x32_bf16(a, xs[nt], acc[mt][nt], 0, 0, 0); }
        }
        bf16* dst = cs + ((size_t)((b * 16 + c) * 16 + g * 8 + hh) * HDIM) * NSTATE;
        __builtin_amdgcn_sched_barrier(0);
        asm volatile("s_nop 15\n\ts_nop 7" ::: "memory");
#pragma unroll
        for (int q = 0; q < 2; ++q)
#pragma unroll
            for (int nt = 0; nt < 4; ++nt) { u32x4 w; w.x = pk_bf16(acc[2 * q][nt][0], acc[2 * q][nt][1]); w.y = pk_bf16(acc[2 * q][nt][2], acc[2 * q][nt][3]);
                w.z = pk_bf16(acc[2 * q + 1][nt][0], acc[2 * q + 1][nt][1]); w.w = pk_bf16(acc[2 * q + 1][nt][2], acc[2 * q + 1][nt][3]);
                *(u32x4*)(dst + (size_t)(16 * nt + fr) * NSTATE + 64 * nh + 32 * q + 8 * fq) = w; }
    }
}

constexpr int PC_RC = 0, PC_RG = SSD_IMG, PC_RX = 2 * SSD_IMG, PC_SCAL = 2 * SSD_IMG + SSD_XT, PC_SQ = PC_SCAL + 2 * 8 * 128 * 4, PC_END = PC_SQ + 128 * 8 * 4;
__device__ __forceinline__ void ssd_phaseC_item(LAS unsigned char* lds, int item, const bf16* __restrict__ proj, const float* __restrict__ dt, const float* __restrict__ conv_w, const float* __restrict__ conv_b,
                                                const float* __restrict__ a_log, const float* __restrict__ d_skip, const float* __restrict__ gw, const bf16* __restrict__ s_in, const bf16* __restrict__ xs, bf16* __restrict__ A2) {
    int tid = threadIdx.x; asm volatile("" : "+v"(tid)); const int wid = __builtin_amdgcn_readfirstlane(tid >> 6), lane = tid & 63, fr = lane & 15, fq = lane >> 4;
    const int b = item >> 5, c = (item >> 1) & 15, g = item & 1, R0 = b * SEQ + c * 128;
    LAS bf16* RC = (LAS bf16*)(lds + PC_RC); LAS bf16* RG = (LAS bf16*)(lds + PC_RG); LAS bf16* RX = (LAS bf16*)(lds + PC_RX);
    LAS float* dtv = (LAS float*)(lds + PC_SCAL); LAS float* acum = dtv + 8 * 128; LAS float* sqb = (LAS float*)(lds + PC_SQ);
    __syncthreads();
    const char* xsrc = (const char*)(xs + (size_t)(item * 2) * (SSD_XT / 2)) + lane * 16;
#define PC_XLOAD(ps) do { _Pragma("unroll") for (int i_ = 0; i_ < 9; ++i_) { const int k_ = wid + 8 * i_; if (k_ < SSD_XT / 1024) \
        __builtin_amdgcn_global_load_lds((const unsigned*)(xsrc + (size_t)(ps) * SSD_XT + k_ * 1024), (LAS unsigned*)(lds + PC_RX + k_ * 1024), 16, 0, 0); } } while (0)
    PC_XLOAD(0);
    (void)ssd_scalars(dtv, acum, R0, g * 8 + wid, wid, lane, dt, a_log);
    stage_conv<128, false>(RC, SSDW + NGRP * NSTATE + g * NSTATE, R0, c == 0, proj, conv_w, conv_b, tid);
    stage_conv<128, false>(RG, SSDW + g * NSTATE, R0, c == 0, proj, conv_w, conv_b, tid);
    __syncthreads();
    {
        f32x4 ga[8];
#pragma unroll
        for (int jt = 0; jt < 8; ++jt) ga[jt] = (f32x4){0.f, 0.f, 0.f, 0.f};
#pragma unroll
        for (int ks = 0; ks < 4; ++ks) { const int n0 = 32 * ks + 8 * fq;
            const bf16x8 a = *(LAS bf16x8*)(RC + (16 * wid + fr) * LDT + n0);
#pragma unroll
            for (int jt = 0; jt < 8; ++jt) if (jt <= wid) { const bf16x8 bb = *(LAS bf16x8*)(RG + (16 * jt + fr) * LDT + n0); ga[jt] = __builtin_amdgcn_mfma_f32_16x16x32_bf16(a, bb, ga[jt], 0, 0, 0); } }
        __syncthreads();
#pragma unroll
        for (int jt = 0; jt < 8; ++jt) if (jt <= wid) {
#pragma unroll
            for (int r = 0; r < 4; ++r) RG[(16 * wid + 4 * fq + r) * LDT + 16 * jt + fr] = f2bf(ga[jt][r]); }
    }
    u32x2 hvp[2][4][4];
    const int hl = wid >> 1, rh = wid & 1;
    int irow[4];
#pragma unroll
    for (int nt = 0; nt < 4; ++nt) irow[nt] = 64 * rh + 16 * nt + fr;
    int prow[4];
#pragma unroll
    for (int mt = 0; mt < 4; ++mt) prow[mt] = 32 * (mt >> 1) + 8 * (fr >> 2) + 4 * (mt & 1) + (fr & 3);
#pragma unroll
    for (int pass = 0; pass < 2; ++pass) {
        asm volatile("s_waitcnt vmcnt(0)" ::: "memory");
        __syncthreads();
        const int hh = pass * 4 + hl, h = g * 8 + hh;
        const float Dh = d_skip[h];
        float ai[4];
#pragma unroll
        for (int nt = 0; nt < 4; ++nt) ai[nt] = acum[hh * 128 + irow[nt]];
        f32x4 hv[4][4];
#pragma unroll
        for (int m = 0; m < 4; ++m)
#pragma unroll
            for (int n = 0; n < 4; ++n) hv[m][n] = (f32x4){0.f, 0.f, 0.f, 0.f};
#pragma unroll
        for (int ks = 0; ks < 4; ++ks) {
            if (ks < 2 + 2 * rh) {
                const int j = 32 * ks + 8 * fq;
                const f32x4 aj0 = *(LAS f32x4*)(acum + hh * 128 + j), aj1 = *(LAS f32x4*)(acum + hh * 128 + j + 4);
                const f32x4 dj0 = *(LAS f32x4*)(dtv + hh * 128 + j), dj1 = *(LAS f32x4*)(dtv + hh * 128 + j + 4);
                bf16x8 sf[4];
#pragma unroll
                for (int nt = 0; nt < 4; ++nt) {
                    if (32 * ks <= 64 * rh + 16 * nt + 15) {
                        const u32x4 raw = *(LAS u32x4*)(RG + irow[nt] * LDT + j);
                        float v[8];
                        v[0] = __uint_as_float(raw.x << 16); v[1] = __uint_as_float(raw.x & 0xffff0000u); v[2] = __uint_as_float(raw.y << 16); v[3] = __uint_as_float(raw.y & 0xffff0000u);
                        v[4] = __uint_as_float(raw.z << 16); v[5] = __uint_as_float(raw.z & 0xffff0000u); v[6] = __uint_as_float(raw.w << 16); v[7] = __uint_as_float(raw.w & 0xffff0000u);
                        int dd = irow[nt] - j; asm volatile("" : "+v"(dd));
#pragma unroll
                        for (int e = 0; e < 8; ++e) { const float aj = e < 4 ? aj0[e & 3] : aj1[e & 3], dj = e < 4 ? dj0[e & 3] : dj1[e & 3];
                            v[e] = (e <= dd) ? v[e] * __expf(ai[nt] - aj) * dj : 0.f; }
                        if (ks == 2 * rh + (nt >> 1)) {
#pragma unroll
                            for (int e = 0; e < 8; ++e) v[e] += (e == dd) ? Dh : 0.f; }
                        u32x4 o; o.x = pk_bf16(v[0], v[1]); o.y = pk_bf16(v[2], v[3]); o.z = pk_bf16(v[4], v[5]); o.w = pk_bf16(v[6], v[7]);
                        sf[nt] = __builtin_bit_cast(bf16x8, o);
                    }
                }
#pragma unroll
                for (int mt = 0; mt < 4; ++mt) { const bf16x8 a = *(LAS bf16x8*)(RX + (hl * 64 + prow[mt]) * LDT + j);
#pragma unroll
                    for (int nt = 0; nt < 4; ++nt) if (32 * ks <= 64 * rh + 16 * nt + 15) hv[mt][nt] = __builtin_amdgcn_mfma_f32_16x16x32_bf16(a, sf[nt], hv[mt][nt], 0, 0, 0); }
            }
        }
        if (c > 0) {
            const bf16* sp = s_in + ((size_t)((b * 16 + c) * 16 + h) * HDIM) * NSTATE;
            float ei[4];
#pragma unroll
            for (int nt = 0; nt < 4; ++nt) ei[nt] = __expf(ai[nt]);
#pragma unroll
            for (int ks = 0; ks < 4; ++ks) { const int n0 = 32 * ks + 8 * fq;
                bf16x8 cf[4];
#pragma unroll
                for (int nt = 0; nt < 4; ++nt) { const u32x4 raw = *(LAS u32x4*)(RC + irow[nt] * LDT + n0); const float e = ei[nt];
                    u32x4 o;
                    o.x = pk_bf16(__uint_as_float(raw.x << 16) * e, __uint_as_float(raw.x & 0xffff0000u) * e); o.y = pk_bf16(__uint_as_float(raw.y << 16) * e, __uint_as_float(raw.y & 0xffff0000u) * e);
                    o.z = pk_bf16(__uint_as_float(raw.z << 16) * e, __uint_as_float(raw.z & 0xffff0000u) * e); o.w = pk_bf16(__uint_as_float(raw.w << 16) * e, __uint_as_float(raw.w & 0xffff0000u) * e);
                    cf[nt] = __builtin_bit_cast(bf16x8, o); }
#pragma unroll
                for (int mt = 0; mt < 4; ++mt) { const bf16x8 a = *(const bf16x8*)(sp + (size_t)prow[mt] * NSTATE + n0);
#pragma unroll
                    for (int nt = 0; nt < 4; ++nt) hv[mt][nt] = __builtin_amdgcn_mfma_f32_16x16x32_bf16(a, cf[nt], hv[mt][nt], 0, 0, 0); }
            }
        }
        u32x4 zr[2][4];
#pragma unroll
        for (int q = 0; q < 2; ++q)
#pragma unroll
            for (int nt = 0; nt < 4; ++nt) zr[q][nt] = *(const u32x4*)(proj + (size_t)(R0 + irow[nt]) * NPROJ + PZ + h * HDIM + 32 * q + 8 * fq);
        if (pass == 0) { __syncthreads(); PC_XLOAD(1); }
        float sq[4] = {0.f, 0.f, 0.f, 0.f};
#pragma unroll
        for (int q = 0; q < 2; ++q)
#pragma unroll
            for (int nt = 0; nt < 4; ++nt) {
#pragma unroll
                for (int hf = 0; hf < 2; ++hf) { const int mt = 2 * q + hf; const unsigned z01 = hf ? zr[q][nt].z : zr[q][nt].x, z23 = hf ? zr[q][nt].w : zr[q][nt].y;
                    const float z[4] = {__uint_as_float(z01 << 16), __uint_as_float(z01 & 0xffff0000u), __uint_as_float(z23 << 16), __uint_as_float(z23 & 0xffff0000u)};
                    float hq[4];
#pragma unroll
                    for (int r = 0; r < 4; ++r) { hq[r] = hv[mt][nt][r] * fast_silu(z[r]); sq[nt] += hq[r] * hq[r]; }
                    hvp[pass][mt][nt].x = pk_bf16(hq[0], hq[1]); hvp[pass][mt][nt].y = pk_bf16(hq[2], hq[3]); }
            }
#pragma unroll
        for (int nt = 0; nt < 4; ++nt) { float s = sq[nt]; s += __shfl_xor(s, 16); s += __shfl_xor(s, 32); if (fq == 0) sqb[irow[nt] * 8 + hh] = s; }
    }
    __syncthreads();
#pragma unroll
    for (int nt = 0; nt < 4; ++nt) {
        const f32x4 s0 = *(LAS f32x4*)(sqb + irow[nt] * 8), s1 = *(LAS f32x4*)(sqb + irow[nt] * 8 + 4);
        const float rs = 1.f / sqrtf(((s0[0] + s0[1]) + (s0[2] + s0[3]) + (s1[0] + s1[1]) + (s1[2] + s1[3])) * (1.f / 512.f) + LN_EPS);
#pragma unroll
        for (int pass = 0; pass < 2; ++pass)
#pragma unroll
            for (int q = 0; q < 2; ++q) { const int ch = (g * 8 + pass * 4 + hl) * HDIM + 32 * q + 8 * fq;
                const f32x4 g0 = *(const f32x4*)(gw + ch), g1 = *(const f32x4*)(gw + ch + 4); const u32x2 ha = hvp[pass][2 * q][nt], hb = hvp[pass][2 * q + 1][nt];
                u32x4 o;
                o.x = pk_bf16(__uint_as_float(ha.x << 16) * rs * g0[0], __uint_as_float(ha.x & 0xffff0000u) * rs * g0[1]); o.y = pk_bf16(__uint_as_float(ha.y << 16) * rs * g0[2], __uint_as_float(ha.y & 0xffff0000u) * rs * g0[3]);
                o.z = pk_bf16(__uint_as_float(hb.x << 16) * rs * g1[0], __uint_as_float(hb.x & 0xffff0000u) * rs * g1[1]); o.w = pk_bf16(__uint_as_float(hb.y << 16) * rs * g1[2], __uint_as_float(hb.y & 0xffff0000u) * rs * g1[3]);
                *(u32x4*)(A2 + (size_t)(R0 + irow[nt]) * DM + ch) = o; }
    }
}

__device__ __forceinline__ void conv_nat64(LAS bf16* dst, int chan0, int R0, int tok0, bool first, const bf16* __restrict__ proj, const float* __restrict__ conv_w, const float* __restrict__ conv_b, int tsk) {
    const int cg = tsk & 15, tb = tsk >> 4, ch = chan0 + 8 * cg, j0 = tok0 + 4 * tb;
    const bf16* src = proj + (size_t)R0 * NPROJ + PX + ch;
    u32x4 row[7];
#pragma unroll
    for (int i = 0; i < 7; ++i) { const int jj = j0 - 3 + i; row[i] = (jj >= 0 || !first) ? *(const u32x4*)(src + (ptrdiff_t)jj * NPROJ) : (u32x4){0u, 0u, 0u, 0u}; }
    float w[4][8], bias[8];
#pragma unroll
    for (int k = 0; k < 4; ++k) { const f32x4 a = *(const f32x4*)(conv_w + k * CONVD + ch), b = *(const f32x4*)(conv_w + k * CONVD + ch + 4);
        w[k][0] = a[0]; w[k][1] = a[1]; w[k][2] = a[2]; w[k][3] = a[3]; w[k][4] = b[0]; w[k][5] = b[1]; w[k][6] = b[2]; w[k][7] = b[3]; }
    { const f32x4 a = *(const f32x4*)(conv_b + ch), b = *(const f32x4*)(conv_b + ch + 4); bias[0] = a[0]; bias[1] = a[1]; bias[2] = a[2]; bias[3] = a[3]; bias[4] = b[0]; bias[5] = b[1]; bias[6] = b[2]; bias[7] = b[3]; }
#pragma unroll
    for (int q = 0; q < 2; ++q) {
        float a0[8], a1[8];
#pragma unroll
        for (int e = 0; e < 8; ++e) { a0[e] = bias[e]; a1[e] = bias[e]; }
#pragma unroll
        for (int k = 0; k < 4; ++k) { const u32x4 v0 = row[2 * q + k], v1 = row[2 * q + 1 + k];
#pragma unroll
            for (int e = 0; e < 4; ++e) { a0[2 * e] += w[k][2 * e] * __uint_as_float(v0[e] << 16); a0[2 * e + 1] += w[k][2 * e + 1] * __uint_as_float(v0[e] & 0xffff0000u);
                                          a1[2 * e] += w[k][2 * e] * __uint_as_float(v1[e] << 16); a1[2 * e + 1] += w[k][2 * e + 1] * __uint_as_float(v1[e] & 0xffff0000u); } }
#pragma unroll
        for (int e = 0; e < 8; ++e) { a0[e] = fast_silu(a0[e]); a1[e] = fast_silu(a1[e]); }
        u32x4 o; o.x = pk_bf16(a0[0], a0[1]); o.y = pk_bf16(a0[2], a0[3]); o.z = pk_bf16(a0[4], a0[5]); o.w = pk_bf16(a0[6], a0[7]);
        *(LAS u32x4*)(dst + (4 * tb + 2 * q) * LDT + 8 * cg) = o;
        o.x = pk_bf16(a1[0], a1[1]); o.y = pk_bf16(a1[2], a1[3]); o.z = pk_bf16(a1[4], a1[5]); o.w = pk_bf16(a1[6], a1[7]);
        *(LAS u32x4*)(dst + (4 * tb + 2 * q + 1) * LDT + 8 * cg) = o;
    }
}

__device__ __forceinline__ void ssd_phaseC_half(LAS unsigned char* lds, int item, const bf16* __restrict__ proj, const float* __restrict__ dt, const float* __restrict__ conv_w, const float* __restrict__ conv_b,
                                                const float* __restrict__ a_log, const float* __restrict__ d_skip, const float* __restrict__ gw, const bf16* __restrict__ s_in, const bf16* __restrict__ xs, bf16* __restrict__ A2) {
    int tid = threadIdx.x; asm volatile("" : "+v"(tid)); const int wid = __builtin_amdgcn_readfirstlane(tid >> 6), lane = tid & 63, fr = lane & 15, fq = lane >> 4;
    const int rh = item & 1, g = (item >> 1) & 1, c = (item >> 2) & 15, b = item >> 6, R0 = b * SEQ + c * 128;
    LAS bf16* RC = (LAS bf16*)(lds + PC_RC); LAS bf16* RG = (LAS bf16*)(lds + PC_RG); LAS bf16* RX = (LAS bf16*)(lds + PC_RX);
    LAS float* dtv = (LAS float*)(lds + PC_SCAL); LAS float* acum = dtv + 8 * 128; LAS float* sqb = (LAS float*)(lds + PC_SQ);
    __syncthreads();
    const char* xsrc = (const char*)(xs + (size_t)((item >> 1) * 2) * (SSD_XT / 2)) + lane * 16;
    PC_XLOAD(0);
    (void)ssd_scalars(dtv, acum, R0, g * 8 + wid, wid, lane, dt, a_log);
    {
        const int half = __builtin_amdgcn_readfirstlane(tid >> 8);
#pragma unroll 1
        for (int rd = 0; rd <= rh; ++rd) {
            if (rd == 0 || half == 0) {
                const bool isC = (rd == 0 && half == 0);
                const int tok0 = (rd == 0) ? 64 * rh : 0;
                conv_nat64(isC ? RC : RG + tok0 * LDT, isC ? SSDW + NGRP * NSTATE + g * NSTATE : SSDW + g * NSTATE, R0, tok0, c == 0, proj, conv_w, conv_b, tid & 255);
            }
        }
    }
    __syncthreads();
    {
        const int it = wid & 3, jh = wid >> 2, gi = 4 * rh + it;
        f32x4 ga[4];
#pragma unroll
        for (int jj = 0; jj < 4; ++jj) ga[jj] = (f32x4){0.f, 0.f, 0.f, 0.f};
#pragma unroll
        for (int ks = 0; ks < 4; ++ks) { const int n0 = 32 * ks + 8 * fq;
            const bf16x8 a = *(LAS bf16x8*)(RC + (16 * it + fr) * LDT + n0);
#pragma unroll
            for (int jj = 0; jj < 4; ++jj) if (4 * jh + jj <= gi) { const bf16x8 bb = *(LAS bf16x8*)(RG + (16 * (4 * jh + jj) + fr) * LDT + n0); ga[jj] = __builtin_amdgcn_mfma_f32_16x16x32_bf16(a, bb, ga[jj], 0, 0, 0); } }
        __syncthreads();
#pragma unroll
        for (int jj = 0; jj < 4; ++jj) if (4 * jh + jj <= gi) {
#pragma unroll
            for (int r = 0; r < 4; ++r) RG[(16 * it + 4 * fq + r) * LDT + 16 * (4 * jh + jj) + fr] = f2bf(ga[jj][r]); }
    }
    u32x2 hvp[2][4][2];
    const int hl = wid >> 1, nh = wid & 1, ksmax = 2 * rh + nh;
    int il[2];
#pragma unroll
    for (int n = 0; n < 2; ++n) il[n] = 32 * nh + 16 * n + fr;
    int prow[4];
#pragma unroll
    for (int mt = 0; mt < 4; ++mt) prow[mt] = 32 * (mt >> 1) + 8 * (fr >> 2) + 4 * (mt & 1) + (fr & 3);
#pragma unroll
    for (int pass = 0; pass < 2; ++pass) {
        asm volatile("s_waitcnt vmcnt(0)" ::: "memory");
        __syncthreads();
        const int hh = pass * 4 + hl, h = g * 8 + hh;
        const float Dh = d_skip[h];
        u32x4 zr[2][2];
#pragma unroll
        for (int q = 0; q < 2; ++q)
#pragma unroll
            for (int n = 0; n < 2; ++n) zr[q][n] = *(const u32x4*)(proj + (size_t)(R0 + 64 * rh + il[n]) * NPROJ + PZ + h * HDIM + 32 * q + 8 * fq);
        bf16x8 sa[4][4];
        if (c > 0) { const bf16* sp = s_in + ((size_t)((b * 16 + c) * 16 + h) * HDIM) * NSTATE;
#pragma unroll
            for (int ks = 0; ks < 4; ++ks)
#pragma unroll
                for (int mt = 0; mt < 4; ++mt) sa[ks][mt] = *(const bf16x8*)(sp + (size_t)prow[mt] * NSTATE + 32 * ks + 8 * fq); }
        float ai[2];
#pragma unroll
        for (int n = 0; n < 2; ++n) ai[n] = acum[hh * 128 + 64 * rh + il[n]];
        f32x4 hv[4][2];
#pragma unroll
        for (int m = 0; m < 4; ++m)
#pragma unroll
            for (int n = 0; n < 2; ++n) hv[m][n] = (f32x4){0.f, 0.f, 0.f, 0.f};
#pragma unroll
        for (int ks = 0; ks < 4; ++ks) {
            if (ks <= ksmax) {
                const int j = 32 * ks + 8 * fq;
                const f32x4 aj0 = *(LAS f32x4*)(acum + hh * 128 + j), aj1 = *(LAS f32x4*)(acum + hh * 128 + j + 4);
                const f32x4 dj0 = *(LAS f32x4*)(dtv + hh * 128 + j), dj1 = *(LAS f32x4*)(dtv + hh * 128 + j + 4);
                bf16x8 sf[2];
#pragma unroll
                for (int n = 0; n < 2; ++n) {
                    const u32x4 raw = *(LAS u32x4*)(RG + il[n] * LDT + j);
                    float v[8];
                    v[0] = __uint_as_float(raw.x << 16); v[1] = __uint_as_float(raw.x & 0xffff0000u); v[2] = __uint_as_float(raw.y << 16); v[3] = __uint_as_float(raw.y & 0xffff0000u);
                    v[4] = __uint_as_float(raw.z << 16); v[5] = __uint_as_float(raw.z & 0xffff0000u); v[6] = __uint_as_float(raw.w << 16); v[7] = __uint_as_float(raw.w & 0xffff0000u);
                    int dd = 64 * rh + il[n] - j; asm volatile("" : "+v"(dd));
#pragma unroll
                    for (int e = 0; e < 8; ++e) { const float aj = e < 4 ? aj0[e & 3] : aj1[e & 3], dj = e < 4 ? dj0[e & 3] : dj1[e & 3];
                        v[e] = (e <= dd) ? v[e] * __expf(ai[n] - aj) * dj : 0.f; }
                    if (ks == ksmax) {
#pragma unroll
                        for (int e = 0; e < 8; ++e) v[e] += (e == dd) ? Dh : 0.f; }
                    u32x4 o; o.x = pk_bf16(v[0], v[1]); o.y = pk_bf16(v[2], v[3]); o.z = pk_bf16(v[4], v[5]); o.w = pk_bf16(v[6], v[7]);
                    sf[n] = __builtin_bit_cast(bf16x8, o);
                }
#pragma unroll
                for (int mt = 0; mt < 4; ++mt) { const bf16x8 a = *(LAS bf16x8*)(RX + (hl * 64 + prow[mt]) * LDT + j);
#pragma unroll
                    for (int n = 0; n < 2; ++n) hv[mt][n] = __builtin_amdgcn_mfma_f32_16x16x32_bf16(a, sf[n], hv[mt][n], 0, 0, 0); }
            }
        }
        if (c > 0) {
            float ei[2];
#pragma unroll
            for (int n = 0; n < 2; ++n) ei[n] = __expf(ai[n]);
#pragma unroll
            for (int ks = 0; ks < 4; ++ks) { const int n0 = 32 * ks + 8 * fq;
                bf16x8 cf[2];
#pragma unroll
                for (int n = 0; n < 2; ++n) { const u32x4 raw = *(LAS u32x4*)(RC + il[n] * LDT + n0); const float e = ei[n];
                    u32x4 o;
                    o.x = pk_bf16(__uint_as_float(raw.x << 16) * e, __uint_as_float(raw.x & 0xffff0000u) * e); o.y = pk_bf16(__uint_as_float(raw.y << 16) * e, __uint_as_float(raw.y & 0xffff0000u) * e);
                    o.z = pk_bf16(__uint_as_float(raw.z << 16) * e, __uint_as_float(raw.z & 0xffff0000u) * e); o.w = pk_bf16(__uint_as_float(raw.w << 16) * e, __uint_as_float(raw.w & 0xffff0000u) * e);
                    cf[n] = __builtin_bit_cast(bf16x8, o); }
#pragma unroll
                for (int mt = 0; mt < 4; ++mt) {
#pragma unroll
                    for (int n = 0; n < 2; ++n) hv[mt][n] = __builtin_amdgcn_mfma_f32_16x16x32_bf16(sa[ks][mt], cf[n], hv[mt][n], 0, 0, 0); }
            }
        }
        if (pass == 0) { __syncthreads(); PC_XLOAD(1); }
        float sq[2] = {0.f, 0.f};
#pragma unroll
        for (int q = 0; q < 2; ++q)
#pragma unroll
            for (int n = 0; n < 2; ++n) {
#pragma unroll
                for (int hf = 0; hf < 2; ++hf) { const int mt = 2 * q + hf; const unsigned z01 = hf ? zr[q][n].z : zr[q][n].x, z23 = hf ? zr[q][n].w : zr[q][n].y;
                    const float z[4] = {__uint_as_float(z01 << 16), __uint_as_float(z01 & 0xffff0000u), __uint_as_float(z23 << 16), __uint_as_float(z23 & 0xffff0000u)};
                    float hq[4];
#pragma unroll
                    for (int r = 0; r < 4; ++r) { hq[r] = hv[mt][n][r] * fast_silu(z[r]); sq[n] += hq[r] * hq[r]; }
                    hvp[pass][mt][n].x = pk_bf16(hq[0], hq[1]); hvp[pass][mt][n].y = pk_bf16(hq[2], hq[3]); }
            }
#pragma unroll
        for (int n = 0; n < 2; ++n) { float s = sq[n]; s += __shfl_xor(s, 16); s += __shfl_xor(s, 32); if (fq == 0) sqb[il[n] * 8 + hh] = s; }
    }
    __syncthreads();
#pragma unroll
    for (int n = 0; n < 2; ++n) {
        const f32x4 s0 = *(LAS f32x4*)(sqb + il[n] * 8), s1 = *(LAS f32x4*)(sqb + il[n] * 8 + 4);
        const float rs = 1.f / sqrtf(((s0[0] + s0[1]) + (s0[2] + s0[3]) + (s1[0] + s1[1]) + (s1[2] + s1[3])) * (1.f / 512.f) + LN_EPS);
#pragma unroll
        for (int pass = 0; pass < 2; ++pass)
#pragma unroll
            for (int q = 0; q < 2; ++q) { const int ch = (g * 8 + pass * 4 + hl) * HDIM + 32 * q + 8 * fq;
                const f32x4 g0 = *(const f32x4*)(gw + ch), g1 = *(const f32x4*)(gw + ch + 4); const u32x2 ha = hvp[pass][2 * q][n], hb = hvp[pass][2 * q + 1][n];
                u32x4 o;
                o.x = pk_bf16(__uint_as_float(ha.x << 16) * rs * g0[0], __uint_as_float(ha.x & 0xffff0000u) * rs * g0[1]); o.y = pk_bf16(__uint_as_float(ha.y << 16) * rs * g0[2], __uint_as_float(ha.y & 0xffff0000u) * rs * g0[3]);
                o.z = pk_bf16(__uint_as_float(hb.x << 16) * rs * g1[0], __uint_as_float(hb.x & 0xffff0000u) * rs * g1[1]); o.w = pk_bf16(__uint_as_float(hb.y << 16) * rs * g1[2], __uint_as_float(hb.y & 0xffff0000u) * rs * g1[3]);
                *(u32x4*)(A2 + (size_t)(R0 + 64 * rh + il[n]) * DM + ch) = o; }
    }
}


__device__ __forceinline__ void ld_row8(const float* __restrict__ p, int lane, f32x4 (&v)[8]) {
#pragma unroll
    for (int k = 0; k < 8; ++k) v[k] = __builtin_nontemporal_load((const f32x4*)(p + 4 * lane + 256 * k));
}
__device__ __forceinline__ void row_stats8(const f32x4 (&v)[8], float& mean, float& rstd) {
    float s = 0.f;
#pragma unroll
    for (int k = 0; k < 8; ++k) s += (v[k][0] + v[k][1]) + (v[k][2] + v[k][3]);
    mean = wave_sum(s) * (1.f / DM);
    float q = 0.f;
#pragma unroll
    for (int k = 0; k < 8; ++k) { const f32x4 d = v[k] - mean; q += (d[0] * d[0] + d[1] * d[1]) + (d[2] * d[2] + d[3] * d[3]); }
    rstd = 1.f / sqrtf(wave_sum(q) * (1.f / DM) + LN_EPS);
}
__device__ __forceinline__ void w_ln_h1_row(int r, int lane, const float* __restrict__ x_prompt, const float* __restrict__ x_sample, const float* __restrict__ g, const float* __restrict__ b,
                                            const float* __restrict__ mod, float* __restrict__ stats, bf16* __restrict__ h1, bf16* __restrict__ xna) {
    const float* xr = r < MP ? x_prompt + (size_t)r * DM : x_sample + (size_t)(r - MP) * DM;
    f32x4 v[8]; ld_row8(xr, lane, v);
    float mean, rstd; row_stats8(v, mean, rstd);
    if (lane == 0) { stats[2 * r] = mean; stats[2 * r + 1] = rstd; }
    const float* mr = mod + (size_t)modrow(r) * NMOD;
#pragma unroll
    for (int k = 0; k < 8; ++k) { const int c = 4 * lane + 256 * k;
        const f32x4 gg = *(const f32x4*)(g + c), bb = *(const f32x4*)(b + c), sc = *(const f32x4*)(mr + DM + c), sh = *(const f32x4*)(mr + c);
        const f32x4 xn = (v[k] - mean) * rstd * gg + bb; const f32x4 o = xn * (sc + 1.f) + sh;
        u32x2 w; w.x = pk_bf16(o[0], o[1]); w.y = pk_bf16(o[2], o[3]); *(u32x2*)(h1 + (size_t)r * DM + c) = w;
        if (xna) { const f32x4 xa = xn * ALPHA; u32x2 w2; w2.x = pk_bf16(xa[0], xa[1]); w2.y = pk_bf16(xa[2], xa[3]); *(u32x2*)(xna + (size_t)r * DM + c) = w2; } }
}
__device__ __forceinline__ void w_ln_mix_row(int r, int lane, const float* __restrict__ x_prompt, const float* __restrict__ x_sample, const float* __restrict__ stats, const float* __restrict__ lg, const float* __restrict__ lb,
                                             const float* __restrict__ mod, const float* __restrict__ mix, const float* __restrict__ slab, const float* __restrict__ g2, const float* __restrict__ b2, float* __restrict__ x1, bf16* __restrict__ h2) {
    const float* xr = r < MP ? x_prompt + (size_t)r * DM : x_sample + (size_t)(r - MP) * DM;
    const float mean0 = stats[2 * r], rstd0 = stats[2 * r + 1];
    const float* mr = mod + (size_t)modrow(r) * NMOD;
    f32x4 v[8];
#pragma unroll
    for (int k = 0; k < 8; ++k) { const int c = 4 * lane + 256 * k;
        const f32x4 xv = *(const f32x4*)(xr + c), gg = *(const f32x4*)(lg + c), bb = *(const f32x4*)(lb + c), gm = *(const f32x4*)(mr + 2 * DM + c); f32x4 mx;
        if (slab && r >= MP) { mx = *(const f32x4*)(slab + (size_t)(r - MP) * DM + c);
#pragma unroll
            for (int s = 1; s < 8; ++s) mx += *(const f32x4*)(slab + (size_t)s * (MS * DM) + (size_t)(r - MP) * DM + c); }
        else mx = *(const f32x4*)(mix + (size_t)r * DM + c);
        const f32x4 xn = (xv - mean0) * rstd0 * gg + bb; v[k] = xn * ALPHA + (gm + 1.f) * mx; }
    float mean, rstd; row_stats8(v, mean, rstd);
#pragma unroll
    for (int k = 0; k < 8; ++k) { const int c = 4 * lane + 256 * k;
        const f32x4 gg = *(const f32x4*)(g2 + c), bb = *(const f32x4*)(b2 + c), sc = *(const f32x4*)(mr + 4 * DM + c), sh = *(const f32x4*)(mr + 3 * DM + c);
        const f32x4 o = (v[k] - mean) * rstd * gg + bb; *(f32x4*)(x1 + (size_t)r * DM + c) = o;
        const f32x4 hh = o * (sc + 1.f) + sh; u32x2 w; w.x = pk_bf16(hh[0], hh[1]); w.y = pk_bf16(hh[2], hh[3]); *(u32x2*)(h2 + (size_t)r * DM + c) = w; }
}
__device__ __forceinline__ void w_ln_out_row(int r, int lane, const float* __restrict__ mod, const float* __restrict__ f, const float* __restrict__ slab, const float* __restrict__ g3, const float* __restrict__ b3, float* __restrict__ xy) {
    const float* mr = mod + (size_t)modrow(r) * NMOD;
    f32x4 v[8];
#pragma unroll
    for (int k = 0; k < 8; ++k) { const int c = 4 * lane + 256 * k;
        const f32x4 xv = *(const f32x4*)(xy + (size_t)r * DM + c), gf = *(const f32x4*)(mr + 5 * DM + c); f32x4 fv;
        if (slab && r >= MP) { fv = *(const f32x4*)(slab + (size_t)(r - MP) * DM + c);
#pragma unroll
            for (int s = 1; s < 8; ++s) fv += *(const f32x4*)(slab + (size_t)s * (MS * DM) + (size_t)(r - MP) * DM + c); }
        else fv = *(const f32x4*)(f + (size_t)r * DM + c);
        v[k] = xv * ALPHA + (gf + 1.f) * fv; }
    float mean, rstd; row_stats8(v, mean, rstd);
#pragma unroll
    for (int k = 0; k < 8; ++k) { const int c = 4 * lane + 256 * k;
        const f32x4 gg = *(const f32x4*)(g3 + c), bb = *(const f32x4*)(b3 + c);
        *(f32x4*)(xy + (size_t)r * DM + c) = (v[k] - mean) * rstd * gg + bb; }
}
__device__ __forceinline__ float fast_gelu(float x) { const float u = 0.7978845608028654f * (x + 0.044715f * x * x * x); const float e = __expf(2.f * u); return x - x * __builtin_amdgcn_rcpf(e + 1.f); }
__device__ __forceinline__ void w_vn_row(int r, int lane, const bf16* __restrict__ proj, const float* __restrict__ g, const float* __restrict__ b, float* __restrict__ vn, float* __restrict__ out) {
    float v[16];
#pragma unroll
    for (int k = 0; k < 2; ++k) { const u32x4 raw = *(const u32x4*)(proj + (size_t)r * NPROJ + PV + 8 * lane + 512 * k);
#pragma unroll
        for (int e = 0; e < 4; ++e) { v[8 * k + 2 * e] = fast_gelu(__uint_as_float(raw[e] << 16)); v[8 * k + 2 * e + 1] = fast_gelu(__uint_as_float(raw[e] & 0xffff0000u)); } }
    float s = 0.f;
#pragma unroll
    for (int e = 0; e < 16; ++e) s += v[e];
    const float mean = wave_sum(s) * (1.f / GMW);
    float q = 0.f;
#pragma unroll
    for (int e = 0; e < 16; ++e) { const float d = v[e] - mean; q += d * d; }
    const float rstd = 1.f / sqrtf(wave_sum(q) * (1.f / GMW) + LN_EPS);
#pragma unroll
    for (int k = 0; k < 2; ++k)
#pragma unroll
        for (int hq = 0; hq < 2; ++hq) { const int c = 8 * lane + 512 * k + 4 * hq;
            const f32x4 gg = *(const f32x4*)(g + c), bb = *(const f32x4*)(b + c);
            f32x4 o;
#pragma unroll
            for (int e = 0; e < 4; ++e) o[e] = (v[8 * k + 4 * hq + e] - mean) * rstd * gg[e] + bb[e];
            *(f32x4*)(vn + (size_t)r * GMW + c) = o; if (r >= MP) *(f32x4*)(out + O_CV + (size_t)(r - MP) * GMW + c) = o; }
}

__device__ __forceinline__ void ld_row_f32x8(const float* __restrict__ p, int lane, float (&v)[4][8]) {
#pragma unroll
    for (int k = 0; k < 4; ++k) { const f32x4 a = *(const f32x4*)(p + 8 * lane + 512 * k), b = *(const f32x4*)(p + 8 * lane + 512 * k + 4);
        v[k][0] = a[0]; v[k][1] = a[1]; v[k][2] = a[2]; v[k][3] = a[3]; v[k][4] = b[0]; v[k][5] = b[1]; v[k][6] = b[2]; v[k][7] = b[3]; }
}
__device__ __forceinline__ void ld_row_bf16x8(const bf16* __restrict__ p, int lane, float (&v)[4][8]) {
#pragma unroll
    for (int k = 0; k < 4; ++k) { const u32x4 raw = __builtin_nontemporal_load((const u32x4*)(p + 8 * lane + 512 * k));
#pragma unroll
        for (int e = 0; e < 4; ++e) { v[k][2 * e] = __uint_as_float(raw[e] << 16); v[k][2 * e + 1] = __uint_as_float(raw[e] & 0xffff0000u); } }
}
__device__ __forceinline__ void row_stats48(const float (&v)[4][8], float& mean, float& rstd) {
    float s = 0.f;
#pragma unroll
    for (int k = 0; k < 4; ++k)
#pragma unroll
        for (int e = 0; e < 8; ++e) s += v[k][e];
    mean = wave_sum(s) * (1.f / DM);
    float q = 0.f;
#pragma unroll
    for (int k = 0; k < 4; ++k)
#pragma unroll
        for (int e = 0; e < 8; ++e) { const float d = v[k][e] - mean; q += d * d; }
    rstd = 1.f / sqrtf(wave_sum(q) * (1.f / DM) + LN_EPS);
}
__device__ __forceinline__ void st_row_bf16x8(bf16* __restrict__ p, int lane, int k, const float (&o)[8]) {
    u32x4 w; w.x = pk_bf16(o[0], o[1]); w.y = pk_bf16(o[2], o[3]); w.z = pk_bf16(o[4], o[5]); w.w = pk_bf16(o[6], o[7]); *(u32x4*)(p + 8 * lane + 512 * k) = w;
}
__device__ __forceinline__ void sum_slabs8(const bf16* __restrict__ slab, int rs, int lane, float (&mx)[4][8]) {
#pragma unroll
    for (int k = 0; k < 4; ++k)
#pragma unroll
        for (int e = 0; e < 8; ++e) mx[k][e] = 0.f;
#pragma unroll 1
    for (int s = 0; s < 8; s += 4) {
        u32x4 raw[4][4];
#pragma unroll
        for (int q = 0; q < 4; ++q)
#pragma unroll
            for (int k = 0; k < 4; ++k) raw[q][k] = __builtin_nontemporal_load((const u32x4*)(slab + (size_t)(s + q) * (MS * DM) + (size_t)rs * DM + 8 * lane + 512 * k));
#pragma unroll
        for (int q = 0; q < 4; ++q)
#pragma unroll
            for (int k = 0; k < 4; ++k)
#pragma unroll
                for (int e = 0; e < 4; ++e) { mx[k][2 * e] += __uint_as_float(raw[q][k][e] << 16); mx[k][2 * e + 1] += __uint_as_float(raw[q][k][e] & 0xffff0000u); } }
}
__device__ __forceinline__ void w_ln_mix3_row(int r, int lane, const float* __restrict__ x_prompt, const float* __restrict__ x_sample, const float* __restrict__ stats, const float* __restrict__ lg, const float* __restrict__ lb,
                                              const float* __restrict__ mod, const bf16* __restrict__ mixb, const bf16* __restrict__ slab, const float* __restrict__ g2, const float* __restrict__ b2,
                                              bf16* __restrict__ X1, int x1_pitch, bf16* __restrict__ h2) {
    const float* xr = r < MP ? x_prompt + (size_t)r * DM : x_sample + (size_t)(r - MP) * DM;
    const float mean0 = stats[2 * r], rstd0 = stats[2 * r + 1];
    const float* mr = mod + (size_t)modrow(r) * NMOD;
    float v[4][8], mx[4][8];
    if (slab && r >= MP) sum_slabs8(slab, r - MP, lane, mx); else ld_row_bf16x8(mixb + (size_t)r * DM, lane, mx);
    ld_row_f32x8(xr, lane, v);
#pragma unroll
    for (int k = 0; k < 4; ++k) { const int c = 8 * lane + 512 * k;
#pragma unroll
        for (int hq = 0; hq < 2; ++hq) { const f32x4 gg = *(const f32x4*)(lg + c + 4 * hq), bb = *(const f32x4*)(lb + c + 4 * hq), gm = *(const f32x4*)(mr + 2 * DM + c + 4 * hq);
#pragma unroll
            for (int e = 0; e < 4; ++e) { const float xn = (v[k][4 * hq + e] - mean0) * rstd0 * gg[e] + bb[e]; v[k][4 * hq + e] = ALPHA * xn + (1.f + gm[e]) * mx[k][4 * hq + e]; } } }
    float mean, rstd; row_stats48(v, mean, rstd);
#pragma unroll
    for (int k = 0; k < 4; ++k) { const int c = 8 * lane + 512 * k; float o[8], hh[8];
#pragma unroll
        for (int hq = 0; hq < 2; ++hq) { const f32x4 gg = *(const f32x4*)(g2 + c + 4 * hq), bb = *(const f32x4*)(b2 + c + 4 * hq), sc = *(const f32x4*)(mr + 4 * DM + c + 4 * hq), sh = *(const f32x4*)(mr + 3 * DM + c + 4 * hq);
#pragma unroll
            for (int e = 0; e < 4; ++e) { o[4 * hq + e] = (v[k][4 * hq + e] - mean) * rstd * gg[e] + bb[e]; hh[4 * hq + e] = o[4 * hq + e] * (1.f + sc[e]) + sh[e]; } }
        st_row_bf16x8(X1 + (size_t)r * x1_pitch, lane, k, o); st_row_bf16x8(h2 + (size_t)r * DM, lane, k, hh); }
}
__device__ __forceinline__ void w_ln_out3_row(int r, int lane, const float* __restrict__ mod, const bf16* X1, int x1_pitch, const bf16* __restrict__ fb, const bf16* __restrict__ slab,
                                              const float* __restrict__ g3, const float* __restrict__ b3, float* y) {
    const float* mr = mod + (size_t)modrow(r) * NMOD;
    float v[4][8], fv[4][8];
    if (slab && r >= MP) sum_slabs8(slab, r - MP, lane, fv); else ld_row_bf16x8(fb + (size_t)r * DM, lane, fv);
    ld_row_bf16x8(X1 + (size_t)r * x1_pitch, lane, v);
#pragma unroll
    for (int k = 0; k < 4; ++k) { const int c = 8 * lane + 512 * k;
#pragma unroll
        for (int hq = 0; hq < 2; ++hq) { const f32x4 gf = *(const f32x4*)(mr + 5 * DM + c + 4 * hq);
#pragma unroll
            for (int e = 0; e < 4; ++e) v[k][4 * hq + e] = ALPHA * v[k][4 * hq + e] + (1.f + gf[e]) * fv[k][4 * hq + e]; } }
    float mean, rstd; row_stats48(v, mean, rstd);
    asm volatile("" ::: "memory");
#pragma unroll
    for (int k = 0; k < 4; ++k) { const int c = 8 * lane + 512 * k;
#pragma unroll
        for (int hq = 0; hq < 2; ++hq) { const f32x4 gg = *(const f32x4*)(g3 + c + 4 * hq), bb = *(const f32x4*)(b3 + c + 4 * hq); f32x4 o;
#pragma unroll
            for (int e = 0; e < 4; ++e) o[e] = (v[k][4 * hq + e] - mean) * rstd * gg[e] + bb[e];
            *(f32x4*)(y + (size_t)r * DM + c + 4 * hq) = o; } }
}

__device__ __forceinline__ void w_ln_h1_proc(int r, int lane, const f32x4 (&v)[8], const float* __restrict__ g, const float* __restrict__ b, const float* __restrict__ mod, float* __restrict__ stats, bf16* __restrict__ h1) {
    float mean, rstd; row_stats8(v, mean, rstd);
    if (lane == 0) { stats[2 * r] = mean; stats[2 * r + 1] = rstd; }
    const float* mr = mod + (size_t)modrow(r) * NMOD;
#pragma unroll
    for (int k = 0; k < 8; ++k) { const int c = 4 * lane + 256 * k;
        const f32x4 gg = *(const f32x4*)(g + c), bb = *(const f32x4*)(b + c), sc = *(const f32x4*)(mr + DM + c), sh = *(const f32x4*)(mr + c);
        const f32x4 xn = (v[k] - mean) * rstd * gg + bb; const f32x4 o = xn * (sc + 1.f) + sh;
        u32x2 w; w.x = pk_bf16(o[0], o[1]); w.y = pk_bf16(o[2], o[3]); *(u32x2*)(h1 + (size_t)r * DM + c) = w; }
}
__device__ __forceinline__ void ld_raw_bf16x8(const bf16* __restrict__ p, int lane, u32x4 (&raw)[4]) {
#pragma unroll
    for (int k = 0; k < 4; ++k) raw[k] = *(const u32x4*)(p + 8 * lane + 512 * k);
}
__device__ __forceinline__ void ld_raw_f32x8(const float* __restrict__ p, int lane, f32x4 (&raw)[8]) {
#pragma unroll
    for (int k = 0; k < 4; ++k) { raw[2 * k] = *(const f32x4*)(p + 8 * lane + 512 * k); raw[2 * k + 1] = *(const f32x4*)(p + 8 * lane + 512 * k + 4); }
}
__device__ __forceinline__ void unpack_bf16x8(const u32x4 (&raw)[4], float (&v)[4][8]) {
#pragma unroll
    for (int k = 0; k < 4; ++k)
#pragma unroll
        for (int e = 0; e < 4; ++e) { v[k][2 * e] = __uint_as_float(raw[k][e] << 16); v[k][2 * e + 1] = __uint_as_float(raw[k][e] & 0xffff0000u); }
}
__device__ __forceinline__ void w_ln_mix3_proc(int r, int lane, const f32x4 (&xraw)[8], const u32x4 (&mraw)[4], const float* __restrict__ stats, const float* __restrict__ lg, const float* __restrict__ lb,
                                               const float* __restrict__ mod, const bf16* __restrict__ slab, const float* __restrict__ g2, const float* __restrict__ b2, bf16* __restrict__ X1, int x1_pitch, bf16* __restrict__ h2) {
    const float mean0 = stats[2 * r], rstd0 = stats[2 * r + 1];
    const float* mr = mod + (size_t)modrow(r) * NMOD;
    float v[4][8], mx[4][8];
    if (slab && r >= MP) sum_slabs8(slab, r - MP, lane, mx); else unpack_bf16x8(mraw, mx);
#pragma unroll
    for (int k = 0; k < 4; ++k) { const int c = 8 * lane + 512 * k;
#pragma unroll
        for (int hq = 0; hq < 2; ++hq) { const f32x4 gg = *(const f32x4*)(lg + c + 4 * hq), bb = *(const f32x4*)(lb + c + 4 * hq), gm = *(const f32x4*)(mr + 2 * DM + c + 4 * hq); const f32x4 xv = xraw[2 * k + hq];
#pragma unroll
            for (int e = 0; e < 4; ++e) { const float xn = (xv[e] - mean0) * rstd0 * gg[e] + bb[e]; v[k][4 * hq + e] = ALPHA * xn + (1.f + gm[e]) * mx[k][4 * hq + e]; } } }
    float mean, rstd; row_stats48(v, mean, rstd);
#pragma unroll
    for (int k = 0; k < 4; ++k) { const int c = 8 * lane + 512 * k; float o[8], hh[8];
#pragma unroll
        for (int hq = 0; hq < 2; ++hq) { const f32x4 gg = *(const f32x4*)(g2 + c + 4 * hq), bb = *(const f32x4*)(b2 + c + 4 * hq), sc = *(const f32x4*)(mr + 4 * DM + c + 4 * hq), sh = *(const f32x4*)(mr + 3 * DM + c + 4 * hq);
#pragma unroll
            for (int e = 0; e < 4; ++e) { o[4 * hq + e] = (v[k][4 * hq + e] - mean) * rstd * gg[e] + bb[e]; hh[4 * hq + e] = o[4 * hq + e] * (1.f + sc[e]) + sh[e]; } }
        st_row_bf16x8(X1 + (size_t)r * x1_pitch, lane, k, o); st_row_bf16x8(h2 + (size_t)r * DM, lane, k, hh); }
}
__device__ __forceinline__ void w_ln_out3_proc(int r, int lane, const u32x4 (&xraw)[4], const u32x4 (&fraw)[4], const float* __restrict__ mod, const bf16* __restrict__ slab,
                                               const float* __restrict__ g3, const float* __restrict__ b3, float* y) {
    const float* mr = mod + (size_t)modrow(r) * NMOD;
    float v[4][8], fv[4][8];
    if (slab && r >= MP) sum_slabs8(slab, r - MP, lane, fv); else unpack_bf16x8(fraw, fv);
    unpack_bf16x8(xraw, v);
#pragma unroll
    for (int k = 0; k < 4; ++k) { const int c = 8 * lane + 512 * k;
#pragma unroll
        for (int hq = 0; hq < 2; ++hq) { const f32x4 gf = *(const f32x4*)(mr + 5 * DM + c + 4 * hq);
#pragma unroll
            for (int e = 0; e < 4; ++e) v[k][4 * hq + e] = ALPHA * v[k][4 * hq + e] + (1.f + gf[e]) * fv[k][4 * hq + e]; } }
    float mean, rstd; row_stats48(v, mean, rstd);
#pragma unroll
    for (int k = 0; k < 4; ++k) { const int c = 8 * lane + 512 * k;
#pragma unroll
        for (int hq = 0; hq < 2; ++hq) { const f32x4 gg = *(const f32x4*)(g3 + c + 4 * hq), bb = *(const f32x4*)(b3 + c + 4 * hq); f32x4 o;
#pragma unroll
            for (int e = 0; e < 4; ++e) o[e] = (v[k][4 * hq + e] - mean) * rstd * gg[e] + bb[e];
            *(f32x4*)(y + (size_t)r * DM + c + 4 * hq) = o; } }
}

__device__ __forceinline__ void w_ln_h1_lds(int r, int lane, const float* __restrict__ xrow, LAS const float* UV, float* __restrict__ stats, bf16* __restrict__ h1) {
    f32x4 v[8]; ld_row8(xrow, lane, v);
    float mean, rstd; row_stats8(v, mean, rstd);
    if (lane == 0) { stats[2 * r] = mean; stats[2 * r + 1] = rstd; }
#pragma unroll
    for (int k = 0; k < 8; ++k) { const int c = 4 * lane + 256 * k;
        const f32x4 U = *(LAS const f32x4*)(UV + c), V = *(LAS const f32x4*)(UV + DM + c);
        const f32x4 o = (v[k] - mean) * rstd * U + V;
        u32x2 w; w.x = pk_bf16(o[0], o[1]); w.y = pk_bf16(o[2], o[3]); *(u32x2*)(h1 + (size_t)r * DM + c) = w; }
}
__device__ __forceinline__ void w_ln_mix3_lds(int r, int lane, const float* __restrict__ xrow, const bf16* __restrict__ mixrow, const float* __restrict__ stats, LAS const float* C, LAS const float* Bt,
                                              bf16* __restrict__ X1row, bf16* __restrict__ h2row) {
    const float mean0 = stats[2 * r], rstd0 = stats[2 * r + 1];
    float v[4][8], mx[4][8];
    ld_row_bf16x8(mixrow, lane, mx);
    ld_row_f32x8(xrow, lane, v);
#pragma unroll
    for (int k = 0; k < 4; ++k) { const int c = 8 * lane + 512 * k;
#pragma unroll
        for (int hq = 0; hq < 2; ++hq) { const f32x4 a1 = *(LAS const f32x4*)(C + c + 4 * hq), b1 = *(LAS const f32x4*)(C + DM + c + 4 * hq), gm = *(LAS const f32x4*)(Bt + c + 4 * hq);
#pragma unroll
            for (int e = 0; e < 4; ++e) v[k][4 * hq + e] = (v[k][4 * hq + e] - mean0) * rstd0 * a1[e] + b1[e] + gm[e] * mx[k][4 * hq + e]; } }
    float mean, rstd; row_stats48(v, mean, rstd);
#pragma unroll
    for (int k = 0; k < 4; ++k) { const int c = 8 * lane + 512 * k; float o[8], hh[8];
#pragma unroll
        for (int hq = 0; hq < 2; ++hq) { const f32x4 gg = *(LAS const f32x4*)(C + 2 * DM + c + 4 * hq), bb = *(LAS const f32x4*)(C + 3 * DM + c + 4 * hq), u2 = *(LAS const f32x4*)(Bt + DM + c + 4 * hq), v2 = *(LAS const f32x4*)(Bt + 2 * DM + c + 4 * hq);
#pragma unroll
            for (int e = 0; e < 4; ++e) { const float t = (v[k][4 * hq + e] - mean) * rstd; o[4 * hq + e] = t * gg[e] + bb[e]; hh[4 * hq + e] = t * u2[e] + v2[e]; } }
        st_row_bf16x8(X1row, lane, k, o); st_row_bf16x8(h2row, lane, k, hh); }
}
__device__ __forceinline__ void w_ln_out3_lds(int r, int lane, const bf16* X1row, const bf16* __restrict__ frow, LAS const float* C, LAS const float* GF, float* yrow, LAS float* tr) {
    float v[4][8], fv[4][8];
    ld_row_bf16x8(frow, lane, fv);
    ld_row_bf16x8(X1row, lane, v);
#pragma unroll
    for (int k = 0; k < 4; ++k) { const int c = 8 * lane + 512 * k;
#pragma unroll
        for (int hq = 0; hq < 2; ++hq) { const f32x4 gf = *(LAS const f32x4*)(GF + c + 4 * hq);
#pragma unroll
            for (int e = 0; e < 4; ++e) v[k][4 * hq + e] = ALPHA * v[k][4 * hq + e] + gf[e] * fv[k][4 * hq + e]; } }
    float mean, rstd; row_stats48(v, mean, rstd);
    asm volatile("" ::: "memory");
#pragma unroll
    for (int k = 0; k < 4; ++k) { const int c = 8 * lane + 512 * k;
        *(LAS f32x4*)(tr + c) = (f32x4){(v[k][0] - mean) * rstd, (v[k][1] - mean) * rstd, (v[k][2] - mean) * rstd, (v[k][3] - mean) * rstd};
        *(LAS f32x4*)(tr + c + 4) = (f32x4){(v[k][4] - mean) * rstd, (v[k][5] - mean) * rstd, (v[k][6] - mean) * rstd, (v[k][7] - mean) * rstd}; }
#pragma unroll
    for (int k = 0; k < 8; ++k) { const int c = 4 * lane + 256 * k;
        const f32x4 t = *(LAS const f32x4*)(tr + c), gg = *(LAS const f32x4*)(C + c), bb = *(LAS const f32x4*)(C + DM + c);
        *(f32x4*)(yrow + c) = t * gg + bb; }
}

typedef float f32x2r __attribute__((ext_vector_type(2)));
__device__ __forceinline__ void wg_row_stats(const f32x4 (&v)[8], LAS f32x2r* red, int wid, int lane, float (&mean)[8], float (&rstd)[8]) {
#pragma unroll
    for (int i = 0; i < 8; ++i) { float s = (v[i][0] + v[i][1]) + (v[i][2] + v[i][3]), q = (v[i][0] * v[i][0] + v[i][1] * v[i][1]) + (v[i][2] * v[i][2] + v[i][3] * v[i][3]);
        s = wave_sum(s); q = wave_sum(q); if (lane == 0) red[i * 8 + wid] = (f32x2r){s, q}; }
    __syncthreads();
#pragma unroll
    for (int i = 0; i < 8; ++i) { float s = 0.f, q = 0.f;
#pragma unroll
        for (int w = 0; w < 8; ++w) { const f32x2r t = red[i * 8 + w]; s += t.x; q += t.y; }
        mean[i] = s * (1.f / DM); rstd[i] = 1.f / sqrtf(fmaxf(q * (1.f / DM) - mean[i] * mean[i], 0.f) + LN_EPS); }
}
__device__ __forceinline__ void wg_ln_h1(int r0, int wid, int lane, const float* __restrict__ x, LAS const float* UV, LAS f32x2r* red, float* __restrict__ stats, bf16* __restrict__ h1) {
    const int c = 256 * wid + 4 * lane;
    const f32x4 U = *(LAS const f32x4*)(UV + c), V = *(LAS const f32x4*)(UV + DM + c);
#pragma unroll 1
    for (int grp = 0; grp < 4; ++grp) { const int rb = r0 + 8 * grp;
        f32x4 v[8];
#pragma unroll
        for (int i = 0; i < 8; ++i) v[i] = *(const f32x4*)(x + (size_t)(rb + i) * DM + c);
        float mean[8], rstd[8]; wg_row_stats(v, red + (grp & 1) * 64, wid, lane, mean, rstd);
        if (wid == 0 && lane < 8) { float m = 0.f, rs = 0.f;
#pragma unroll
            for (int i = 0; i < 8; ++i) { m = lane == i ? mean[i] : m; rs = lane == i ? rstd[i] : rs; }
            stats[2 * (rb + lane)] = m; stats[2 * (rb + lane) + 1] = rs; }
#pragma unroll
        for (int i = 0; i < 8; ++i) { const f32x4 o = (v[i] - mean[i]) * rstd[i] * U + V; u32x2 w; w.x = pk_bf16(o[0], o[1]); w.y = pk_bf16(o[2], o[3]); *(u32x2*)(h1 + (size_t)(rb + i) * DM + c) = w; } }
}
__device__ __forceinline__ void wg_ln_mix(int r0, int wid, int lane, const float* __restrict__ x, const bf16* __restrict__ mixb, const float* __restrict__ stats, LAS const float* Cc, LAS const float* Bt, LAS f32x2r* red,
                                          bf16* __restrict__ X1, int x1_pitch, bf16* __restrict__ h2) {
    const int c = 256 * wid + 4 * lane;
    const f32x4 A1 = *(LAS const f32x4*)(Cc + c), B1 = *(LAS const f32x4*)(Cc + DM + c), G2 = *(LAS const f32x4*)(Cc + 2 * DM + c), B2 = *(LAS const f32x4*)(Cc + 3 * DM + c);
    const f32x4 GM = *(LAS const f32x4*)(Bt + c), U2 = *(LAS const f32x4*)(Bt + DM + c), V2 = *(LAS const f32x4*)(Bt + 2 * DM + c);
#pragma unroll 1
    for (int grp = 0; grp < 4; ++grp) { const int rb = r0 + 8 * grp;
        f32x4 v[8]; u32x2 mr[8];
#pragma unroll
        for (int i = 0; i < 8; ++i) { v[i] = *(const f32x4*)(x + (size_t)(rb + i) * DM + c); mr[i] = *(const u32x2*)(mixb + (size_t)(rb + i) * DM + c); }
#pragma unroll
        for (int i = 0; i < 8; ++i) { const float m0 = stats[2 * (rb + i)], s0 = stats[2 * (rb + i) + 1];
            const f32x4 mx = (f32x4){__uint_as_float(mr[i].x << 16), __uint_as_float(mr[i].x & 0xffff0000u), __uint_as_float(mr[i].y << 16), __uint_as_float(mr[i].y & 0xffff0000u)};
            v[i] = (v[i] - m0) * s0 * A1 + B1 + GM * mx; }
        float mean[8], rstd[8]; wg_row_stats(v, red + (grp & 1) * 64, wid, lane, mean, rstd);
#pragma unroll
        for (int i = 0; i < 8; ++i) { const f32x4 t = (v[i] - mean[i]) * rstd[i]; const f32x4 o = t * G2 + B2, hh = t * U2 + V2;
            u32x2 w; w.x = pk_bf16(o[0], o[1]); w.y = pk_bf16(o[2], o[3]); *(u32x2*)(X1 + (size_t)(rb + i) * x1_pitch + c) = w;
            u32x2 w2; w2.x = pk_bf16(hh[0], hh[1]); w2.y = pk_bf16(hh[2], hh[3]); *(u32x2*)(h2 + (size_t)(rb + i) * DM + c) = w2; } }
}
__device__ __forceinline__ void wg_ln_out(int r0, int wid, int lane, const bf16* X1, int x1_pitch, const bf16* __restrict__ fb, LAS const float* Cc, LAS const float* GFp, LAS f32x2r* red, float* y) {
    const int c = 256 * wid + 4 * lane;
    const f32x4 G3 = *(LAS const f32x4*)(Cc + c), B3 = *(LAS const f32x4*)(Cc + DM + c), GF = *(LAS const f32x4*)(GFp + c);
#pragma unroll 1
    for (int grp = 0; grp < 4; ++grp) { const int rb = r0 + 8 * grp;
        f32x4 v[8]; u32x2 xr[8], fr[8];
#pragma unroll
        for (int i = 0; i < 8; ++i) { xr[i] = *(const u32x2*)(X1 + (size_t)(rb + i) * x1_pitch + c); fr[i] = *(const u32x2*)(fb + (size_t)(rb + i) * DM + c); }
#pragma unroll
        for (int i = 0; i < 8; ++i) { const f32x4 x1 = (f32x4){__uint_as_float(xr[i].x << 16), __uint_as_float(xr[i].x & 0xffff0000u), __uint_as_float(xr[i].y << 16), __uint_as_float(xr[i].y & 0xffff0000u)};
            const f32x4 fv = (f32x4){__uint_as_float(fr[i].x << 16), __uint_as_float(fr[i].x & 0xffff0000u), __uint_as_float(fr[i].y << 16), __uint_as_float(fr[i].y & 0xffff0000u)};
            v[i] = x1 * ALPHA + GF * fv; }
        float mean[8], rstd[8]; wg_row_stats(v, red + (grp & 1) * 64, wid, lane, mean, rstd);
#pragma unroll
        for (int i = 0; i < 8; ++i) *(f32x4*)(y + (size_t)(rb + i) * DM + c) = (v[i] - mean[i]) * rstd[i] * G3 + B3; }
}


__device__ __forceinline__ void w_vstats_row(int r, int lane, const bf16* __restrict__ proj, const float* __restrict__ g, const float* __restrict__ b, float* __restrict__ vstats, float* __restrict__ out) {
    float v[16];
#pragma unroll
    for (int k = 0; k < 2; ++k) { const u32x4 raw = *(const u32x4*)(proj + (size_t)r * NPROJ + PV + 8 * lane + 512 * k);
#pragma unroll
        for (int e = 0; e < 4; ++e) { v[8 * k + 2 * e] = fast_gelu(__uint_as_float(raw[e] << 16)); v[8 * k + 2 * e + 1] = fast_gelu(__uint_as_float(raw[e] & 0xffff0000u)); } }
    float s = 0.f;
#pragma unroll
    for (int e = 0; e < 16; ++e) s += v[e];
    const float mean = wave_sum(s) * (1.f / GMW);
    float q = 0.f;
#pragma unroll
    for (int e = 0; e < 16; ++e) { const float d = v[e] - mean; q += d * d; }
    const float rstd = 1.f / sqrtf(wave_sum(q) * (1.f / GMW) + LN_EPS);
    if (lane == 0) { vstats[2 * r] = mean; vstats[2 * r + 1] = rstd; }
    if (r >= MP) {
#pragma unroll
        for (int k = 0; k < 2; ++k)
#pragma unroll
            for (int hq = 0; hq < 2; ++hq) { const int c = 8 * lane + 512 * k + 4 * hq;
                const f32x4 gg = *(const f32x4*)(g + c), bb = *(const f32x4*)(b + c);
                f32x4 o;
#pragma unroll
                for (int e = 0; e < 4; ++e) o[e] = (v[8 * k + 4 * hq + e] - mean) * rstd * gg[e] + bb[e];
                *(f32x4*)(out + O_CV + (size_t)(r - MP) * GMW + c) = o; }
    }
}
__device__ __forceinline__ void w_gmlp_ln_row(int r, int lane, bf16* proj, const float* __restrict__ g, const float* __restrict__ b, float* __restrict__ out) {
    float v[16];
#pragma unroll
    for (int k = 0; k < 2; ++k) { const u32x4 raw = __builtin_nontemporal_load((const u32x4*)(proj + (size_t)r * NPROJ + PV + 8 * lane + 512 * k));
#pragma unroll
        for (int e = 0; e < 4; ++e) { v[8 * k + 2 * e] = fast_gelu(__uint_as_float(raw[e] << 16)); v[8 * k + 2 * e + 1] = fast_gelu(__uint_as_float(raw[e] & 0xffff0000u)); } }
    float s = 0.f;
#pragma unroll
    for (int e = 0; e < 16; ++e) s += v[e];
    const float mean = wave_sum(s) * (1.f / GMW);
    float q = 0.f;
#pragma unroll
    for (int e = 0; e < 16; ++e) { const float d = v[e] - mean; q += d * d; }
    const float rstd = 1.f / sqrtf(wave_sum(q) * (1.f / GMW) + LN_EPS);
#pragma unroll
    for (int k = 0; k < 2; ++k) { const int c = 8 * lane + 512 * k;
        const f32x4 g0 = *(const f32x4*)(g + c), g1 = *(const f32x4*)(g + c + 4), b0 = *(const f32x4*)(b + c), b1 = *(const f32x4*)(b + c + 4);
        f32x4 o0, o1;
#pragma unroll
        for (int e = 0; e < 4; ++e) { o0[e] = (v[8 * k + e] - mean) * rstd * g0[e] + b0[e]; o1[e] = (v[8 * k + 4 + e] - mean) * rstd * g1[e] + b1[e]; }
        if (r >= MP) { *(f32x4*)(out + O_CV + (size_t)(r - MP) * GMW + c) = o0; *(f32x4*)(out + O_CV + (size_t)(r - MP) * GMW + c + 4) = o1; }
        else { u32x4 w; w.x = pk_bf16(o0[0], o0[1]); w.y = pk_bf16(o0[2], o0[3]); w.z = pk_bf16(o1[0], o1[1]); w.w = pk_bf16(o1[2], o1[3]); *(u32x4*)(proj + (size_t)r * NPROJ + PV + c) = w; } }
}
__device__ __forceinline__ void gmlp_group(LAS unsigned char* lds, int hd, int bc0, int bcs, int cnt, const bf16* __restrict__ proj, const float* __restrict__ w_s, const float* __restrict__ b_s, bf16* __restrict__ A2) {
    int tid = threadIdx.x; asm volatile("" : "+v"(tid)); const int wid = __builtin_amdgcn_readfirstlane(tid >> 6), lane = tid & 63, fr = lane & 15, fq = lane >> 4;
    LAS bf16* Wl = (LAS bf16*)(lds + 2 * SSD_IMG);
    const int dq = wid & 3, ih = wid >> 2, dg = tid >> 5, tb = tid & 31;
    const bf16* vsrc = proj + (size_t)(4 * tb) * NPROJ + PV + hd * GMHD + 8 * dg;
    u32x4 raw[4];
#pragma unroll
    for (int t = 0; t < 4; ++t) raw[t] = *(const u32x4*)(vsrc + (size_t)(bc0 * 128 + t) * NPROJ);
    float bs[4];
#pragma unroll
    for (int n = 0; n < 4; ++n) bs[n] = b_s[hd * 128 + 16 * (2 * n + ih) + fr];
    __syncthreads();
    {
        const int i = tid >> 2, j0 = (tid & 3) * 32; const float* wp = w_s + ((size_t)hd * 128 + i) * 128 + j0;
#pragma unroll
        for (int q = 0; q < 4; ++q) { const f32x4 a = *(const f32x4*)(wp + 8 * q), c = *(const f32x4*)(wp + 8 * q + 4); const int j = j0 + 8 * q;
            u32x4 w; w.x = pk_bf16(j <= i ? a[0] : 0.f, j + 1 <= i ? a[1] : 0.f); w.y = pk_bf16(j + 2 <= i ? a[2] : 0.f, j + 3 <= i ? a[3] : 0.f);
            w.z = pk_bf16(j + 4 <= i ? c[0] : 0.f, j + 5 <= i ? c[1] : 0.f); w.w = pk_bf16(j + 6 <= i ? c[2] : 0.f, j + 7 <= i ? c[3] : 0.f);
            *(LAS u32x4*)(Wl + i * LDT + j) = w; }
    }
    int prow[2];
#pragma unroll
    for (int mt = 0; mt < 2; ++mt) prow[mt] = 32 * dq + 8 * (fr >> 2) + 4 * mt + (fr & 3);
    const bf16* usrc = proj + (size_t)(16 * ih + fr) * NPROJ + PU + hd * GMHD + 32 * dq + 8 * fq;
    bf16* dsto = A2 + (size_t)(16 * ih + fr) * DM + SSDW + hd * GMHD + 32 * dq + 8 * fq;
#pragma unroll 1
    for (int k = 0; k < cnt; ++k) {
        const int R0 = (bc0 + k * bcs) * 128;
        LAS bf16* vT = (LAS bf16*)(lds + (k & 1) * SSD_IMG);
#pragma unroll
        for (int e = 0; e < 4; ++e) { u32x2 w;
            w.x = __builtin_amdgcn_perm(raw[1][e], raw[0][e], 0x05040100u); w.y = __builtin_amdgcn_perm(raw[3][e], raw[2][e], 0x05040100u); *(LAS u32x2*)(vT + (8 * dg + 2 * e) * LDT + 4 * tb) = w;
            w.x = __builtin_amdgcn_perm(raw[1][e], raw[0][e], 0x07060302u); w.y = __builtin_amdgcn_perm(raw[3][e], raw[2][e], 0x07060302u); *(LAS u32x2*)(vT + (8 * dg + 2 * e + 1) * LDT + 4 * tb) = w; }
        if (k + 1 < cnt) {
#pragma unroll
            for (int t = 0; t < 4; ++t) raw[t] = *(const u32x4*)(vsrc + (size_t)(R0 + bcs * 128 + t) * NPROJ); }
        u32x4 ur[4];
#pragma unroll
        for (int n = 0; n < 4; ++n) ur[n] = *(const u32x4*)(usrc + (size_t)(R0 + 32 * n) * NPROJ);
        __syncthreads();
        f32x4 acc[2][4];
#pragma unroll
        for (int mt = 0; mt < 2; ++mt)
#pragma unroll
            for (int n = 0; n < 4; ++n) acc[mt][n] = (f32x4){0.f, 0.f, 0.f, 0.f};
#pragma unroll
        for (int ks = 0; ks < 4; ++ks) { const int j = 32 * ks + 8 * fq;
            const bf16x8 a0 = *(LAS bf16x8*)(vT + prow[0] * LDT + j), a1 = *(LAS bf16x8*)(vT + prow[1] * LDT + j);
#pragma unroll
            for (int n = 0; n < 4; ++n) if (32 * ks <= 16 * (2 * n + 1) + 15 && (32 * ks <= 16 * (2 * n) + 15 || ih == 1)) { const bf16x8 bw = *(LAS bf16x8*)(Wl + (16 * (2 * n + ih) + fr) * LDT + j);
                acc[0][n] = __builtin_amdgcn_mfma_f32_16x16x32_bf16(a0, bw, acc[0][n], 0, 0, 0); acc[1][n] = __builtin_amdgcn_mfma_f32_16x16x32_bf16(a1, bw, acc[1][n], 0, 0, 0); } }
#pragma unroll
        for (int n = 0; n < 4; ++n) {
            const float u0 = fast_gelu(__uint_as_float(ur[n].x << 16)), u1 = fast_gelu(__uint_as_float(ur[n].x & 0xffff0000u)), u2 = fast_gelu(__uint_as_float(ur[n].y << 16)), u3 = fast_gelu(__uint_as_float(ur[n].y & 0xffff0000u));
            const float u4 = fast_gelu(__uint_as_float(ur[n].z << 16)), u5 = fast_gelu(__uint_as_float(ur[n].z & 0xffff0000u)), u6 = fast_gelu(__uint_as_float(ur[n].w << 16)), u7 = fast_gelu(__uint_as_float(ur[n].w & 0xffff0000u));
            u32x4 o; o.x = pk_bf16(u0 * (acc[0][n][0] + bs[n]), u1 * (acc[0][n][1] + bs[n])); o.y = pk_bf16(u2 * (acc[0][n][2] + bs[n]), u3 * (acc[0][n][3] + bs[n]));
            o.z = pk_bf16(u4 * (acc[1][n][0] + bs[n]), u5 * (acc[1][n][1] + bs[n])); o.w = pk_bf16(u6 * (acc[1][n][2] + bs[n]), u7 * (acc[1][n][3] + bs[n]));
            *(u32x4*)(dsto + (size_t)(R0 + 32 * n) * DM) = o; }
    }
}
__device__ __forceinline__ void gmlp_sample_item(int bs, const bf16* __restrict__ proj, const float* __restrict__ vn_s, const float* __restrict__ w_s, const float* __restrict__ b_s, bf16* __restrict__ A2) {
    int tid = threadIdx.x; asm volatile("" : "+v"(tid));
    const int c0 = 2 * tid, hd = c0 >> 7, R0 = MP + bs * DSEQ;
    float v[8][2];
#pragma unroll
    for (int j = 0; j < 8; ++j) { const float2 t = *(const float2*)(vn_s + (size_t)(bs * DSEQ + j) * GMW + c0); v[j][0] = t.x; v[j][1] = t.y; }
#pragma unroll
    for (int i = 0; i < 8; ++i) { float a0 = 0.f, a1 = 0.f;
#pragma unroll
        for (int j = 0; j <= i; ++j) { const float w = w_s[((size_t)hd * 128 + i) * 128 + j]; a0 += w * v[j][0]; a1 += w * v[j][1]; }
        const float bsv = b_s[hd * 128 + i];
        const unsigned ur = *(const unsigned*)(proj + (size_t)(R0 + i) * NPROJ + PU + c0);
        const float u0 = fast_gelu(__uint_as_float(ur << 16)), u1 = fast_gelu(__uint_as_float(ur & 0xffff0000u));
        *(unsigned*)(A2 + (size_t)(R0 + i) * DM + SSDW + c0) = pk_bf16(u0 * (a0 + bsv), u1 * (a1 + bsv)); }
}


__device__ __forceinline__ void p0_transpose_item(const float* __restrict__ W, int K, int ld, int nblk, bf16* __restrict__ WT, LAS float* scr, int item, int lane) {
    const int kb = item / nblk, nb = item % nblk, k0 = 64 * kb, n0 = 32 * nb;
    float tv[32];
#pragma unroll
    for (int i = 0; i < 32; ++i) { const int kk = 2 * i + (lane >> 5); tv[i] = __builtin_nontemporal_load(W + (size_t)(k0 + kk) * ld + n0 + (lane & 31)); }
#pragma unroll
    for (int i = 0; i < 32; ++i) { const int kk = 2 * i + (lane >> 5); scr[kk * 33 + (lane & 31)] = tv[i]; }
    asm volatile("s_waitcnt lgkmcnt(0)" ::: "memory");
    const int c = lane & 7;
#pragma unroll
    for (int j = 0; j < 4; ++j) { const int n = (lane >> 3) + 8 * j; const LAS float* s = scr + (8 * c) * 33 + n;
        u32x4 o; o.x = pk_bf16(s[0 * 33], s[1 * 33]); o.y = pk_bf16(s[2 * 33], s[3 * 33]); o.z = pk_bf16(s[4 * 33], s[5 * 33]); o.w = pk_bf16(s[6 * 33], s[7 * 33]);
        *(u32x4*)(WT + (size_t)(n0 + n) * K + k0 + 8 * c) = o; }
    asm volatile("s_waitcnt lgkmcnt(0)" ::: "memory");
}
constexpr int MOD_LDW = 136, MOD_WBUF = 48 * MOD_LDW * 2;
__device__ __forceinline__ void mod_item(LAS unsigned char* lds, int item, const bf16* __restrict__ csilu, const float* __restrict__ w_mod, const float* __restrict__ b_mod, float* __restrict__ mod) {
    int tid = threadIdx.x; asm volatile("" : "+v"(tid)); const int wid = __builtin_amdgcn_readfirstlane(tid >> 6), lane = tid & 63, fr = lane & 15, fq = lane >> 4;
    const int n0 = 48 * item;
    __syncthreads();
    const bool stg = tid < 384;
    const int sn4 = tid % 12, skq = tid / 12;
    const float* wsrc = w_mod + (size_t)(4 * skq) * NMOD + n0 + 4 * sn4;
    f32x4 pre[4][4];
    if (stg) {
#pragma unroll
        for (int u = 0; u < 4; ++u)
#pragma unroll
            for (int j = 0; j < 4; ++j) pre[u][j] = __builtin_nontemporal_load((const f32x4*)(wsrc + (size_t)(128 * u + j) * NMOD)); }
    constexpr int ALD = 136, ABUF = 132 * ALD * 2;
    LAS unsigned char* abase = lds + 2 * MOD_WBUF;
    u32x4 areg[5];
#define MOD_ALOAD(kcn) do { _Pragma("unroll") for (int i_ = 0; i_ < 5; ++i_) { const int p_ = tid + 512 * i_; if (p_ < 132 * 16) areg[i_] = *(const u32x4*)(csilu + (size_t)(p_ >> 4) * DM + 128 * (kcn) + 8 * (p_ & 15)); } } while (0)
    MOD_ALOAD(0);
    f32x4 acc[3], acc9[3];
#pragma unroll
    for (int nt = 0; nt < 3; ++nt) { acc[nt] = (f32x4){0.f, 0.f, 0.f, 0.f}; acc9[nt] = (f32x4){0.f, 0.f, 0.f, 0.f}; }
#pragma unroll 1
    for (int kc4 = 0; kc4 < 16; kc4 += 4) {
#pragma unroll
      for (int u = 0; u < 4; ++u) { const int kc = kc4 + u;
        LAS bf16* Wb = (LAS bf16*)(lds + (u & 1) * MOD_WBUF); LAS bf16* Ab = (LAS bf16*)(abase + (u & 1) * ABUF);
#pragma unroll
        for (int i_ = 0; i_ < 5; ++i_) { const int p_ = tid + 512 * i_; if (p_ < 132 * 16) *(LAS u32x4*)(Ab + (p_ >> 4) * ALD + 8 * (p_ & 15)) = areg[i_]; }
        if (kc < 15) MOD_ALOAD(kc + 1);
        if (stg) {
#pragma unroll
            for (int e = 0; e < 4; ++e) { u32x2 w; w.x = pk_bf16(pre[u][0][e], pre[u][1][e]); w.y = pk_bf16(pre[u][2][e], pre[u][3][e]); *(LAS u32x2*)(Wb + (4 * sn4 + e) * MOD_LDW + 4 * skq) = w; }
            if (kc < 12) {
#pragma unroll
                for (int j = 0; j < 4; ++j) pre[u][j] = __builtin_nontemporal_load((const f32x4*)(wsrc + (size_t)(128 * (kc + 4) + j) * NMOD)); }
        }
        __syncthreads();
#pragma unroll
        for (int ks = 0; ks < 4; ++ks) {
            const int kk = 32 * ks + 8 * fq;
            const bf16x8 afr = *(LAS bf16x8*)(Ab + (16 * wid + fr) * ALD + kk);
            bf16x8 bfr[3];
#pragma unroll
            for (int nt = 0; nt < 3; ++nt) bfr[nt] = *(LAS bf16x8*)(Wb + (16 * nt + fr) * MOD_LDW + kk);
#pragma unroll
            for (int nt = 0; nt < 3; ++nt) acc[nt] = __builtin_amdgcn_mfma_f32_16x16x32_bf16(afr, bfr[nt], acc[nt], 0, 0, 0);
            if (((4 * kc + ks) & 7) == wid) {
                u32x4 ep = (u32x4){0u, 0u, 0u, 0u};
                if (fr < 4) ep = *(LAS u32x4*)(Ab + (128 + fr) * ALD + kk);
                const bf16x8 ef = __builtin_bit_cast(bf16x8, ep);
#pragma unroll
                for (int nt = 0; nt < 3; ++nt) acc9[nt] = __builtin_amdgcn_mfma_f32_16x16x32_bf16(ef, bfr[nt], acc9[nt], 0, 0, 0);
            }
        }
      }
    }
#undef MOD_ALOAD
#pragma unroll
    for (int nt = 0; nt < 3; ++nt) { const int n = n0 + 16 * nt + fr; const float bb = b_mod[n];
#pragma unroll
        for (int r = 0; r < 4; ++r) mod[(size_t)(16 * wid + 4 * fq + r) * NMOD + n] = acc[nt][r] + bb; }
    __syncthreads();
    LAS float* red = (LAS float*)(lds + 2 * MOD_WBUF + 2 * ABUF);
    if (fq == 0) {
#pragma unroll
        for (int nt = 0; nt < 3; ++nt) *(LAS f32x4*)(red + ((wid * 3 + nt) * 16 + fr) * 4) = acc9[nt]; }
    __syncthreads();
    if (tid < 192) { const int nt = tid >> 6, f = (tid >> 2) & 15, r = tid & 3; float s = 0.f;
#pragma unroll
        for (int w = 0; w < 8; ++w) s += red[((w * 3 + nt) * 16 + f) * 4 + r];
        const int n = n0 + 16 * nt + f; mod[(size_t)(128 + r) * NMOD + n] = s + b_mod[n]; }
}


constexpr int SM_XS = 0, SM_BS = 16384, SM_CS = 20480, SM_G = 24576, SM_SQ = 24832, SM_END = 25088;
__device__ __forceinline__ void sample_ssd_item(LAS unsigned char* lds, int item, const bf16* __restrict__ proj, const float* __restrict__ dt, const float* __restrict__ state_conv, const float* __restrict__ conv_w,
                                                const float* __restrict__ conv_b, const float* __restrict__ a_log, const float* __restrict__ d_skip, const float* __restrict__ gw, const float* __restrict__ state_ssm,
                                                bf16* __restrict__ A2, float* __restrict__ out) {
    int tid = threadIdx.x; asm volatile("" : "+v"(tid)); const int wid = __builtin_amdgcn_readfirstlane(tid >> 6), lane = tid & 63, fr = lane & 15, fq = lane >> 4;
    const int bs = item >> 1, g = item & 1, R0 = MP + bs * DSEQ, h = g * 8 + wid;
    LAS float* xs = (LAS float*)(lds + SM_XS); LAS float* Bs = (LAS float*)(lds + SM_BS); LAS float* Cs = (LAS float*)(lds + SM_CS); LAS float* Gl = (LAS float*)(lds + SM_G); LAS float* sqb = (LAS float*)(lds + SM_SQ);
    __syncthreads();
#define SM_LOAD_XP_ROW(dstv, pos, chn) do { if ((pos) < 3) { const float* sp_ = state_conv + ((size_t)bs * 3 + (pos)) * CONVD + (chn); const f32x4 a_ = *(const f32x4*)sp_, b_ = *(const f32x4*)(sp_ + 4); \
            dstv[0] = a_[0]; dstv[1] = a_[1]; dstv[2] = a_[2]; dstv[3] = a_[3]; dstv[4] = b_[0]; dstv[5] = b_[1]; dstv[6] = b_[2]; dstv[7] = b_[3]; } \
        else { const u32x4 q_ = *(const u32x4*)(proj + (size_t)(R0 + (pos) - 3) * NPROJ + PX + (chn)); \
            _Pragma("unroll") for (int e_ = 0; e_ < 4; ++e_) { dstv[2 * e_] = __uint_as_float(q_[e_] << 16); dstv[2 * e_ + 1] = __uint_as_float(q_[e_] & 0xffff0000u); } } } while (0)
#define SM_CONV_TASK(chn, dstp) do { const int ch_ = (chn); float r_[4][8]; \
        _Pragma("unroll") for (int k = 0; k < 4; ++k) SM_LOAD_XP_ROW(r_[k], wid + k, ch_); \
        float o_[8]; { const f32x4 a_ = *(const f32x4*)(conv_b + ch_), b_ = *(const f32x4*)(conv_b + ch_ + 4); o_[0] = a_[0]; o_[1] = a_[1]; o_[2] = a_[2]; o_[3] = a_[3]; o_[4] = b_[0]; o_[5] = b_[1]; o_[6] = b_[2]; o_[7] = b_[3]; } \
        _Pragma("unroll") for (int k = 0; k < 4; ++k) { const f32x4 a_ = *(const f32x4*)(conv_w + k * CONVD + ch_), b_ = *(const f32x4*)(conv_w + k * CONVD + ch_ + 4); \
            o_[0] += a_[0] * r_[k][0]; o_[1] += a_[1] * r_[k][1]; o_[2] += a_[2] * r_[k][2]; o_[3] += a_[3] * r_[k][3]; o_[4] += b_[0] * r_[k][4]; o_[5] += b_[1] * r_[k][5]; o_[6] += b_[2] * r_[k][6]; o_[7] += b_[3] * r_[k][7]; } \
        LAS float* d_ = (dstp); *(LAS f32x4*)d_ = (f32x4){fast_silu(o_[0]), fast_silu(o_[1]), fast_silu(o_[2]), fast_silu(o_[3])}; *(LAS f32x4*)(d_ + 4) = (f32x4){fast_silu(o_[4]), fast_silu(o_[5]), fast_silu(o_[6]), fast_silu(o_[7])}; \
        if (wid >= 5) { float* c_ = out + O_CONVS + ((size_t)bs * 3 + (wid - 5)) * CONVD + ch_; *(f32x4*)c_ = (f32x4){r_[3][0], r_[3][1], r_[3][2], r_[3][3]}; *(f32x4*)(c_ + 4) = (f32x4){r_[3][4], r_[3][5], r_[3][6], r_[3][7]}; } } while (0)
    SM_CONV_TASK(g * 512 + 8 * lane, xs + wid * 512 + 8 * lane);
    { const int cg = lane & 31;
      SM_CONV_TASK(cg < 16 ? SSDW + g * NSTATE + 8 * cg : SSDW + NGRP * NSTATE + g * NSTATE + 8 * (cg - 16), (cg < 16 ? Bs + 8 * cg : Cs + 8 * (cg - 16)) + wid * 128); }
#undef SM_CONV_TASK
#undef SM_LOAD_XP_ROW
    const float* sp = state_ssm + ((size_t)(bs * NHEAD + h) * HDIM) * NSTATE;
    f32x4 S[4][4][2];
#pragma unroll
    for (int mt = 0; mt < 4; ++mt)
#pragma unroll
        for (int ks = 0; ks < 4; ++ks) { const float* q = sp + (size_t)(16 * mt + fr) * NSTATE + 32 * ks + 8 * fq; S[mt][ks][0] = __builtin_nontemporal_load((const f32x4*)q); S[mt][ks][1] = __builtin_nontemporal_load((const f32x4*)(q + 4)); }
    const float A = -__expf(a_log[h]), Dh = d_skip[h];
    float dtv[8], ac[8];
    { float run = 0.f;
#pragma unroll
      for (int t = 0; t < 8; ++t) { dtv[t] = dt[(size_t)(R0 + t) * 16 + h]; run += dtv[t] * A; ac[t] = run; } }
    __syncthreads();
    if (tid < 64) { const int t = tid >> 3, s = tid & 7; float a = 0.f;
        for (int n = 0; n < NSTATE; n += 4) { const f32x4 cv = *(LAS f32x4*)(Cs + t * 128 + n), bv = *(LAS f32x4*)(Bs + s * 128 + n); a += (cv[0] * bv[0] + cv[1] * bv[1]) + (cv[2] * bv[2] + cv[3] * bv[3]); }
        Gl[t * 8 + s] = a; }
    __syncthreads();
    f32x4 yacc[4];
#pragma unroll
    for (int mt = 0; mt < 4; ++mt) yacc[mt] = (f32x4){0.f, 0.f, 0.f, 0.f};
    float act_ = 0.f;
#pragma unroll
    for (int t = 0; t < 8; ++t) act_ = fr == t ? ac[t] : act_;
    const float et = __expf(act_);
#pragma unroll
    for (int ks = 0; ks < 4; ++ks) {
        u32x4 cp = (u32x4){0u, 0u, 0u, 0u};
        if (fr < 8) { const f32x4 c0 = *(LAS f32x4*)(Cs + fr * 128 + 32 * ks + 8 * fq), c1 = *(LAS f32x4*)(Cs + fr * 128 + 32 * ks + 8 * fq + 4);
            cp.x = pk_bf16(c0[0] * et, c0[1] * et); cp.y = pk_bf16(c0[2] * et, c0[3] * et); cp.z = pk_bf16(c1[0] * et, c1[1] * et); cp.w = pk_bf16(c1[2] * et, c1[3] * et); }
        const bf16x8 cf = __builtin_bit_cast(bf16x8, cp);
#pragma unroll
        for (int mt = 0; mt < 4; ++mt) { u32x4 sp4; sp4.x = pk_bf16(S[mt][ks][0][0], S[mt][ks][0][1]); sp4.y = pk_bf16(S[mt][ks][0][2], S[mt][ks][0][3]); sp4.z = pk_bf16(S[mt][ks][1][0], S[mt][ks][1][1]); sp4.w = pk_bf16(S[mt][ks][1][2], S[mt][ks][1][3]);
            yacc[mt] = __builtin_amdgcn_mfma_f32_16x16x32_bf16(__builtin_bit_cast(bf16x8, sp4), cf, yacc[mt], 0, 0, 0); }
    }
    {
        u32x4 gp = (u32x4){0u, 0u, 0u, 0u};
        if (fq == 0 && fr < 8) { float gd[8];
#pragma unroll
            for (int s = 0; s < 8; ++s) gd[s] = s <= fr ? Gl[fr * 8 + s] * __expf(act_ - ac[s]) * dtv[s] : 0.f;
            gp.x = pk_bf16(gd[0], gd[1]); gp.y = pk_bf16(gd[2], gd[3]); gp.z = pk_bf16(gd[4], gd[5]); gp.w = pk_bf16(gd[6], gd[7]); }
        const bf16x8 gf = __builtin_bit_cast(bf16x8, gp);
#pragma unroll
        for (int mt = 0; mt < 4; ++mt) { u32x4 xp = (u32x4){0u, 0u, 0u, 0u};
            if (fq == 0) { const LAS float* xq = xs + wid * 64 + 16 * mt + fr;
                xp.x = pk_bf16(xq[0], xq[512]); xp.y = pk_bf16(xq[1024], xq[1536]); xp.z = pk_bf16(xq[2048], xq[2560]); xp.w = pk_bf16(xq[3072], xq[3584]); }
            yacc[mt] = __builtin_amdgcn_mfma_f32_16x16x32_bf16(__builtin_bit_cast(bf16x8, xp), gf, yacc[mt], 0, 0, 0); }
    }
    { const float dc = __expf(ac[7]);
#pragma unroll
      for (int mt = 0; mt < 4; ++mt)
#pragma unroll
          for (int ks = 0; ks < 4; ++ks) { S[mt][ks][0] = S[mt][ks][0] * dc; S[mt][ks][1] = S[mt][ks][1] * dc; }
#pragma unroll
      for (int t = 0; t < 8; ++t) { const float wt = dtv[t] * __expf(ac[7] - ac[t]);
          float xw[4];
#pragma unroll
          for (int mt = 0; mt < 4; ++mt) xw[mt] = wt * xs[t * 512 + wid * 64 + 16 * mt + fr];
#pragma unroll
          for (int ks = 0; ks < 4; ++ks) { const f32x4 b0 = *(LAS f32x4*)(Bs + t * 128 + 32 * ks + 8 * fq), b1 = *(LAS f32x4*)(Bs + t * 128 + 32 * ks + 8 * fq + 4);
#pragma unroll
              for (int mt = 0; mt < 4; ++mt) { S[mt][ks][0] = S[mt][ks][0] + b0 * xw[mt]; S[mt][ks][1] = S[mt][ks][1] + b1 * xw[mt]; } } }
      float* so = out + O_SSMS + ((size_t)(bs * NHEAD + h) * HDIM) * NSTATE;
#pragma unroll
      for (int mt = 0; mt < 4; ++mt)
#pragma unroll
          for (int ks = 0; ks < 4; ++ks) { float* q = so + (size_t)(16 * mt + fr) * NSTATE + 32 * ks + 8 * fq; __builtin_nontemporal_store(S[mt][ks][0], (f32x4*)q); __builtin_nontemporal_store(S[mt][ks][1], (f32x4*)(q + 4)); } }
    float hq[4][4]; float sq = 0.f;
    if (fr < 8) {
#pragma unroll
        for (int mt = 0; mt < 4; ++mt) { const int p0 = 16 * mt + 4 * fq;
            const u32x2 zr = *(const u32x2*)(proj + (size_t)(R0 + fr) * NPROJ + PZ + h * HDIM + p0);
            const float z[4] = {__uint_as_float(zr.x << 16), __uint_as_float(zr.x & 0xffff0000u), __uint_as_float(zr.y << 16), __uint_as_float(zr.y & 0xffff0000u)};
            const f32x4 xv = *(LAS f32x4*)(xs + fr * 512 + wid * 64 + p0);
#pragma unroll
            for (int r = 0; r < 4; ++r) { hq[mt][r] = (yacc[mt][r] + Dh * xv[r]) * fast_silu(z[r]); sq += hq[mt][r] * hq[mt][r]; } }
    }
    sq += __shfl_xor(sq, 16); sq += __shfl_xor(sq, 32);
    if (lane < 8) sqb[lane * 8 + wid] = sq;
    __syncthreads();
    if (fr < 8) { const f32x4 s0 = *(LAS f32x4*)(sqb + fr * 8), s1 = *(LAS f32x4*)(sqb + fr * 8 + 4);
        const float rs = 1.f / sqrtf(((s0[0] + s0[1]) + (s0[2] + s0[3]) + (s1[0] + s1[1]) + (s1[2] + s1[3])) * (1.f / 512.f) + LN_EPS);
#pragma unroll
        for (int mt = 0; mt < 4; ++mt) { const int ch = h * HDIM + 16 * mt + 4 * fq; const f32x4 gv = *(const f32x4*)(gw + ch);
            u32x2 o; o.x = pk_bf16(hq[mt][0] * rs * gv[0], hq[mt][1] * rs * gv[1]); o.y = pk_bf16(hq[mt][2] * rs * gv[2], hq[mt][3] * rs * gv[3]);
            *(u32x2*)(A2 + (size_t)(R0 + fr) * DM + ch) = o; } }
}

__device__ __forceinline__ void p_transpose_tile(const VB& v, bool on, const float* __restrict__ W, int K, int ld, int col0, int N, bf16* __restrict__ WT, int item) {
    LAS float* tile = v.scr;
    const int nb = N / 64, kb = item / nb, nbi = item % nb, k0 = kb * 64, n0 = nbi * 64, tid = v.vt;
    if (on) {
#pragma unroll
        for (int i = 0; i < 16; ++i) { const int kk = i * 4 + (tid >> 6), nn = tid & 63; tile[kk * 65 + nn] = W[(size_t)(k0 + kk) * ld + col0 + n0 + nn]; }
    }
    __syncthreads();
    if (on) {
#pragma unroll
        for (int i = 0; i < 16; ++i) { const int nn = i * 4 + (tid >> 6), kk = tid & 63; WT[(size_t)(n0 + nn) * K + k0 + kk] = f2bf(tile[kk * 65 + nn]); }
    }
    __syncthreads();
}
__device__ __forceinline__ void p_mod_item(const VB& v, bool on, int item, const float* __restrict__ c_prompt, const float* __restrict__ c_sample, const float* __restrict__ w_mod, const float* __restrict__ b_mod, float* __restrict__ mod) {
    LAS float* sc = v.scr;
    const int tid = v.vt, bx = item % (NMOD / 256), by = item / (NMOD / 256), n = bx * 256 + tid, r0 = by * 12;
    float acc[12];
#pragma unroll
    for (int i = 0; i < 12; ++i) acc[i] = 0.f;
    for (int k0 = 0; k0 < DM; k0 += 256) {
        __syncthreads();
        if (on) {
#pragma unroll
            for (int i = 0; i < 12; ++i) { const int r = r0 + i; const float* c = r < NPB ? c_prompt + (size_t)r * DM : c_sample + (size_t)(r - NPB) * DM; sc[i * 256 + tid] = silu_f(c[k0 + tid]); }
        }
        __syncthreads();
        if (on) {
            for (int kk = 0; kk < 256; ++kk) { const float w = w_mod[(size_t)(k0 + kk) * NMOD + n];
#pragma unroll
                for (int i = 0; i < 12; ++i) acc[i] += sc[i * 256 + kk] * w; }
        }
    }
    if (on) { const float bb = b_mod[n];
#pragma unroll
        for (int i = 0; i < 12; ++i) mod[(size_t)(r0 + i) * NMOD + n] = acc[i] + bb; }
}
__device__ __forceinline__ void p_ln_h1_row(const VB& vb, int r, const float* __restrict__ x_prompt, const float* __restrict__ x_sample, const float* __restrict__ g, const float* __restrict__ b,
                                            const float* __restrict__ mod, float* __restrict__ stats, bf16* __restrict__ h1) {
    const int tid = vb.vt;
    const float* xr = r < MP ? x_prompt + (size_t)r * DM : x_sample + (size_t)(r - MP) * DM;
    float v[8];
    { const f32x4 a = *(const f32x4*)(xr + tid * 4), c = *(const f32x4*)(xr + 1024 + tid * 4); v[0] = a[0]; v[1] = a[1]; v[2] = a[2]; v[3] = a[3]; v[4] = c[0]; v[5] = c[1]; v[6] = c[2]; v[7] = c[3]; }
    float s = 0.f;
#pragma unroll
    for (int j = 0; j < 8; ++j) s += v[j];
    const float mean = vb_sum(s, vb.scr, tid) * (1.f / DM);
    float q = 0.f;
#pragma unroll
    for (int j = 0; j < 8; ++j) { const float d = v[j] - mean; q += d * d; }
    const float rstd = 1.f / sqrtf(vb_sum(q, vb.scr, tid) * (1.f / DM) + LN_EPS);
    if (tid == 0) { stats[2 * r] = mean; stats[2 * r + 1] = rstd; }
    const float* mr = mod + (size_t)modrow(r) * NMOD;
#pragma unroll
    for (int j = 0; j < 8; ++j) { const int c = (j < 4 ? 0 : 1024) + tid * 4 + (j & 3);
        const float xn = (v[j] - mean) * rstd * g[c] + b[c];
        h1[(size_t)r * DM + c] = f2bf(xn * (1.f + mr[DM + c]) + mr[c]); }
}
__device__ __forceinline__ void p_dt_item(int vt, int item, const bf16* __restrict__ h1, const float* __restrict__ wdt, const float* __restrict__ dt_bias, float* __restrict__ dt) {
    const int r = item * 16 + (vt >> 4), h = vt & 15;
    const bf16* hr = h1 + (size_t)r * DM; const float* w = wdt + (size_t)h * DM;
    float a = 0.f;
    for (int k = 0; k < DM; ++k) a += bf2f(hr[k]) * w[k];
    dt[r * 16 + h] = softplus_f(a + dt_bias[h]);
}
__device__ __forceinline__ void p_conv_item(int vt, int item, const bf16* __restrict__ proj, const float* __restrict__ state_conv, const float* __restrict__ conv_w, const float* __restrict__ conv_b,
                                            float* __restrict__ act, float* __restrict__ out) {
    const int r = item / 6, c = (item % 6) * 256 + vt;
    int t, rowbase; const float* sc = nullptr;
    if (r < MP) { t = r & (SEQ - 1); rowbase = r - t; } else { const int bs = (r - MP) >> 3; t = (r - MP) & 7; rowbase = r - t; sc = state_conv + (size_t)bs * 3 * CONVD; }
    float a = conv_b[c];
#pragma unroll
    for (int k = 0; k < 4; ++k) { const int tp = t - 3 + k; float xv;
        if (tp >= 0) xv = bf2f(proj[(size_t)(rowbase + tp) * NPROJ + PX + c]); else xv = sc ? sc[(size_t)(tp + 3) * CONVD + c] : 0.f;
        a += conv_w[k * CONVD + c] * xv; }
    act[(size_t)r * CONVD + c] = silu_f(a);
    const float pre = bf2f(proj[(size_t)r * NPROJ + PX + c]);
    if (r < MP) { if (t >= SEQ - 3) out[O_CONVP + ((size_t)(r >> 11) * 3 + (t - (SEQ - 3))) * CONVD + c] = pre; }
    else { if (t >= DSEQ - 3) out[O_CONVS + ((size_t)((r - MP) >> 3) * 3 + (t - (DSEQ - 3))) * CONVD + c] = pre; }
}
__device__ __forceinline__ void p_ssd_seq_item(int tid, int item, const float* __restrict__ act, const float* __restrict__ dt, const float* __restrict__ a_log, const float* __restrict__ d_skip,
                                               const float* __restrict__ state_ssm, float* __restrict__ y, float* __restrict__ out) {
    const int seq = item >> 4, h = item & 15, p = tid >> 2, q = tid & 3, g = h >> 3;
    const float A = -expf(a_log[h]), D = d_skip[h];
    int row0, L; float* sout;
    float S[32];
    if (seq < NPB) { row0 = seq * SEQ; L = SEQ; sout = out + O_SSMP + ((size_t)(seq * NHEAD + h) * HDIM + p) * NSTATE + q * 32;
#pragma unroll
        for (int n = 0; n < 32; ++n) S[n] = 0.f; }
    else { const int bs = seq - NPB; row0 = MP + bs * DSEQ; L = DSEQ; sout = out + O_SSMS + ((size_t)(bs * NHEAD + h) * HDIM + p) * NSTATE + q * 32;
        const float* s0 = state_ssm + ((size_t)(bs * NHEAD + h) * HDIM + p) * NSTATE + q * 32;
#pragma unroll
        for (int n = 0; n < 32; ++n) S[n] = s0[n]; }
    for (int t = 0; t < L; ++t) {
        const int r = row0 + t; const float* ar = act + (size_t)r * CONVD;
        const float dtv = dt[r * 16 + h], dA = expf(dtv * A), xv = ar[h * HDIM + p], xd = dtv * xv;
        const float* Bp = ar + SSDW + g * NSTATE + q * 32; const float* Cp = ar + SSDW + NGRP * NSTATE + g * NSTATE + q * 32;
        float part = 0.f;
#pragma unroll
        for (int n = 0; n < 32; ++n) { S[n] = dA * S[n] + xd * Bp[n]; part += S[n] * Cp[n]; }
        part += __shfl_xor(part, 1); part += __shfl_xor(part, 2);
        if (q == 0) y[(size_t)r * SSDW + h * HDIM + p] = part + D * xv;
    }
#pragma unroll
    for (int n = 0; n < 32; ++n) sout[n] = S[n];
}
__device__ __forceinline__ void p_gated_norm_row(const VB& vb, int r, const float* __restrict__ y, const bf16* __restrict__ proj, const float* __restrict__ gw, bf16* __restrict__ A2) {
    LAS float* red = vb.scr; const int tid = vb.vt, c0 = tid * 4;
    float hv[4]; float q = 0.f;
#pragma unroll
    for (int j = 0; j < 4; ++j) { const float z = bf2f(proj[(size_t)r * NPROJ + PZ + c0 + j]); hv[j] = y[(size_t)r * SSDW + c0 + j] * silu_f(z); q += hv[j] * hv[j]; }
    q = wave_sum(q);
    __syncthreads();
    if ((tid & 63) == 0) red[tid >> 6] = q;
    __syncthreads();
    const float ms = (tid < 128 ? red[0] + red[1] : red[2] + red[3]) * (1.f / 512.f);
    const float rs = 1.f / sqrtf(ms + LN_EPS);
#pragma unroll
    for (int j = 0; j < 4; ++j) A2[(size_t)r * DM + c0 + j] = f2bf(hv[j] * rs * gw[c0 + j]);
}
__device__ __forceinline__ void p_vn_row(const VB& vb, int r, const bf16* __restrict__ proj, const float* __restrict__ g, const float* __restrict__ b, float* __restrict__ vn, float* __restrict__ out) {
    const int tid = vb.vt, c0 = tid * 4;
    float v[4]; float s = 0.f;
#pragma unroll
    for (int j = 0; j < 4; ++j) { v[j] = gelu_f(bf2f(proj[(size_t)r * NPROJ + PV + c0 + j])); s += v[j]; }
    const float mean = vb_sum(s, vb.scr, tid) * (1.f / GMW);
    float q = 0.f;
#pragma unroll
    for (int j = 0; j < 4; ++j) { const float d = v[j] - mean; q += d * d; }
    const float rstd = 1.f / sqrtf(vb_sum(q, vb.scr, tid) * (1.f / GMW) + LN_EPS);
#pragma unroll
    for (int j = 0; j < 4; ++j) { const float o = (v[j] - mean) * rstd * g[c0 + j] + b[c0 + j]; vn[(size_t)r * GMW + c0 + j] = o; if (r >= MP) out[O_CV + (size_t)(r - MP) * GMW + c0 + j] = o; }
}
__device__ __forceinline__ void p_gmlp_mix_row(int tid, int r, const bf16* __restrict__ proj, const float* __restrict__ vn, const float* __restrict__ w_s, const float* __restrict__ b_s, bf16* __restrict__ A2) {
    const int c0 = tid * 4, hd = c0 >> 7;
    const int i = r < MP ? (r & 127) : ((r - MP) & 7), base = r - i;
    const float* wrow = w_s + ((size_t)hd * 128 + i) * 128;
    float a[4] = {0.f, 0.f, 0.f, 0.f};
    for (int j = 0; j <= i; ++j) { const float w = wrow[j]; const f32x4 vv = *(const f32x4*)(vn + (size_t)(base + j) * GMW + c0);
#pragma unroll
        for (int e = 0; e < 4; ++e) a[e] += w * vv[e]; }
    const float bs = b_s[hd * 128 + i];
#pragma unroll
    for (int e = 0; e < 4; ++e) { const float u = gelu_f(bf2f(proj[(size_t)r * NPROJ + PU + c0 + e])); A2[(size_t)r * DM + SSDW + c0 + e] = f2bf(u * (a[e] + bs)); }
}
__device__ __forceinline__ void p_ln_mix_row(const VB& vb, int r, const float* __restrict__ x_prompt, const float* __restrict__ x_sample, const float* __restrict__ stats, const float* __restrict__ lg, const float* __restrict__ lb,
                                             const float* __restrict__ mod, const float* __restrict__ mix, const float* __restrict__ g2, const float* __restrict__ b2, float* __restrict__ x1, bf16* __restrict__ h2) {
    const int tid = vb.vt;
    const float* xr = r < MP ? x_prompt + (size_t)r * DM : x_sample + (size_t)(r - MP) * DM;
    const float mean0 = stats[2 * r], rstd0 = stats[2 * r + 1];
    const float* mr = mod + (size_t)modrow(r) * NMOD;
    float v[8]; float s = 0.f;
#pragma unroll
    for (int j = 0; j < 8; ++j) { const int c = (j < 4 ? 0 : 1024) + tid * 4 + (j & 3);
        const float xn = (xr[c] - mean0) * rstd0 * lg[c] + lb[c];
        v[j] = ALPHA * xn + (1.f + mr[2 * DM + c]) * mix[(size_t)r * DM + c]; s += v[j]; }
    const float mean = vb_sum(s, vb.scr, tid) * (1.f / DM);
    float q = 0.f;
#pragma unroll
    for (int j = 0; j < 8; ++j) { const float d = v[j] - mean; q += d * d; }
    const float rstd = 1.f / sqrtf(vb_sum(q, vb.scr, tid) * (1.f / DM) + LN_EPS);
#pragma unroll
    for (int j = 0; j < 8; ++j) { const int c = (j < 4 ? 0 : 1024) + tid * 4 + (j & 3);
        const float o = (v[j] - mean) * rstd * g2[c] + b2[c];
        x1[(size_t)r * DM + c] = o;
        h2[(size_t)r * DM + c] = f2bf(o * (1.f + mr[4 * DM + c]) + mr[3 * DM + c]); }
}
__device__ __forceinline__ void p_ln_out_row(const VB& vb, int r, const float* __restrict__ mod, const float* __restrict__ f, const float* __restrict__ g3, const float* __restrict__ b3, float* __restrict__ xy) {
    const int tid = vb.vt;
    const float* mr = mod + (size_t)modrow(r) * NMOD;
    float v[8]; float s = 0.f;
#pragma unroll
    for (int j = 0; j < 8; ++j) { const int c = (j < 4 ? 0 : 1024) + tid * 4 + (j & 3);
        v[j] = ALPHA * xy[(size_t)r * DM + c] + (1.f + mr[5 * DM + c]) * f[(size_t)r * DM + c]; s += v[j]; }
    const float mean = vb_sum(s, vb.scr, tid) * (1.f / DM);
    float q = 0.f;
#pragma unroll
    for (int j = 0; j < 8; ++j) { const float d = v[j] - mean; q += d * d; }
    const float rstd = 1.f / sqrtf(vb_sum(q, vb.scr, tid) * (1.f / DM) + LN_EPS);
#pragma unroll
    for (int j = 0; j < 8; ++j) { const int c = (j < 4 ? 0 : 1024) + tid * 4 + (j & 3); xy[(size_t)r * DM + c] = (v[j] - mean) * rstd * g3[c] + b3[c]; }
}

__global__ void __launch_bounds__(NWAVES * 64, 2) mega_fwd(Args args) {
    extern __shared__ __attribute__((aligned(16))) unsigned char lds_raw[];
    LAS unsigned char* lds = (LAS unsigned char*)lds_raw;
    volatile LAS unsigned* MISC = (volatile LAS unsigned*)(lds + MISC_OFF);
    const int tid = threadIdx.x, G = gridDim.x;
    for (int u = tid; u < (LDS_BYTES - LDSCTL_OFF) / 4; u += NWAVES * 64) ((LAS unsigned*)(lds + LDSCTL_OFF))[u] = 0u;
    __syncthreads();
    unsigned char* ws = args.ws;
    XcdBarrier bar = xcd_barrier_post((unsigned*)(ws + WS_CTL) + CW_BAR, MISC + 8);
    unsigned* ctlw = (unsigned*)(ws + WS_CTL);

    const float* x_prompt = args.in[0]; const float* x_sample = args.in[1]; const float* state_ssm = args.in[2]; const float* state_conv = args.in[3];
    const float* c_prompt = args.in[4]; const float* c_sample = args.in[5]; const float* ln_in_g = args.in[6]; const float* ln_in_b = args.in[7];
    const float* w_mod = args.in[8]; const float* b_mod = args.in[9]; const float* w_in = args.in[10]; const float* conv_w = args.in[11];
    const float* conv_b = args.in[12]; const float* dt_bias = args.in[13]; const float* a_log = args.in[14]; const float* d_skip = args.in[15];
    const float* ssd_norm_g = args.in[16]; const float* gm_ln_g = args.in[17]; const float* gm_ln_b = args.in[18]; const float* gm_w_s = args.in[19];
    const float* gm_b_s = args.in[20]; const float* w_out = args.in[21]; const float* ln_mix_g = args.in[22]; const float* ln_mix_b = args.in[23];
    const float* w_ff1 = args.in[24]; const float* w_ff2 = args.in[25]; const float* ln_ffn_g = args.in[26]; const float* ln_ffn_b = args.in[27];
    float* out = args.out;
    bf16* Wt_in = (bf16*)(ws + WS_WIN); bf16* Wt_out = (bf16*)(ws + WS_WOUT); bf16* Wt_ff1 = (bf16*)(ws + WS_WFF1); bf16* Wt_ff2 = (bf16*)(ws + WS_WFF2);
    float* mod = (float*)(ws + WS_MOD); float* stats = (float*)(ws + WS_STATS); float* vstats = (float*)(ws + WS_STATS + 512 * 1024); float* dt = (float*)(ws + WS_DT);
    bf16* hbuf = (bf16*)(ws + WS_H); bf16* proj = (bf16*)(ws + WS_BIG); float* act = (float*)(ws + WS_ACT); bf16* hid = (bf16*)(ws + WS_BIG);
    bf16* mixb = (bf16*)(ws + WS_E); bf16* csilu = (bf16*)(ws + WS_STATS + 256 * 1024); bf16* slab1 = (bf16*)(ws + WS_BIG); bf16* slab2 = (bf16*)(ws + WS_SLAB2); bf16* xsb = (bf16*)(ws + WS_SLAB2);   float* ybuf = (float*)(ws + WS_E); bf16* cs = (bf16*)(ws + WS_E); float* cd = (float*)(ws + WS_CD); bf16* s_in = (bf16*)(ws + WS_SIN); float* vn = (float*)(ws + WS_VN); float* mix = (float*)(ws + WS_E); float* fbuf = (float*)(ws + WS_E);

    #define MAKE_VB() VB vb; { int t_ = threadIdx.x; asm volatile("" : "+v"(t_)); const int half_ = __builtin_amdgcn_readfirstlane(t_ >> 8); vb.vt = t_ & 255; vb.id = (int)blockIdx.x * 2 + half_; vb.n = 2 * (int)gridDim.x; vb.scr = (LAS float*)(lds + half_ * 32768); }

    { int t_ = threadIdx.x; asm volatile("" : "+v"(t_)); const int lane = t_ & 63, wv = __builtin_amdgcn_readfirstlane(t_ >> 6), gw = (int)blockIdx.x * NWAVES + wv, NGW = G * NWAVES;
      for (int i = (int)blockIdx.x * 512 + t_; i < NSEQ * DM / 4; i += G * 512) { const int r = i / (DM / 4), k4 = i % (DM / 4);
          const f32x4 cv = *(const f32x4*)((r < NPB ? c_prompt + (size_t)r * DM : c_sample + (size_t)(r - NPB) * DM) + 4 * k4);
          u32x2 w; w.x = pk_bf16(fast_silu(cv[0]), fast_silu(cv[1])); w.y = pk_bf16(fast_silu(cv[2]), fast_silu(cv[3])); *(u32x2*)(csilu + (size_t)r * DM + 4 * k4) = w; }
      asm volatile("s_waitcnt vmcnt(0)" ::: "memory");
      __syncthreads();
      if (t_ == 0) { __builtin_amdgcn_fence(__ATOMIC_RELEASE, "agent"); asm volatile("s_waitcnt vmcnt(0)" ::: "memory"); (void)xb_add(ctlw + CW_CSILU, 1u); }
      LAS float* scr = (LAS float*)(lds + wv * 8448);
      constexpr int I1 = 32 * 80, I2 = 32 * 64, I3 = 32 * 64, I4 = 32 * 256, I5 = 128 * 64;
      const int IT = (G == 256) ? I1 + I2 : I1 + I2 + I3 + I4 + I5;
      for (int it = gw; it < IT; it += NGW) { int r = it;
          if (r < I1) { p0_transpose_item(w_in, DM, DINP, 80, Wt_in, scr, r, lane); continue; } r -= I1;
          if (r < I2) { p0_transpose_item(w_in + 2576, DM, DINP, 64, Wt_in + (size_t)2560 * DM, scr, r, lane); continue; } r -= I2;
          if (r < I3) { p0_transpose_item(w_out, DM, DM, 64, Wt_out, scr, r, lane); continue; } r -= I3;
          if (r < I4) { p0_transpose_item(w_ff1, DM, DFF, 256, Wt_ff1, scr, r, lane); continue; } r -= I4;
          p0_transpose_item(w_ff2, DFF, DM, 64, Wt_ff2, scr, r, lane); }
      for (int i = (int)blockIdx.x * 512 + t_; i < 256 * DM; i += G * 512) { const int h = i / DM, k = i % DM; Wt_in[(size_t)(NPROJ + h) * DM + k] = h < 16 ? f2bf(w_in[(size_t)k * DINP + 2560 + h]) : (bf16)0; }
    }
    { int t_ = threadIdx.x; asm volatile("" : "+v"(t_));
      if (t_ == 0) { unsigned* tmo = ctlw + CW_BAR; XB_SPIN(xb_ld(ctlw + CW_CSILU) < (unsigned)G, tmo); __builtin_amdgcn_fence(__ATOMIC_ACQUIRE, "agent"); asm volatile("s_waitcnt vmcnt(0)" ::: "memory"); }
      __syncthreads(); }
    if (G == 256) mod_item(lds, ((int)blockIdx.x & 7) * 32 + ((int)blockIdx.x >> 3), csilu, w_mod, b_mod, mod);
    else for (int it = blockIdx.x; it < NMOD / 48; it += G) mod_item(lds, it, csilu, w_mod, b_mod, mod);
    xcd_barrier(bar);
    { int t_ = threadIdx.x; asm volatile("" : "+v"(t_)); const int lane = t_ & 63, gw = (int)blockIdx.x * NWAVES + __builtin_amdgcn_readfirstlane(t_ >> 6), NGW = G * NWAVES;
      LAS float* UV = (LAS float*)lds;
      __syncthreads();
      for (int i = t_; i < NPB * DM; i += NWAVES * 64) { const int bb = i / DM, c = i % DM; const float* mr = mod + (size_t)bb * NMOD; const float sc1 = 1.f + mr[DM + c];
          UV[bb * 2 * DM + c] = ln_in_g[c] * sc1; UV[bb * 2 * DM + DM + c] = ln_in_b[c] * sc1 + mr[c]; }
      __syncthreads();
      const int rs_odd = gw & 1, rs_j = gw >> 1, rs_n = (G == 256) ? (rs_odd ? 5 : 4) : (MROWS - gw + NGW - 1) / NGW;
#pragma unroll 1
      for (int rs_k = 0; rs_k < rs_n; ++rs_k) { const int r = (G != 256) ? gw + rs_k * NGW : rs_odd ? 3072 + rs_j + 1024 * rs_k : (rs_k == 0 ? MP + rs_j : rs_j + 1024 * (rs_k - 1));
          if (r < MP) w_ln_h1_lds(r, lane, x_prompt + (size_t)r * DM, UV + (r >> 11) * 2 * DM, stats, hbuf);
          else w_ln_h1_row(r, lane, x_prompt, x_sample, ln_in_g, ln_in_b, mod, stats, hbuf, nullptr); } }
    xcd_barrier(bar);
    { pg8::Gemm g{hbuf, Wt_in, MROWS, NPROJ + 256, DM, 0}; pg8::StaticOrder S; S.init(MROWS, NPROJ + 256, G, (int)blockIdx.x, DM); pg8::EpiProj E{proj, dt, dt_bias};
      pg8::gemm_phase<pg8::EpiProj, pg8::StaticOrder, true, true>(lds, g, S, E); }
    if (G == 256 && blockIdx.x >= 172) {
        int t_ = threadIdx.x; asm volatile("" : "+v"(t_)); const int lane = t_ & 63, wv = __builtin_amdgcn_readfirstlane(t_ >> 6); LAS float* scr = (LAS float*)(lds + wv * 8448);
        for (int it = ((int)blockIdx.x - 172) * NWAVES + wv; it < 32 * 256 + 32 * 64; it += 84 * NWAVES) {
            if (it < 32 * 256) p0_transpose_item(w_ff1, DM, DFF, 256, Wt_ff1, scr, it, lane); else p0_transpose_item(w_out, DM, DM, 64, Wt_out, scr, it - 32 * 256, lane); } }
    xcd_barrier(bar);
    { const bool sample_first = (((int)blockIdx.x >> 3) & 1) != 0;
#pragma unroll 1
      for (int step = 0; step < 3; ++step) {
        const int what = (step == 1) ? 0 : (((step == 0) == sample_first) ? 1 : 2);
        if (what == 0) {
    { MAKE_VB();
    for (int i = vb.id * 256 + vb.vt; i < NPB * 3 * CONVD; i += vb.n * 256) { const int bb = i / (3 * CONVD), jj = (i / CONVD) % 3, cc = i % CONVD; out[O_CONVP + i] = bf2f(proj[(size_t)(bb * SEQ + SEQ - 3 + jj) * NPROJ + PX + cc]); }
    }
    { int t_ = threadIdx.x; asm volatile("" : "+v"(t_)); const int lane = t_ & 63, gw = (int)blockIdx.x * NWAVES + __builtin_amdgcn_readfirstlane(t_ >> 6), NGW = G * NWAVES;
      for (int r = gw; r < MROWS; r += NGW) w_gmlp_ln_row(r, lane, proj, gm_ln_g, gm_ln_b, out); }
        } else if (what == 1) { for (int it = blockIdx.x; it < NSB * NGRP; it += G) sample_ssd_item(lds, it, proj, dt, state_conv, conv_w, conv_b, a_log, d_skip, ssd_norm_g, state_ssm, hbuf, out); }
        else { for (int it = blockIdx.x; it < NPB * 16 * NGRP * 2; it += G) ssd_phaseA_item(lds, it, proj, dt, conv_w, conv_b, a_log, cs, cd, xsb); }
      } }
    xcd_barrier(bar);
    { MAKE_VB();
    if ((int)threadIdx.x < 256)
    for (int e = (int)blockIdx.x * 256 + (int)threadIdx.x; e < NPB * NHEAD * HDIM * NSTATE / 8; e += G * 256) {
        const int bh = e / (HDIM * NSTATE / 8), rem = e % (HDIM * NSTATE / 8), bb = bh >> 4, hh = bh & 15;
        u32x4 cv[16]; float dc[16];
#pragma unroll
        for (int cc = 0; cc < 16; ++cc) { cv[cc] = __builtin_nontemporal_load((const u32x4*)(cs + ((size_t)((bb * 16 + cc) * 16 + hh) * (HDIM * NSTATE / 8) + rem) * 8)); dc[cc] = cd[(bb * 16 + cc) * 16 + hh]; }
        float sv[8];
#pragma unroll
        for (int k = 0; k < 8; ++k) sv[k] = 0.f;
#pragma unroll
        for (int cc = 0; cc < 16; ++cc) {
            u32x4 w; w.x = pk_bf16(sv[0], sv[1]); w.y = pk_bf16(sv[2], sv[3]); w.z = pk_bf16(sv[4], sv[5]); w.w = pk_bf16(sv[6], sv[7]);
            *(u32x4*)(s_in + ((size_t)((bb * 16 + cc) * 16 + hh) * (HDIM * NSTATE / 8) + rem) * 8) = w;
#pragma unroll
            for (int k = 0; k < 4; ++k) { sv[2 * k] = sv[2 * k] * dc[cc] + __uint_as_float(cv[cc][k] << 16); sv[2 * k + 1] = sv[2 * k + 1] * dc[cc] + __uint_as_float(cv[cc][k] & 0xffff0000u); } }
        *(f32x4*)(out + O_SSMP + (size_t)e * 8) = (f32x4){sv[0], sv[1], sv[2], sv[3]}; *(f32x4*)(out + O_SSMP + (size_t)e * 8 + 4) = (f32x4){sv[4], sv[5], sv[6], sv[7]}; }
    }
    xcd_barrier(bar);
    { MAKE_VB();
    }
    if (G == 256) {
        const int bx = (int)blockIdx.x, rh = (bx >> 3) & 1, w = (bx & 7) + 8 * (bx >> 4);
        ssd_phaseC_half(lds, 2 * w + rh, proj, dt, conv_w, conv_b, a_log, d_skip, ssd_norm_g, s_in, xsb, hbuf);
        if (rh == 0) gmlp_group(lds, w & 7, w >> 3, 16, 3, proj, gm_w_s, gm_b_s, hbuf);
        else { gmlp_group(lds, w & 7, 48 + (w >> 3), 0, 1, proj, gm_w_s, gm_b_s, hbuf); gmlp_sample_item(w, proj, out + O_CV, gm_w_s, gm_b_s, hbuf); }
    } else {
        for (int it = blockIdx.x; it < NPB * 16 * NGRP * 2; it += G) ssd_phaseC_half(lds, it, proj, dt, conv_w, conv_b, a_log, d_skip, ssd_norm_g, s_in, xsb, hbuf);
        for (int it = blockIdx.x; it < NPB * 16 * GMNH; it += G) gmlp_group(lds, it & 7, it >> 3, 0, 1, proj, gm_w_s, gm_b_s, hbuf);
        for (int bs = blockIdx.x; bs < NSB; bs += G) gmlp_sample_item(bs, proj, out + O_CV, gm_w_s, gm_b_s, hbuf);
    }
    xcd_barrier(bar);
    { pg8::Gemm g{hbuf, Wt_out, MROWS, DM, DM, 0}; pg8::EpiBf16S E{mixb, slab1, DM, 0};
      if (G == 256) { pg8::SplitOrder S; S.init((int)blockIdx.x, DM); pg8::gemm_phase<pg8::EpiBf16S, pg8::SplitOrder, true, true>(lds, g, S, E); }
      else { pg8::StaticOrder S; S.init(MROWS, DM, G, (int)blockIdx.x, DM); pg8::gemm_phase<pg8::EpiBf16S, pg8::StaticOrder, true, true>(lds, g, S, E); } }
    xcd_barrier(bar);
    { int t_ = threadIdx.x; asm volatile("" : "+v"(t_)); const int lane = t_ & 63, gw = (int)blockIdx.x * NWAVES + __builtin_amdgcn_readfirstlane(t_ >> 6), NGW = G * NWAVES;
      LAS float* Cc = (LAS float*)lds; LAS float* Bt = Cc + 4 * DM;
      __syncthreads();
      for (int c = t_; c < DM; c += NWAVES * 64) { Cc[c] = ALPHA * ln_in_g[c]; Cc[DM + c] = ALPHA * ln_in_b[c]; Cc[2 * DM + c] = ln_mix_g[c]; Cc[3 * DM + c] = ln_mix_b[c]; }
      for (int i = t_; i < NPB * DM; i += NWAVES * 64) { const int bb = i / DM, c = i % DM; const float* mr = mod + (size_t)bb * NMOD; const float sc1 = 1.f + mr[4 * DM + c];
          Bt[bb * 3 * DM + c] = 1.f + mr[2 * DM + c]; Bt[bb * 3 * DM + DM + c] = ln_mix_g[c] * sc1; Bt[bb * 3 * DM + 2 * DM + c] = ln_mix_b[c] * sc1 + mr[3 * DM + c]; }
      __syncthreads();
      const int rs_odd = gw & 1, rs_j = gw >> 1, rs_n = (G == 256) ? (rs_odd ? 5 : 4) : (MROWS - gw + NGW - 1) / NGW;
#pragma unroll 1
      for (int rs_k = 0; rs_k < rs_n; ++rs_k) { const int r = (G != 256) ? gw + rs_k * NGW : rs_odd ? 3072 + rs_j + 1024 * rs_k : (rs_k == 0 ? MP + rs_j : rs_j + 1024 * (rs_k - 1));
          if (r < MP) w_ln_mix3_lds(r, lane, x_prompt + (size_t)r * DM, mixb + (size_t)r * DM, stats, Cc, Bt + (r >> 11) * 3 * DM, (bf16*)(out + O_YP) + (size_t)r * 2 * DM, hbuf + (size_t)r * DM);
          else w_ln_mix3_row(r, lane, x_prompt, x_sample, stats, ln_in_g, ln_in_b, mod, mixb, G == 256 ? slab1 : nullptr, ln_mix_g, ln_mix_b, (bf16*)(out + O_YP), 2 * DM, hbuf); } }
    xcd_barrier(bar);
    { pg8::Gemm g{hbuf, Wt_ff1, MROWS, DFF, DM, 0}; pg8::StaticOrder S; S.init(MROWS, DFF, G, (int)blockIdx.x, DM); pg8::EpiBf16P<2> E{hid, DFF, 0};
      pg8::gemm_phase<pg8::EpiBf16P<2>, pg8::StaticOrder, true, true>(lds, g, S, E); }
    if (G == 256 && blockIdx.x >= 128) {
        int t_ = threadIdx.x; asm volatile("" : "+v"(t_)); const int lane = t_ & 63, wv = __builtin_amdgcn_readfirstlane(t_ >> 6); LAS float* scr = (LAS float*)(lds + wv * 8448);
        for (int it = ((int)blockIdx.x - 128) * NWAVES + wv; it < 128 * 64; it += 128 * NWAVES) p0_transpose_item(w_ff2, DFF, DM, 64, Wt_ff2, scr, it, lane); }
    xcd_barrier(bar);
    { pg8::Gemm g{hid, Wt_ff2, MROWS, DM, DFF, 0}; pg8::EpiBf16S E{mixb, slab2, DM, 0};
      if (G == 256) { pg8::SplitOrder S; S.init((int)blockIdx.x, DFF); pg8::gemm_phase<pg8::EpiBf16S, pg8::SplitOrder, true, true>(lds, g, S, E); }
      else { pg8::StaticOrder S; S.init(MROWS, DM, G, (int)blockIdx.x, DFF); pg8::gemm_phase<pg8::EpiBf16S, pg8::StaticOrder, true, true>(lds, g, S, E); } }
    xcd_barrier(bar);
    { int t_ = threadIdx.x; asm volatile("" : "+v"(t_)); const int lane = t_ & 63, gw = (int)blockIdx.x * NWAVES + __builtin_amdgcn_readfirstlane(t_ >> 6), NGW = G * NWAVES;
      LAS float* Cc = (LAS float*)lds; LAS float* GF = Cc + 2 * DM;
      __syncthreads();
      for (int c = t_; c < DM; c += NWAVES * 64) { Cc[c] = ln_ffn_g[c]; Cc[DM + c] = ln_ffn_b[c]; }
      for (int i = t_; i < NPB * DM; i += NWAVES * 64) { const int bb = i / DM, c = i % DM; GF[i] = 1.f + mod[(size_t)bb * NMOD + 5 * DM + c]; }
      __syncthreads();
      const int rs_odd = gw & 1, rs_j = gw >> 1, rs_n = (G == 256) ? (rs_odd ? 5 : 4) : (MROWS - gw + NGW - 1) / NGW;
#pragma unroll 1
      for (int rs_k = 0; rs_k < rs_n; ++rs_k) { const int r = (G != 256) ? gw + rs_k * NGW : rs_odd ? 3072 + rs_j + 1024 * rs_k : (rs_k == 0 ? MP + rs_j : rs_j + 1024 * (rs_k - 1));
          if (r < MP) w_ln_out3_lds(r, lane, (const bf16*)(out + O_YP) + (size_t)r * 2 * DM, mixb + (size_t)r * DM, Cc, GF + (r >> 11) * DM, out + O_YP + (size_t)r * DM, GF + NPB * DM + (gw & 7) * DM);
          else w_ln_out3_row(r, lane, mod, (const bf16*)(out + O_YP), 2 * DM, mixb, G == 256 ? slab2 : nullptr, ln_ffn_g, ln_ffn_b, out + O_YP); } }
}

extern "C" void kernel_launch(void* const* d_in, const int* in_sizes, int n_in, void* d_out, int out_size, void* d_ws, size_t ws_size, hipStream_t stream) {
    static int grid = 0;
    if (grid == 0) {
        if (n_in != 28 || ws_size < WS_END) { fprintf(stderr, "kernel_launch: unexpected n_in %d / ws_size %zu\n", n_in, ws_size); grid = -1; return; }
        int dev = 0, cus = 0;
        if (hipGetDevice(&dev) != hipSuccess || hipDeviceGetAttribute(&cus, hipDeviceAttributeMultiprocessorCount, dev) != hipSuccess) { grid = -1; return; }
        if (hipFuncSetAttribute((const void*)mega_fwd, hipFuncAttributeMaxDynamicSharedMemorySize, LDS_BYTES) != hipSuccess) { fprintf(stderr, "kernel_launch: hipFuncSetAttribute failed\n"); grid = -1; return; }
        int per_cu = 0; (void)hipOccupancyMaxActiveBlocksPerMultiprocessor(&per_cu, (const void*)mega_fwd, NWAVES * 64, LDS_BYTES); (void)hipGetLastError();
        if (per_cu < 1) fprintf(stderr, "kernel_launch: occupancy query reports %d blocks per CU\n", per_cu);
        grid = cus;
    }
    if (grid < 0) return;
    (void)hipMemsetAsync((char*)d_ws + WS_CTL, 0, CTL_ZERO_BYTES, stream);
    Args a{};
    for (int i = 0; i < 28; ++i) a.in[i] = (const float*)d_in[i];
    a.out = (float*)d_out; a.ws = (unsigned char*)d_ws;
    hipLaunchKernelGGL(mega_fwd, dim3(grid), dim3(NWAVES * 64), LDS_BYTES, stream, a);
}
```

```cpp
#include <hip/hip_runtime.h>
#include <cstdio>
#include <cstdint>
namespace pg8 {
#define PG8_LAS __attribute__((address_space(3)))
typedef unsigned short bf16_t;
typedef short bf16x8 __attribute__((ext_vector_type(8)));
typedef float f32x4 __attribute__((ext_vector_type(4)));
typedef unsigned u32x4 __attribute__((ext_vector_type(4)));
constexpr int BM = 256, BK = 64, HALF = 128, HTB = HALF * BK * 2  , STAGE_BYTES = 8 * HTB, NXCD = 8, WGM = 8;

__host__ __device__ __forceinline__ int lds_byte(int r, int c) { const int st = (r >> 4) * 2 + (c >> 5), rr = r & 15, cc = c & 31, ob = rr * 64 + cc * 2; return st * 1024 + (ob ^ (((ob >> 9) & 1) << 5)); }
__host__ __device__ __forceinline__ void stage_rc(int b, int& R, int& C) { const int st = b / 1024, sb = b % 1024, swz = sb ^ (((sb >> 9) & 1) << 5); R = (st >> 1) * 16 + swz / 64; C = (st & 1) * 32 + (swz % 64) / 2; }
__host__ __device__ __forceinline__ int perm32(int rho) { const int n = rho >> 4, i = rho & 15; return 8 * (i >> 2) + 4 * n + (i & 3); }

struct Unit { int pm, pn, kt0, nkt, slab; };
struct Gemm { const bf16_t* A; const bf16_t* Bt; int M, N, K, pad; };

struct StaticOrder {
    int nM, nN, nwg, G, c, nktf;
    __host__ __device__ void init(int M, int N, int G_, int c_, int K) { nM = M / BM; nN = N / BM; nwg = nM * nN; G = G_; c = c_; nktf = K / BK; }
    __host__ __device__ bool next(int i, Unit& u) const {
        const long L = (long)i * G + c; if (L >= nwg) return false;
        int wgid = (int)L; { const int q = nwg / NXCD, r = nwg % NXCD, xcd = wgid % NXCD, off = wgid / NXCD; wgid = (xcd < r ? xcd * (q + 1) : r * (q + 1) + (xcd - r) * q) + off; }
        const int nig = WGM * nN, gid = wgid / nig, fm = gid * WGM, gsz = (nM - fm) < WGM ? (nM - fm) : WGM;
        u.pm = fm + ((wgid % nig) % gsz); u.pn = (wgid % nig) / gsz; u.kt0 = 0; u.nkt = nktf; u.slab = -1; return true;
    }
    __device__ __forceinline__ void a_ready(const Unit&) const {}
    __device__ __forceinline__ void done(const Unit&) const {}
};

struct SplitOrder {
    int c, nktf;
    __host__ __device__ void init(int c_, int K) { c = c_; nktf = K / BK; }
    __host__ __device__ bool next(int i, Unit& u) const {
        if (i > 1) return false;
        const bool sl = (i == 0);
        const int hi = c >> 3, lo = c & 7, nks = nktf / 8;
        u.pm = sl ? 32 + (hi >> 3) : 4 * lo + (hi >> 3); u.pn = hi & 7; u.nkt = sl ? nks : nktf; u.kt0 = sl ? lo * nks : 0; u.slab = sl ? lo : -1;
        return true;
    }
    __device__ __forceinline__ void a_ready(const Unit&) const {}
    __device__ __forceinline__ void done(const Unit&) const {}
};

__device__ __forceinline__ void st_wt16(void* p, u32x4 v) { asm volatile("global_store_dwordx4 %0, %1, off sc1\n\ts_nop 1" :: "v"(p), "v"(v) : "memory"); }
__device__ __forceinline__ unsigned cvt_pk_bf16(float lo, float hi) { unsigned r; asm volatile("v_cvt_pk_bf16_f32 %0, %1, %2" : "=v"(r) : "v"(lo), "v"(hi)); return r; }

template <int ACT  > struct EpiBf16P {
    static constexpr bool PERM = true, AFTER_DRAIN = false;
    bf16_t* O; int ldc, pad;
    __device__ __forceinline__ void operator()(const f32x4 (&acc)[2][2][4][2], const Unit& u, int wr, int wc, int fr, int fq) const {
        const int row0 = u.pm * BM + wr * 64 + fr; const int col0 = u.pn * BM + wc * 32 + 8 * fq;
#pragma unroll
        for (int ai = 0; ai < 2; ++ai)
#pragma unroll
            for (int m = 0; m < 4; ++m) { bf16_t* rowp = O + (size_t)(row0 + ai * HALF + m * 16) * ldc + col0;
#pragma unroll
                for (int bj = 0; bj < 2; ++bj) { f32x4 v0 = acc[ai][bj][m][0], v1 = acc[ai][bj][m][1];
                    if (ACT == 2) {
#pragma unroll
                        for (int j = 0; j < 4; ++j) { const float a = fmaxf(v0[j], 0.f), b = fmaxf(v1[j], 0.f); v0[j] = a * a; v1[j] = b * b; } }
                    u32x4 w; w.x = cvt_pk_bf16(v0[0], v0[1]); w.y = cvt_pk_bf16(v0[2], v0[3]); w.z = cvt_pk_bf16(v1[0], v1[1]); w.w = cvt_pk_bf16(v1[2], v1[3]);
                    st_wt16(rowp + bj * HALF, w); } }
    }
};
struct EpiF32P {
    static constexpr bool PERM = false, AFTER_DRAIN = false;
    float* C; int ldc, pad;
    __device__ __forceinline__ void operator()(const f32x4 (&acc)[2][2][4][2], const Unit& u, int wr, int wc, int fr, int fq) const {
        const int row0 = u.pm * BM + wr * 64 + fr, col0 = u.pn * BM + wc * 32 + 4 * fq;
#pragma unroll
        for (int ai = 0; ai < 2; ++ai)
#pragma unroll
            for (int m = 0; m < 4; ++m) { float* rowp = C + (size_t)(row0 + ai * HALF + m * 16) * ldc + col0;
#pragma unroll
                for (int bj = 0; bj < 2; ++bj)
#pragma unroll
                    for (int n = 0; n < 2; ++n) *(f32x4*)(rowp + bj * HALF + n * 16) = acc[ai][bj][m][n]; }
    }
};

__device__ __forceinline__ float softplus_e(float x) { return fmaxf(x, 0.f) + __logf(1.f + __expf(-fabsf(x))); }
struct EpiProj {
    static constexpr bool PERM = true, AFTER_DRAIN = false;
    bf16_t* O; float* dt; const float* dt_bias;
    __device__ __forceinline__ void operator()(const f32x4 (&acc)[2][2][4][2], const Unit& u, int wr, int wc, int fr, int fq) const {
        const int row0 = u.pm * BM + wr * 64 + fr;
        if (u.pn < 18) {
            const int col0 = u.pn * BM + wc * 32 + 8 * fq;
#pragma unroll
            for (int ai = 0; ai < 2; ++ai)
#pragma unroll
                for (int m = 0; m < 4; ++m) { bf16_t* rowp = O + (size_t)(row0 + ai * HALF + m * 16) * 4608 + col0;
#pragma unroll
                    for (int bj = 0; bj < 2; ++bj) { const f32x4 v0 = acc[ai][bj][m][0], v1 = acc[ai][bj][m][1];
                        u32x4 w; w.x = cvt_pk_bf16(v0[0], v0[1]); w.y = cvt_pk_bf16(v0[2], v0[3]); w.z = cvt_pk_bf16(v1[0], v1[1]); w.w = cvt_pk_bf16(v1[2], v1[3]);
                        *(u32x4*)(rowp + bj * HALF) = w; } }
        } else if (wc == 0 && fq < 2) {
#pragma unroll
            for (int ai = 0; ai < 2; ++ai)
#pragma unroll
                for (int m = 0; m < 4; ++m) { float* rowp = dt + (size_t)(row0 + ai * HALF + m * 16) * 16 + 8 * fq;
#pragma unroll
                    for (int n = 0; n < 2; ++n) { f32x4 v = acc[ai][0][m][n];
#pragma unroll
                        for (int j = 0; j < 4; ++j) v[j] = softplus_e(v[j] + dt_bias[8 * fq + 4 * n + j]);
                        *(f32x4*)(rowp + 4 * n) = v; } }
        }
    }
};

struct EpiF32S {
    static constexpr bool PERM = false, AFTER_DRAIN = false;
    float* C; float* slab; int ldc, pad;
    __device__ __forceinline__ void operator()(const f32x4 (&acc)[2][2][4][2], const Unit& u, int wr, int wc, int fr, int fq) const {
        const int row0 = u.pm * BM + wr * 64 + fr, col0 = u.pn * BM + wc * 32 + 4 * fq;
        float* base = u.slab < 0 ? C + (size_t)row0 * ldc : slab + (size_t)u.slab * (1024 * 2048) + (size_t)(row0 - 8192) * ldc;
#pragma unroll
        for (int ai = 0; ai < 2; ++ai)
#pragma unroll
            for (int m = 0; m < 4; ++m) { float* rowp = base + (size_t)(ai * HALF + m * 16) * ldc + col0;
#pragma unroll
                for (int bj = 0; bj < 2; ++bj)
#pragma unroll
                    for (int n = 0; n < 2; ++n) *(f32x4*)(rowp + bj * HALF + n * 16) = acc[ai][bj][m][n]; }
    }
};

struct EpiBf16S {
    static constexpr bool PERM = true, AFTER_DRAIN = false;
    bf16_t* O; bf16_t* slab; int ldc, pad;
    __device__ __forceinline__ void operator()(const f32x4 (&acc)[2][2][4][2], const Unit& u, int wr, int wc, int fr, int fq) const {
        const int row0 = u.pm * BM + wr * 64 + fr, col0 = u.pn * BM + wc * 32 + 8 * fq;
        bf16_t* base = u.slab < 0 ? O + (size_t)row0 * ldc + col0 : slab + (size_t)u.slab * (1024 * 2048) + (size_t)(row0 - 8192) * ldc + col0;
#pragma unroll
        for (int ai = 0; ai < 2; ++ai)
#pragma unroll
            for (int m = 0; m < 4; ++m) { bf16_t* rowp = base + (size_t)(ai * HALF + m * 16) * ldc;
#pragma unroll
                for (int bj = 0; bj < 2; ++bj) { const f32x4 v0 = acc[ai][bj][m][0], v1 = acc[ai][bj][m][1];
                    u32x4 w; w.x = cvt_pk_bf16(v0[0], v0[1]); w.y = cvt_pk_bf16(v0[2], v0[3]); w.z = cvt_pk_bf16(v1[0], v1[1]); w.w = cvt_pk_bf16(v1[2], v1[3]);
                    *(u32x4*)(rowp + bj * HALF) = w; } }
    }
};
template <class Epi, class Sched, bool ALIGN_EPI = false, bool SP2 = false>
__device__ __forceinline__ void gemm_phase(PG8_LAS unsigned char* lds, const Gemm g, const Sched& S, const Epi& E) {
    int tid = threadIdx.x; asm volatile("" : "+v"(tid)); const int wid = __builtin_amdgcn_readfirstlane(tid >> 6), lane = tid & 63, wr = wid >> 2, wc = wid & 3, fr = lane & 15, fq = lane >> 4;
    const int K = g.K; int nt;
    unsigned voffA[2], voffB[2];
#pragma unroll
    for (int i = 0; i < 2; ++i) { int R, C; stage_rc(tid * 16 + i * 8192, R, C); const int Rb = Epi::PERM ? ((R & ~31) + perm32(R & 31)) : R;
        voffA[i] = (unsigned)(R * K + C) * 2u; voffB[i] = (unsigned)(Rb * K + C) * 2u; }
    const size_t kstep = (size_t)(BK * 2);
    const size_t hstep = (size_t)HALF * K * 2;
    const size_t tstep = 2 * hstep;
    const unsigned ldsw = (unsigned)wid * 1024u;
    const int aoff = lds_byte(wr * 64 + fr, fq * 8), boff = lds_byte(wc * 32 + fr, fq * 8);
#define PG8_SA(b, h) (((b) * 2 + (h)) * HTB)
#define PG8_SB(b, h) ((4 + (b) * 2 + (h)) * HTB)
#define PG8_STAGE(bufoff, gbase, voff) do { _Pragma("unroll") for (int _i = 0; _i < 2; ++_i) \
        __builtin_amdgcn_global_load_lds((const unsigned*)((const char*)(gbase) + (voff)[_i]), (PG8_LAS unsigned*)(lds + (bufoff) + ldsw + _i * 8192), 16, 0, 0); } while (0)
#define PG8_LDA(dst, b, h) do { _Pragma("unroll") for (int m = 0; m < 4; ++m) _Pragma("unroll") for (int k = 0; k < 2; ++k) dst[m][k] = *(const PG8_LAS bf16x8*)(lds + PG8_SA(b, h) + aoff + m * 2048 + k * 1024); } while (0)
#define PG8_LDB(dst, b, h) do { _Pragma("unroll") for (int n = 0; n < 2; ++n) _Pragma("unroll") for (int k = 0; k < 2; ++k) dst[n][k] = *(const PG8_LAS bf16x8*)(lds + PG8_SB(b, h) + boff + n * 2048 + k * 1024); } while (0)
#define PG8_MMA(ai, bj, At, Bt) do { __builtin_amdgcn_s_setprio(1); _Pragma("unroll") for (int m = 0; m < 4; ++m) _Pragma("unroll") for (int n = 0; n < 2; ++n) _Pragma("unroll") for (int k = 0; k < 2; ++k) \
        acc[ai][bj][m][n] = __builtin_amdgcn_mfma_f32_16x16x32_bf16(Bt[n][k], At[m][k], acc[ai][bj][m][n], 0, 0, 0); __builtin_amdgcn_s_setprio(0); } while (0)
#define PG8_WAIT_V(n) asm volatile("s_waitcnt vmcnt(" #n ")" ::: "memory")
#define PG8_WAIT_L(n) asm volatile("s_waitcnt lgkmcnt(" #n ")" ::: "memory")
#define PG8_BAR __builtin_amdgcn_s_barrier()
#define PG8_SCHED __builtin_amdgcn_sched_barrier(0)
    Unit cur, nxt; int ui = 0;
    if (!S.next(0, cur)) return;
    f32x4 acc[2][2][4][2];
#pragma unroll
    for (int a = 0; a < 2; ++a)
#pragma unroll
        for (int b = 0; b < 2; ++b)
#pragma unroll
            for (int m = 0; m < 4; ++m)
#pragma unroll
                for (int n = 0; n < 2; ++n) acc[a][b][m][n] = (f32x4){0.f, 0.f, 0.f, 0.f};
    bf16x8 At[4][2], B0[2][2], B1[2][2];
    const char* cA = (const char*)g.A + (size_t)cur.pm * tstep + (size_t)cur.kt0 * kstep; const char* cB = (const char*)g.Bt + (size_t)cur.pn * tstep + (size_t)cur.kt0 * kstep; nt = cur.nkt;
    S.a_ready(cur);
    if constexpr (SP2) {
        PG8_STAGE(PG8_SB(0, 0), cB, voffB); PG8_STAGE(PG8_SB(0, 1), cB + hstep, voffB); PG8_STAGE(PG8_SA(0, 0), cA, voffA); PG8_STAGE(PG8_SA(0, 1), cA + hstep, voffA);
        if (wr == 1) PG8_BAR;
        PG8_WAIT_V(2); PG8_BAR;
        PG8_STAGE(PG8_SB(1, 0), cB + kstep, voffB); PG8_STAGE(PG8_SA(1, 0), cA + kstep, voffA); PG8_STAGE(PG8_SB(1, 1), cB + hstep + kstep, voffB);
        PG8_WAIT_V(6); PG8_BAR;
    } else {
        PG8_STAGE(PG8_SB(0, 0), cB, voffB); PG8_STAGE(PG8_SA(0, 0), cA, voffA); PG8_STAGE(PG8_SB(0, 1), cB + hstep, voffB); PG8_STAGE(PG8_SA(0, 1), cA + hstep, voffA);
        if (wr == 1) PG8_BAR;
        PG8_WAIT_V(4); PG8_BAR;
        PG8_STAGE(PG8_SB(1, 0), cB + kstep, voffB); PG8_STAGE(PG8_SA(1, 0), cA + kstep, voffA); PG8_STAGE(PG8_SB(1, 1), cB + hstep + kstep, voffB);
        PG8_WAIT_V(6); PG8_BAR;
    }
    for (;;) {
        const bool has_next = S.next(ui + 1, nxt);
        const char* nA = has_next ? (const char*)g.A + (size_t)nxt.pm * tstep + (size_t)nxt.kt0 * kstep : cA; const char* nB = has_next ? (const char*)g.Bt + (size_t)nxt.pn * tstep + (size_t)nxt.kt0 * kstep : cB;
        for (int t = 0; t < nt; t += 2) {
            const bool last = (t == nt - 2);
            const char* a1 = cA + (size_t)(t + 1) * kstep;
            const char* a2 = last ? nA : cA + (size_t)(t + 2) * kstep; const char* b2 = last ? nB : cB + (size_t)(t + 2) * kstep;
            const char* a3 = a2 + kstep; const char* b3 = b2 + kstep;
            if (last && has_next) S.a_ready(nxt);
            if constexpr (SP2) {
            PG8_LDB(B0, 0, 0); PG8_LDB(B1, 0, 1); PG8_SCHED; PG8_LDA(At, 0, 0); PG8_STAGE(PG8_SA(1, 1), a1 + hstep, voffA);
            PG8_WAIT_V(8); PG8_WAIT_L(0); PG8_BAR; PG8_MMA(0, 0, At, B0); PG8_MMA(0, 1, At, B1); PG8_BAR; PG8_SCHED;
            PG8_LDA(At, 0, 1); PG8_STAGE(PG8_SB(0, 0), b2, voffB); PG8_STAGE(PG8_SB(0, 1), b2 + hstep, voffB); PG8_STAGE(PG8_SA(0, 0), a2, voffA);
            PG8_WAIT_V(8); PG8_WAIT_L(0); PG8_BAR; PG8_MMA(1, 0, At, B0); PG8_MMA(1, 1, At, B1); PG8_BAR; PG8_SCHED;
            PG8_LDB(B0, 1, 0); PG8_LDB(B1, 1, 1); PG8_SCHED; PG8_LDA(At, 1, 0); PG8_STAGE(PG8_SA(0, 1), a2 + hstep, voffA);
            PG8_WAIT_V(8); PG8_WAIT_L(0); PG8_BAR; PG8_MMA(0, 0, At, B0); PG8_MMA(0, 1, At, B1); PG8_BAR; PG8_SCHED;
            PG8_LDA(At, 1, 1); PG8_STAGE(PG8_SB(1, 0), b3, voffB); PG8_STAGE(PG8_SB(1, 1), b3 + hstep, voffB); PG8_STAGE(PG8_SA(1, 0), a3, voffA);
            PG8_WAIT_V(8); PG8_WAIT_L(0); PG8_BAR; PG8_MMA(1, 0, At, B0); PG8_MMA(1, 1, At, B1); PG8_BAR; PG8_SCHED;
            } else {
            PG8_LDB(B0, 0, 0); PG8_SCHED; PG8_LDA(At, 0, 0); PG8_STAGE(PG8_SA(1, 1), a1 + hstep, voffA);
            PG8_WAIT_L(8); PG8_BAR; PG8_WAIT_L(0); PG8_MMA(0, 0, At, B0); PG8_BAR; PG8_SCHED;
            PG8_LDB(B1, 0, 1); PG8_STAGE(PG8_SB(0, 0), b2, voffB);
            PG8_BAR; PG8_WAIT_L(0); PG8_MMA(0, 1, At, B1); PG8_BAR;
            PG8_LDA(At, 0, 1); PG8_STAGE(PG8_SA(0, 0), a2, voffA);
            PG8_BAR; PG8_WAIT_L(0); PG8_MMA(1, 0, At, B0); PG8_BAR; PG8_SCHED;
            PG8_STAGE(PG8_SB(0, 1), b2 + hstep, voffB);
            PG8_WAIT_V(6); PG8_BAR; PG8_MMA(1, 1, At, B1); PG8_BAR;
            PG8_LDB(B0, 1, 0); PG8_SCHED; PG8_LDA(At, 1, 0); PG8_STAGE(PG8_SA(0, 1), a2 + hstep, voffA);
            PG8_WAIT_L(8); PG8_BAR; PG8_WAIT_L(0); PG8_MMA(0, 0, At, B0); PG8_BAR; PG8_SCHED;
            PG8_LDB(B1, 1, 1); PG8_STAGE(PG8_SB(1, 0), b3, voffB);
            PG8_BAR; PG8_WAIT_L(0); PG8_MMA(0, 1, At, B1); PG8_BAR;
            PG8_LDA(At, 1, 1); PG8_STAGE(PG8_SA(1, 0), a3, voffA);
            PG8_BAR; PG8_WAIT_L(0); PG8_MMA(1, 0, At, B0); PG8_BAR; PG8_SCHED;
            PG8_STAGE(PG8_SB(1, 1), b3 + hstep, voffB);
            PG8_WAIT_V(6); PG8_BAR; PG8_MMA(1, 1, At, B1); PG8_BAR;
            }
        }
        if constexpr (ALIGN_EPI) { if (wr == 0) PG8_BAR; }
        if (!Epi::AFTER_DRAIN || has_next) { E(acc, cur, wr, wc, fr, fq); S.done(cur); }
        if (!has_next) break;
#pragma unroll
        for (int a = 0; a < 2; ++a)
#pragma unroll
            for (int b = 0; b < 2; ++b)
#pragma unroll
                for (int m = 0; m < 4; ++m)
#pragma unroll
                    for (int n = 0; n < 2; ++n) acc[a][b][m][n] = (f32x4){0.f, 0.f, 0.f, 0.f};
        cur = nxt; cA = nA; cB = nB; ++ui; nt = cur.nkt;
        if constexpr (ALIGN_EPI) { if (wr == 1) PG8_BAR; }
    }
    PG8_WAIT_V(0);
    if constexpr (!ALIGN_EPI) { if (wr == 0) PG8_BAR; }
    PG8_BAR;
    if constexpr (Epi::AFTER_DRAIN) { E.fused(acc, cur, wr, wc, fr, fq, lds, wid, lane); S.done(cur); }
#undef PG8_SA
#undef PG8_SB
#undef PG8_STAGE
#undef PG8_LDA
#undef PG8_LDB
#undef PG8_MMA
#undef PG8_WAIT_V
#undef PG8_WAIT_L
#undef PG8_BAR
#undef PG8_SCHED
}
}

typedef unsigned short bf16;
typedef float f32x4 __attribute__((ext_vector_type(4)));
constexpr int DM = 2048, NPB = 4, SEQ = 2048, NSB = 128, DSEQ = 8;
constexpr int MP = NPB * SEQ, MS = NSB * DSEQ, MROWS = MP + MS;
constexpr int NSEQ = NPB + NSB;
constexpr int SSDW = 1024, HDIM = 64, NHEAD = 16, NGRP = 2, NSTATE = 128, CONVD = 1536, GMW = 1024, GMHD = 128, GMNH = 8, DFF = 8192;
constexpr int DINP = 4624, NPROJ = 4608;
constexpr int PZ = 0, PX = 1024, PU = 2560, PV = 3584;
constexpr int NMOD = 6 * DM;
constexpr float LN_EPS = 1e-5f, ALPHA = 1.189207115002721f;
constexpr size_t O_YP = 0, O_YS = 16777216, O_SSMP = 18874368, O_CONVP = 19398656, O_SSMS = 19417088, O_CONVS = 36194304, O_CV = 36784128;
constexpr size_t MiB = 1u << 20;
constexpr size_t WS_WIN = 2 * MiB, WS_WOUT = 22 * MiB, WS_WFF1 = 30 * MiB, WS_WFF2 = 62 * MiB, WS_MOD = 95 * MiB, WS_STATS = 102 * MiB, WS_DT = 103 * MiB, WS_CD = 104 * MiB;
constexpr size_t WS_XB1 = 104 * MiB + 256 * 1024, WS_XB2 = 105 * MiB;
constexpr size_t WS_H = 106 * MiB;
constexpr size_t WS_BIG = 142 * MiB;
constexpr size_t WS_ACT = WS_BIG + 81 * MiB;
constexpr size_t WS_E = 286 * MiB;
constexpr size_t WS_VN = WS_E + 36 * MiB;
constexpr size_t WS_SIN = 358 * MiB;
constexpr size_t WS_SLAB2 = 322 * MiB;
constexpr size_t WS_END = 386 * MiB;

__device__ __forceinline__ float bf2f(bf16 b) { return __uint_as_float(((unsigned)b) << 16); }
__device__ __forceinline__ bf16 f2bf(float f) { unsigned u = __float_as_uint(f); return (bf16)((u + 0x7fffu + ((u >> 16) & 1u)) >> 16); }
__device__ __forceinline__ float silu_f(float x) { return x / (1.f + expf(-x)); }
__device__ __forceinline__ float softplus_f(float x) { return fmaxf(x, 0.f) + log1pf(expf(-fabsf(x))); }
__device__ __forceinline__ float gelu_f(float x) { return 0.5f * x * (1.f + tanhf(0.7978845608028654f * (x + 0.044715f * x * x * x))); }
__device__ __forceinline__ int modrow(int r) { return r < MP ? (r >> 11) : NPB + ((r - MP) >> 3); }
__device__ __forceinline__ float wave_sum(float v) {
#pragma unroll
    for (int o = 1; o < 64; o <<= 1) v += __shfl_xor(v, o);
    return v;
}
__device__ __forceinline__ float block_sum256(float v, float* red) {
    v = wave_sum(v);
    __syncthreads();
    if ((threadIdx.x & 63) == 0) red[threadIdx.x >> 6] = v;
    __syncthreads();
    return (red[0] + red[1]) + (red[2] + red[3]);
}


#define GAS __attribute__((address_space(1)))
#define LAS __attribute__((address_space(3)))
typedef GAS unsigned gu32;
constexpr int NWAVES = 8;
constexpr int LDSCTL_OFF = 155648, MISC_OFF = LDSCTL_OFF + 320, LDS_BYTES = 163840;
constexpr size_t WS_CTL = 0, CTL_ZERO_BYTES = 64 * 1024;
constexpr int CW_BAR = 1024, CW_CSILU = 512;
#define XB_TMO      128
#define XB_XCNT(j)  (256  + 64 * (j))
#define XB_XSUB(j)  (1280 + 64 * (j))
#define XB_XGEN(j)  (2304 + 64 * (j))
#define XB_TOP      3328
#define XB_TOPGEN   3392
#define XCD_BAR_WORDS 3456
#define XB_SPIN_CAP (1u << 18)

__device__ __forceinline__ unsigned xb_ld(unsigned* p)              { return __hip_atomic_load(p, __ATOMIC_RELAXED, __HIP_MEMORY_SCOPE_AGENT); }
__device__ __forceinline__ unsigned xb_add(unsigned* p, unsigned v) { return __hip_atomic_fetch_add(p, v, __ATOMIC_RELAXED, __HIP_MEMORY_SCOPE_AGENT); }
__device__ __forceinline__ unsigned xb_xcc_id() { return (unsigned)__builtin_amdgcn_s_getreg((3 << 11) | 20) & 0xFu; }
#define XB_SPIN(cond, bar) do { unsigned _sp = 0; while (cond) { __builtin_amdgcn_s_sleep(1); \
    if ((++_sp & 255u) == 0u) { if (xb_ld(&(bar)[XB_TMO])) break; if (_sp > XB_SPIN_CAP) { atomicAdd(&(bar)[XB_TMO], 1u); break; } } } } while (0)

struct XcdBarrier {
    unsigned* bar; unsigned x;
    volatile LAS unsigned* st;
};

__device__ __forceinline__ XcdBarrier xcd_barrier_post(unsigned* bar, volatile LAS unsigned* st) {
    XcdBarrier b; b.bar = bar; b.x = xb_xcc_id(); b.st = st;
    if (threadIdx.x == 0) (void)xb_add(&bar[XB_XCNT(b.x)], 1u);
    return b;
}
__device__ __forceinline__ void xcd_barrier_complete(unsigned* bar, unsigned x, unsigned& nloc, unsigned& nx) {
    const unsigned G = gridDim.x * gridDim.y * gridDim.z;
    unsigned sum, cnt, mine, sp = 0u;
    for (;;) {
        sum = 0u; cnt = 0u; mine = 0u;
#pragma unroll
        for (unsigned j = 0; j < 16; ++j) { const unsigned c = xb_ld(&bar[XB_XCNT(j)]); sum += c; cnt += (c > 0u) ? 1u : 0u; mine = (j == x) ? c : mine; }
        if (sum == G) break;
        __builtin_amdgcn_s_sleep(1);
        if ((++sp & 255u) == 0u) { if (xb_ld(&bar[XB_TMO])) break; if (sp > XB_SPIN_CAP) { atomicAdd(&bar[XB_TMO], 1u); break; } }
    }
    nloc = mine > 0u ? mine : 1u; nx = cnt > 0u ? cnt : 1u;
}

__device__ __forceinline__ void xcd_barrier(const XcdBarrier& b) {
    asm volatile("s_waitcnt vmcnt(0)" ::: "memory");
    __syncthreads();
    if (threadIdx.x == 0) {
        unsigned* bar = b.bar;
        __builtin_amdgcn_s_waitcnt(0);
        unsigned nloc = b.st[0], nx = b.st[1];
        if (nloc == 0u) { xcd_barrier_complete(bar, b.x, nloc, nx); b.st[0] = nloc; b.st[1] = nx; }
        const unsigned old = xb_add(&bar[XB_XSUB(b.x)], 1u);
        const unsigned gen = old / nloc;
        if (old + 1u == (gen + 1u) * nloc) {
            __builtin_amdgcn_fence(__ATOMIC_RELEASE, "agent");
            asm volatile("s_waitcnt vmcnt(0)" ::: "memory");
            const unsigned og = xb_add(&bar[XB_TOP], 1u);
            const unsigned tg = og / nx;
            if (og + 1u == (tg + 1u) * nx) xb_add(&bar[XB_TOPGEN], 1u);
            else XB_SPIN(xb_ld(&bar[XB_TOPGEN]) == tg, bar);
            __builtin_amdgcn_fence(__ATOMIC_ACQUIRE, "agent");
            xb_add(&bar[XB_XGEN(b.x)], 1u);
            asm volatile("s_waitcnt vmcnt(0)" ::: "memory");
        } else {
            XB_SPIN(xb_ld(&bar[XB_XGEN(b.x)]) == gen, bar);
            __builtin_amdgcn_fence(__ATOMIC_ACQUIRE, "agent");
            asm volatile("s_waitcnt vmcnt(0)" ::: "memory");
        }
    }
    __syncthreads();
}
template <class F> __device__ __forceinline__ void xcd_barrier_fill(const XcdBarrier& b, F&& fill) {
    asm volatile("s_waitcnt vmcnt(0)" ::: "memory");
    __syncthreads();
    if (threadIdx.x == 0) {
        unsigned* bar = b.bar;
        __builtin_amdgcn_s_waitcnt(0);
        unsigned nloc = b.st[0], nx = b.st[1];
        if (nloc == 0u) { xcd_barrier_complete(bar, b.x, nloc, nx); b.st[0] = nloc; b.st[1] = nx; }
        const unsigned old = xb_add(&bar[XB_XSUB(b.x)], 1u);
        const unsigned gen = old / nloc;
        if (old + 1u == (gen + 1u) * nloc) {
            __builtin_amdgcn_fence(__ATOMIC_RELEASE, "agent");
            asm volatile("s_waitcnt vmcnt(0)" ::: "memory");
            const unsigned og = xb_add(&bar[XB_TOP], 1u);
            const unsigned tg = og / nx;
            if (og + 1u == (tg + 1u) * nx) xb_add(&bar[XB_TOPGEN], 1u);
            else XB_SPIN(xb_ld(&bar[XB_TOPGEN]) == tg, bar);
            __builtin_amdgcn_fence(__ATOMIC_ACQUIRE, "agent");
            xb_add(&bar[XB_XGEN(b.x)], 1u);
            asm volatile("s_waitcnt vmcnt(0)" ::: "memory");
        } else {
            XB_SPIN(xb_ld(&bar[XB_XGEN(b.x)]) == gen, bar);
            __builtin_amdgcn_fence(__ATOMIC_ACQUIRE, "agent");
            asm volatile("s_waitcnt vmcnt(0)" ::: "memory");
        }
    } else if (threadIdx.x >= 64) { fill(); }
    __syncthreads();
}


struct Args { const float* in[28]; float* out; unsigned char* ws; };
struct VB { int vt, id, n; LAS float* scr; };

__device__ __forceinline__ float vb_sum(float v, LAS float* red, int vt) {
    v = wave_sum(v);
    __syncthreads();
    if ((vt & 63) == 0) red[vt >> 6] = v;
    __syncthreads();
    return (red[0] + red[1]) + (red[2] + red[3]);
}


typedef short bf16x8 __attribute__((ext_vector_type(8)));
typedef unsigned u32x4 __attribute__((ext_vector_type(4)));
typedef unsigned u32x2 __attribute__((ext_vector_type(2)));
constexpr int LDT = 136;
constexpr int SSD_IMG = 128 * LDT * 2;
constexpr int SSD_XT = 256 * LDT * 2;
__device__ __forceinline__ unsigned pk_bf16(float lo, float hi) { unsigned r; asm volatile("v_cvt_pk_bf16_f32 %0, %1, %2" : "=v"(r) : "v"(lo), "v"(hi)); return r; }
__device__ __forceinline__ float fast_silu(float a) { return a * __builtin_amdgcn_rcpf(1.f + __expf(-a)); }

template <int NCH, bool TR> __device__ __forceinline__ void stage_conv(LAS bf16* dst, int chan0, int R0, bool first, const bf16* __restrict__ proj, const float* __restrict__ conv_w, const float* __restrict__ conv_b, int tid) {
    constexpr int NG = NCH / 8, TB = (NG == 32) ? 8 : 4, CGB = NG / 8;
    int cg, tb;
    if (TR) { const int wv = tid >> 6, ln = tid & 63; cg = 8 * (wv % CGB) + (ln >> 3); tb = 8 * (wv / CGB) + (ln & 7); }
    else { cg = tid % NG; tb = tid / NG; }
    const int ch = chan0 + 8 * cg, j0 = TB * tb;
    const bf16* src = proj + (size_t)R0 * NPROJ + PX + ch;
    u32x4 row[TB + 3];
#pragma unroll
    for (int i = 0; i < TB + 3; ++i) { const int jj = j0 - 3 + i; row[i] = (jj >= 0 || !first) ? *(const u32x4*)(src + (ptrdiff_t)jj * NPROJ) : (u32x4){0u, 0u, 0u, 0u}; }
    float w[4][8], bias[8];
#pragma unroll
    for (int k = 0; k < 4; ++k) { const f32x4 a = *(const f32x4*)(conv_w + k * CONVD + ch), b = *(const f32x4*)(conv_w + k * CONVD + ch + 4);
        w[k][0] = a[0]; w[k][1] = a[1]; w[k][2] = a[2]; w[k][3] = a[3]; w[k][4] = b[0]; w[k][5] = b[1]; w[k][6] = b[2]; w[k][7] = b[3]; }
    { const f32x4 a = *(const f32x4*)(conv_b + ch), b = *(const f32x4*)(conv_b + ch + 4); bias[0] = a[0]; bias[1] = a[1]; bias[2] = a[2]; bias[3] = a[3]; bias[4] = b[0]; bias[5] = b[1]; bias[6] = b[2]; bias[7] = b[3]; }
    unsigned outp[8][TB / 2];
#pragma unroll
    for (int q = 0; q < TB / 2; ++q) {
        float a0[8], a1[8];
#pragma unroll
        for (int e = 0; e < 8; ++e) { a0[e] = bias[e]; a1[e] = bias[e]; }
#pragma unroll
        for (int k = 0; k < 4; ++k) { const u32x4 v0 = row[2 * q + k], v1 = row[2 * q + 1 + k];
#pragma unroll
            for (int e = 0; e < 4; ++e) { a0[2 * e] += w[k][2 * e] * __uint_as_float(v0[e] << 16); a0[2 * e + 1] += w[k][2 * e + 1] * __uint_as_float(v0[e] & 0xffff0000u);
                                          a1[2 * e] += w[k][2 * e] * __uint_as_float(v1[e] << 16); a1[2 * e + 1] += w[k][2 * e + 1] * __uint_as_float(v1[e] & 0xffff0000u); } }
#pragma unroll
        for (int e = 0; e < 8; ++e) { a0[e] = fast_silu(a0[e]); a1[e] = fast_silu(a1[e]); }
        if (TR) {
#pragma unroll
            for (int e = 0; e < 8; ++e) outp[e][q] = pk_bf16(a0[e], a1[e]);
        } else {
            u32x4 o; o.x = pk_bf16(a0[0], a0[1]); o.y = pk_bf16(a0[2], a0[3]); o.z = pk_bf16(a0[4], a0[5]); o.w = pk_bf16(a0[6], a0[7]);
            *(LAS u32x4*)(dst + (j0 + 2 * q) * LDT + 8 * cg) = o;
            o.x = pk_bf16(a1[0], a1[1]); o.y = pk_bf16(a1[2], a1[3]); o.z = pk_bf16(a1[4], a1[5]); o.w = pk_bf16(a1[6], a1[7]);
            *(LAS u32x4*)(dst + (j0 + 2 * q + 1) * LDT + 8 * cg) = o;
        }
    }
    if (TR) {
#pragma unroll
        for (int e = 0; e < 8; ++e) {
            if (TB == 8) { u32x4 o; o.x = outp[e][0]; o.y = outp[e][1]; o.z = outp[e][TB / 2 - 2]; o.w = outp[e][TB / 2 - 1]; *(LAS u32x4*)(dst + (8 * cg + e) * LDT + j0) = o; }
            else { u32x2 o; o.x = outp[e][0]; o.y = outp[e][1]; *(LAS u32x2*)(dst + (8 * cg + e) * LDT + j0) = o; }
        }
    }
}
__device__ __forceinline__ float ssd_scalars(LAS float* dtv, LAS float* acum, int R0, int h, int wid, int lane, const float* __restrict__ dt, const float* __restrict__ a_log) {
    const float A = -__expf(a_log[h]);
    const int j0 = 2 * lane;
    const float d0 = dt[(size_t)(R0 + j0) * 16 + h], d1 = dt[(size_t)(R0 + j0 + 1) * 16 + h];
    const float a0 = d0 * A, a1 = d1 * A;
    float s = a0 + a1;
#pragma unroll
    for (int o = 1; o < 64; o <<= 1) { const float t = __shfl_up(s, o); if (lane >= o) s += t; }
    dtv[wid * 128 + j0] = d0; dtv[wid * 128 + j0 + 1] = d1;
    acum[wid * 128 + j0] = s - a1; acum[wid * 128 + j0 + 1] = s;
    return __shfl(s, 63);
}

__device__ __forceinline__ void ssd_phaseA_item(LAS unsigned char* lds, int item, const bf16* __restrict__ proj, const float* __restrict__ dt, const float* __restrict__ conv_w, const float* __restrict__ conv_b,
                                                const float* __restrict__ a_log, bf16* __restrict__ cs, float* __restrict__ cd, bf16* __restrict__ xs) {
    int tid = threadIdx.x; asm volatile("" : "+v"(tid)); const int wid = __builtin_amdgcn_readfirstlane(tid >> 6), lane = tid & 63, fr = lane & 15, fq = lane >> 4;
    const int pass = item & 1, b = item >> 6, c = (item >> 2) & 15, g = (item >> 1) & 1, R0 = b * SEQ + c * 128;
    LAS bf16* BT = (LAS bf16*)lds; LAS bf16* xT = (LAS bf16*)(lds + SSD_IMG);
    LAS float* dtv = (LAS float*)(lds + SSD_IMG + SSD_XT); LAS float* acum = dtv + 8 * 128; LAS float* wj = acum + 8 * 128;
    __syncthreads();
    { const int h = g * 8 + wid; const float tot = ssd_scalars(dtv, acum, R0, h, wid, lane, dt, a_log);
      const int j0 = 2 * lane;
      wj[wid * 128 + j0] = dtv[wid * 128 + j0] * __expf(tot - acum[wid * 128 + j0]); wj[wid * 128 + j0 + 1] = dtv[wid * 128 + j0 + 1] * __expf(tot - acum[wid * 128 + j0 + 1]);
      if (lane == 0 && pass == 0) cd[(b * 16 + c) * 16 + h] = __expf(tot); }
    stage_conv<128, true>(BT, SSDW + g * NSTATE, R0, c == 0, proj, conv_w, conv_b, tid);
    {
        stage_conv<256, true>(xT, (g * 8 + pass * 4) * HDIM, R0, c == 0, proj, conv_w, conv_b, tid);
        __syncthreads();
        {
            bf16* xd = xs + (size_t)item * (SSD_XT / 2);
#pragma unroll
            for (int i = 0; i < 9; ++i) { const int idx = tid + 512 * i; if (idx < SSD_XT / 16) *(u32x4*)(xd + 8 * idx) = *(LAS u32x4*)(xT + 8 * idx); }
        }
        const int hl = wid >> 1, nh = wid & 1, hh = pass * 4 + hl;
        f32x4 acc[4][4];
#pragma unroll
        for (int m = 0; m < 4; ++m)
#pragma unroll
            for (int n = 0; n < 4; ++n) acc[m][n] = (f32x4){0.f, 0.f, 0.f, 0.f};
#pragma unroll
        for (int ks = 0; ks < 4; ++ks) {
            const int j = 32 * ks + 8 * fq;
            const f32x4 w0 = *(LAS f32x4*)(wj + hh * 128 + j), w1 = *(LAS f32x4*)(wj + hh * 128 + j + 4);
            bf16x8 xs[4];
#pragma unroll
            for (int nt = 0; nt < 4; ++nt) { const u32x4 raw = *(LAS u32x4*)(xT + (hl * 64 + 16 * nt + fr) * LDT + j);
                u32x4 o;
                o.x = pk_bf16(__uint_as_float(raw.x << 16) * w0[0], __uint_as_float(raw.x & 0xffff0000u) * w0[1]);
                o.y = pk_bf16(__uint_as_float(raw.y << 16) * w0[2], __uint_as_float(raw.y & 0xffff0000u) * w0[3]);
                o.z = pk_bf16(__uint_as_float(raw.z << 16) * w1[0], __uint_as_float(raw.z & 0xffff0000u) * w1[1]);
                o.w = pk_bf16(__uint_as_float(raw.w << 16) * w1[2], __uint_as_float(raw.w & 0xffff0000u) * w1[3]);
                xs[nt] = __builtin_bit_cast(bf16x8, o); }
#pragma unroll
            for (int mt = 0; mt < 4; ++mt) { const bf16x8 a = *(LAS bf16x8*)(BT + (64 * nh + 32 * (mt >> 1) + 8 * (fr >> 2) + 4 * (mt & 1) + (fr & 3)) * LDT + j);
#pragma unroll
                for (int nt = 0; nt < 4; ++nt) acc[mt][nt] = __builtin_amdgcn_mfma_f32_16x16x32_bf16(a, xs[nt], acc[mt][nt], 0, 0, 0); }
        }
        bf16* dst = cs + ((size_t)((b * 16 + c) * 16 + g * 8 + hh) * HDIM) * NSTATE;
        __builtin_amdgcn_sched_barrier(0);
        asm volatile("s_nop 15\n\ts_nop 7" ::: "memory");
#pragma unroll
        for (int q = 0; q < 2; ++q)
#pragma unroll
            for (int nt = 0; nt < 4; ++nt) { u32x4 w; w.x = pk_bf16(acc[2 * q][nt][0], acc[2 * q][nt][1]); w.y = pk_bf16(acc[2 * q][nt][2], acc[2 * q][nt][3]);
                w.z = pk_bf16(acc[2 * q + 1][nt][0], acc[2 * q + 1][nt][1]); w.w = pk_bf16(acc[2 * q + 1][nt][2], acc[2 * q + 1][nt][3]);
                *(u32x4*)(dst + (size_t)(16 * nt + fr) * NSTATE + 64 * nh + 32 * q + 8 * fq) = w; }
    }
}

constexpr int PC_RC = 0, PC_RG = SSD_IMG, PC_RX = 2 * SSD_IMG, PC_SCAL = 2 * SSD_IMG + SSD_XT, PC_SQ = PC_SCAL + 2 * 8 * 128 * 4, PC_END = PC_SQ + 128 * 8 * 4;
__device__ __forceinline__ void ssd_phaseC_item(LAS unsigned char* lds, int item, const bf16* __restrict__ proj, const float* __restrict__ dt, const float* __restrict__ conv_w, const float* __restrict__ conv_b,
                                                const float* __restrict__ a_log, const float* __restrict__ d_skip, const float* __restrict__ gw, const bf16* __restrict__ s_in, const bf16* __restrict__ xs, bf16* __restrict__ A2) {
    int tid = threadIdx.x; asm volatile("" : "+v"(tid)); const int wid = __builtin_amdgcn_readfirstlane(tid >> 6), lane = tid & 63, fr = lane & 15, fq = lane >> 4;
    const int b = item >> 5, c = (item >> 1) & 15, g = item & 1, R0 = b * SEQ + c * 128;
    LAS bf16* RC = (LAS bf16*)(lds + PC_RC); LAS bf16* RG = (LAS bf16*)(lds + PC_RG); LAS bf16* RX = (LAS bf16*)(lds + PC_RX);
    LAS float* dtv = (LAS float*)(lds + PC_SCAL); LAS float* acum = dtv + 8 * 128; LAS float* sqb = (LAS float*)(lds + PC_SQ);
    __syncthreads();
    const char* xsrc = (const char*)(xs + (size_t)(item * 2) * (SSD_XT / 2)) + lane * 16;
#define PC_XLOAD(ps) do { _Pragma("unroll") for (int i_ = 0; i_ < 9; ++i_) { const int k_ = wid + 8 * i_; if (k_ < SSD_XT / 1024) \
        __builtin_amdgcn_global_load_lds((const unsigned*)(xsrc + (size_t)(ps) * SSD_XT + k_ * 1024), (LAS unsigned*)(lds + PC_RX + k_ * 1024), 16, 0, 0); } } while (0)
    PC_XLOAD(0);
    (void)ssd_scalars(dtv, acum, R0, g * 8 + wid, wid, lane, dt, a_log);
    stage_conv<128, false>(RC, SSDW + NGRP * NSTATE + g * NSTATE, R0, c == 0, proj, conv_w, conv_b, tid);
    stage_conv<128, false>(RG, SSDW + g * NSTATE, R0, c == 0, proj, conv_w, conv_b, tid);
    __syncthreads();
    {
        f32x4 ga[8];
#pragma unroll
        for (int jt = 0; jt < 8; ++jt) ga[jt] = (f32x4){0.f, 0.f, 0.f, 0.f};
#pragma unroll
        for (int ks = 0; ks < 4; ++ks) { const int n0 = 32 * ks + 8 * fq;
            const bf16x8 a = *(LAS bf16x8*)(RC + (16 * wid + fr) * LDT + n0);
#pragma unroll
            for (int jt = 0; jt < 8; ++jt) if (jt <= wid) { const bf16x8 bb = *(LAS bf16x8*)(RG + (16 * jt + fr) * LDT + n0); ga[jt] = __builtin_amdgcn_mfma_f32_16x16x32_bf16(a, bb, ga[jt], 0, 0, 0); } }
        __syncthreads();
#pragma unroll
        for (int jt = 0; jt < 8; ++jt) if (jt <= wid) {
#pragma unroll
            for (int r = 0; r < 4; ++r) RG[(16 * wid + 4 * fq + r) * LDT + 16 * jt + fr] = f2bf(ga[jt][r]); }
    }
    u32x2 hvp[2][4][4];
    const int hl = wid >> 1, rh = wid & 1;
    int irow[4];
#pragma unroll
    for (int nt = 0; nt < 4; ++nt) irow[nt] = 64 * rh + 16 * nt + fr;
    int prow[4];
#pragma unroll
    for (int mt = 0; mt < 4; ++mt) prow[mt] = 32 * (mt >> 1) + 8 * (fr >> 2) + 4 * (mt & 1) + (fr & 3);
#pragma unroll
    for (int pass = 0; pass < 2; ++pass) {
        asm volatile("s_waitcnt vmcnt(0)" ::: "memory");
        __syncthreads();
        const int hh = pass * 4 + hl, h = g * 8 + hh;
        const float Dh = d_skip[h];
        float ai[4];
#pragma unroll
        for (int nt = 0; nt < 4; ++nt) ai[nt] = acum[hh * 128 + irow[nt]];
        f32x4 hv[4][4];
#pragma unroll
        for (int m = 0; m < 4; ++m)
#pragma unroll
            for (int n = 0; n < 4; ++n) hv[m][n] = (f32x4){0.f, 0.f, 0.f, 0.f};
#pragma unroll
        for (int ks = 0; ks < 4; ++ks) {
            if (ks < 2 + 2 * rh) {
                const int j = 32 * ks + 8 * fq;
                const f32x4 aj0 = *(LAS f32x4*)(acum + hh * 128 + j), aj1 = *(LAS f32x4*)(acum + hh * 128 + j + 4);
                const f32x4 dj0 = *(LAS f32x4*)(dtv + hh * 128 + j), dj1 = *(LAS f32x4*)(dtv + hh * 128 + j + 4);
                bf16x8 sf[4];
#pragma unroll
                for (int nt = 0; nt < 4; ++nt) {
                    if (32 * ks <= 64 * rh + 16 * nt + 15) {
                        const u32x4 raw = *(LAS u32x4*)(RG + irow[nt] * LDT + j);
                        float v[8];
                        v[0] = __uint_as_float(raw.x << 16); v[1] = __uint_as_float(raw.x & 0xffff0000u); v[2] = __uint_as_float(raw.y << 16); v[3] = __uint_as_float(raw.y & 0xffff0000u);
                        v[4] = __uint_as_float(raw.z << 16); v[5] = __uint_as_float(raw.z & 0xffff0000u); v[6] = __uint_as_float(raw.w << 16); v[7] = __uint_as_float(raw.w & 0xffff0000u);
                        int dd = irow[nt] - j; asm volatile("" : "+v"(dd));
#pragma unroll
                        for (int e = 0; e < 8; ++e) { const float aj = e < 4 ? aj0[e & 3] : aj1[e & 3], dj = e < 4 ? dj0[e & 3] : dj1[e & 3];
                            v[e] = (e <= dd) ? v[e] * __expf(ai[nt] - aj) * dj : 0.f; }
                        if (ks == 2 * rh + (nt >> 1)) {
#pragma unroll
                            for (int e = 0; e < 8; ++e) v[e] += (e == dd) ? Dh : 0.f; }
                        u32x4 o; o.x = pk_bf16(v[0], v[1]); o.y = pk_bf16(v[2], v[3]); o.z = pk_bf16(v[4], v[5]); o.w = pk_bf16(v[6], v[7]);
                        sf[nt] = __builtin_bit_cast(bf16x8, o);
                    }
                }
#pragma unroll
                for (int mt = 0; mt < 4; ++mt) { const bf16x8 a = *(LAS bf16x8*)(RX + (hl * 64 + prow[mt]) * LDT + j);
#pragma unroll
                    for (int nt = 0; nt < 4; ++nt) if (32 * ks <= 64 * rh + 16 * nt + 15) hv[mt][nt] = __builtin_amdgcn_mfma_f32_16x16x32_bf16(a, sf[nt], hv[mt][nt], 0, 0, 0); }
            }
        }
        if (c > 0) {
            const bf16* sp = s_in + ((size_t)((b * 16 + c) * 16 + h) * HDIM) * NSTATE;
            float ei[4];
#pragma unroll
            for (int nt = 0; nt < 4; ++nt) ei[nt] = __expf(ai[nt]);
#pragma unroll
            for (int ks = 0; ks < 4; ++ks) { const int n0 = 32 * ks + 8 * fq;
                bf16x8 cf[4];
#pragma unroll
                for (int nt = 0; nt < 4; ++nt) { const u32x4 raw = *(LAS u32x4*)(RC + irow[nt] * LDT + n0); const float e = ei[nt];
                    u32x4 o;
                    o.x = pk_bf16(__uint_as_float(raw.x << 16) * e, __uint_as_float(raw.x & 0xffff0000u) * e); o.y = pk_bf16(__uint_as_float(raw.y << 16) * e, __uint_as_float(raw.y & 0xffff0000u) * e);
                    o.z = pk_bf16(__uint_as_float(raw.z << 16) * e, __uint_as_float(raw.z & 0xffff0000u) * e); o.w = pk_bf16(__uint_as_float(raw.w << 16) * e, __uint_as_float(raw.w & 0xffff0000u) * e);
                    cf[nt] = __builtin_bit_cast(bf16x8, o); }
#pragma unroll
                for (int mt = 0; mt < 4; ++mt) { const bf16x8 a = *(const bf16x8*)(sp + (size_t)prow[mt] * NSTATE + n0);
#pragma unroll
                    for (int nt = 0; nt < 4; ++nt) hv[mt][nt] = __builtin_amdgcn_mfma_f32_16x16x32_bf16(a, cf[nt], hv[mt][nt], 0, 0, 0); }
            }
        }
        u32x4 zr[2][4];
#pragma unroll
        for (int q = 0; q < 2; ++q)
#pragma unroll
            for (int nt = 0; nt < 4; ++nt) zr[q][nt] = *(const u32x4*)(proj + (size_t)(R0 + irow[nt]) * NPROJ + PZ + h * HDIM + 32 * q + 8 * fq);
        if (pass == 0) { __syncthreads(); PC_XLOAD(1); }
        float sq[4] = {0.f, 0.f, 0.f, 0.f};
#pragma unroll
        for (int q = 0; q < 2; ++q)
#pragma unroll
            for (int nt = 0; nt < 4; ++nt) {
#pragma unroll
                for (int hf = 0; hf < 2; ++hf) { const int mt = 2 * q + hf; const unsigned z01 = hf ? zr[q][nt].z : zr[q][nt].x, z23 = hf ? zr[q][nt].w : zr[q][nt].y;
                    const float z[4] = {__uint_as_float(z01 << 16), __uint_as_float(z01 & 0xffff0000u), __uint_as_float(z23 << 16), __uint_as_float(z23 & 0xffff0000u)};
                    float hq[4];
#pragma unroll
                    for (int r = 0; r < 4; ++r) { hq[r] = hv[mt][nt][r] * fast_silu(z[r]); sq[nt] += hq[r] * hq[r]; }
                    hvp[pass][mt][nt].x = pk_bf16(hq[0], hq[1]); hvp[pass][mt][nt].y = pk_bf16(hq[2], hq[3]); }
            }
#pragma unroll
        for (int nt = 0; nt < 4; ++nt) { float s = sq[nt]; s += __shfl_xor(s, 16); s += __shfl_xor(s, 32); if (fq == 0) sqb[irow[nt] * 8 + hh] = s; }
    }
    __syncthreads();
#pragma unroll
    for (int nt = 0; nt < 4; ++nt) {
        const f32x4 s0 = *(LAS f32x4*)(sqb + irow[nt] * 8), s1 = *(LAS f32x4*)(sqb + irow[nt] * 8 + 4);
        const float rs = 1.f / sqrtf(((s0[0] + s0[1]) + (s0[2] + s0[3]) + (s1[0] + s1[1]) + (s1[2] + s1[3])) * (1.f / 512.f) + LN_EPS);
#pragma unroll
        for (int pass = 0; pass < 2; ++pass)
#pragma unroll
            for (int q = 0; q < 2; ++q) { const int ch = (g * 8 + pass * 4 + hl) * HDIM + 32 * q + 8 * fq;
                const f32x4 g0 = *(const f32x4*)(gw + ch), g1 = *(const f32x4*)(gw + ch + 4); const u32x2 ha = hvp[pass][2 * q][nt], hb = hvp[pass][2 * q + 1][nt];
                u32x4 o;
                o.x = pk_bf16(__uint_as_float(ha.x << 16) * rs * g0[0], __uint_as_float(ha.x & 0xffff0000u) * rs * g0[1]); o.y = pk_bf16(__uint_as_float(ha.y << 16) * rs * g0[2], __uint_as_float(ha.y & 0xffff0000u) * rs * g0[3]);
                o.z = pk_bf16(__uint_as_float(hb.x << 16) * rs * g1[0], __uint_as_float(hb.x & 0xffff0000u) * rs * g1[1]); o.w = pk_bf16(__uint_as_float(hb.y << 16) * rs * g1[2], __uint_as_float(hb.y & 0xffff0000u) * rs * g1[3]);
                *(u32x4*)(A2 + (size_t)(R0 + irow[nt]) * DM + ch) = o; }
    }
}

__device__ __forceinline__ void conv_nat64(LAS bf16* dst, int chan0, int R0, int tok0, bool first, const bf16* __restrict__ proj, const float* __restrict__ conv_w, const float* __restrict__ conv_b, int tsk) {
    const int cg = tsk & 15, tb = tsk >> 4, ch = chan0 + 8 * cg, j0 = tok0 + 4 * tb;
    const bf16* src = proj + (size_t)R0 * NPROJ + PX + ch;
    u32x4 row[7];
#pragma unroll
    for (int i = 0; i < 7; ++i) { const int jj = j0 - 3 + i; row[i] = (jj >= 0 || !first) ? *(const u32x4*)(src + (ptrdiff_t)jj * NPROJ) : (u32x4){0u, 0u, 0u, 0u}; }
    float w[4][8], bias[8];
#pragma unroll
    for (int k = 0; k < 4; ++k) { const f32x4 a = *(const f32x4*)(conv_w + k * CONVD + ch), b = *(const f32x4*)(conv_w + k * CONVD + ch + 4);
        w[k][0] = a[0]; w[k][1] = a[1]; w[k][2] = a[2]; w[k][3] = a[3]; w[k][4] = b[0]; w[k][5] = b[1]; w[k][6] = b[2]; w[k][7] = b[3]; }
    { const f32x4 a = *(const f32x4*)(conv_b + ch), b = *(const f32x4*)(conv_b + ch + 4); bias[0] = a[0]; bias[1] = a[1]; bias[2] = a[2]; bias[3] = a[3]; bias[4] = b[0]; bias[5] = b[1]; bias[6] = b[2]; bias[7] = b[3]; }
#pragma unroll
    for (int q = 0; q < 2; ++q) {
        float a0[8], a1[8];
#pragma unroll
        for (int e = 0; e < 8; ++e) { a0[e] = bias[e]; a1[e] = bias[e]; }
#pragma unroll
        for (int k = 0; k < 4; ++k) { const u32x4 v0 = row[2 * q + k], v1 = row[2 * q + 1 + k];
#pragma unroll
            for (int e = 0; e < 4; ++e) { a0[2 * e] += w[k][2 * e] * __uint_as_float(v0[e] << 16); a0[2 * e + 1] += w[k][2 * e + 1] * __uint_as_float(v0[e] & 0xffff0000u);
                                          a1[2 * e] += w[k][2 * e] * __uint_as_float(v1[e] << 16); a1[2 * e + 1] += w[k][2 * e + 1] * __uint_as_float(v1[e] & 0xffff0000u); } }
#pragma unroll
        for (int e = 0; e < 8; ++e) { a0[e] = fast_silu(a0[e]); a1[e] = fast_silu(a1[e]); }
        u32x4 o; o.x = pk_bf16(a0[0], a0[1]); o.y = pk_bf16(a0[2], a0[3]); o.z = pk_bf16(a0[4], a0[5]); o.w = pk_bf16(a0[6], a0[7]);
        *(LAS u32x4*)(dst + (4 * tb + 2 * q) * LDT + 8 * cg) = o;
        o.x = pk_bf16(a1[0], a1[1]); o.y = pk_bf16(a1[2], a1[3]); o.z = pk_bf16(a1[4], a1[5]); o.w = pk_bf16(a1[6], a1[7]);
        *(LAS u32x4*)(dst + (4 * tb + 2 * q + 1) * LDT + 8 * cg) = o;
    }
}

__device__ __forceinline__ void ssd_phaseC_half(LAS unsigned char* lds, int item, const bf16* __restrict__ proj, const float* __restrict__ dt, const float* __restrict__ conv_w, const float* __restrict__ conv_b,
                                                const float* __restrict__ a_log, const float* __restrict__ d_skip, const float* __restrict__ gw, const bf16* __restrict__ s_in, const bf16* __restrict__ xs, bf16* __restrict__ A2) {
    int tid = threadIdx.x; asm volatile("" : "+v"(tid)); const int wid = __builtin_amdgcn_readfirstlane(tid >> 6), lane = tid & 63, fr = lane & 15, fq = lane >> 4;
    const int rh = item & 1, g = (item >> 1) & 1, c = (item >> 2) & 15, b = item >> 6, R0 = b * SEQ + c * 128;
    LAS bf16* RC = (LAS bf16*)(lds + PC_RC); LAS bf16* RG = (LAS bf16*)(lds + PC_RG); LAS bf16* RX = (LAS bf16*)(lds + PC_RX);
    LAS float* dtv = (LAS float*)(lds + PC_SCAL); LAS float* acum = dtv + 8 * 128; LAS float* sqb = (LAS float*)(lds + PC_SQ);
    __syncthreads();
    const char* xsrc = (const char*)(xs + (size_t)((item >> 1) * 2) * (SSD_XT / 2)) + lane * 16;
    PC_XLOAD(0);
    (void)ssd_scalars(dtv, acum, R0, g * 8 + wid, wid, lane, dt, a_log);
    {
        const int half = __builtin_amdgcn_readfirstlane(tid >> 8);
#pragma unroll 1
        for (int rd = 0; rd <= rh; ++rd) {
            if (rd == 0 || half == 0) {
                const bool isC = (rd == 0 && half == 0);
                const int tok0 = (rd == 0) ? 64 * rh : 0;
                conv_nat64(isC ? RC : RG + tok0 * LDT, isC ? SSDW + NGRP * NSTATE + g * NSTATE : SSDW + g * NSTATE, R0, tok0, c == 0, proj, conv_w, conv_b, tid & 255);
            }
        }
    }
    __syncthreads();
    {
        const int it = wid & 3, jh = wid >> 2, gi = 4 * rh + it;
        f32x4 ga[4];
#pragma unroll
        for (int jj = 0; jj < 4; ++jj) ga[jj] = (f32x4){0.f, 0.f, 0.f, 0.f};
#pragma unroll
        for (int ks = 0; ks < 4; ++ks) { const int n0 = 32 * ks + 8 * fq;
            const bf16x8 a = *(LAS bf16x8*)(RC + (16 * it + fr) * LDT + n0);
#pragma unroll
            for (int jj = 0; jj < 4; ++jj) if (4 * jh + jj <= gi) { const bf16x8 bb = *(LAS bf16x8*)(RG + (16 * (4 * jh + jj) + fr) * LDT + n0); ga[jj] = __builtin_amdgcn_mfma_f32_16x16x32_bf16(a, bb, ga[jj], 0, 0, 0); } }
        __syncthreads();
#pragma unroll
        for (int jj = 0; jj < 4; ++jj) if (4 * jh + jj <= gi) {
#pragma unroll
            for (int r = 0; r < 4; ++r) RG[(16 * it + 4 * fq + r) * LDT + 16 * (4 * jh + jj) + fr] = f2bf(ga[jj][r]); }
    }
    u32x2 hvp[2][4][2];
    const int hl = wid >> 1, nh = wid & 1, ksmax = 2 * rh + nh;
    int il[2];
#pragma unroll
    for (int n = 0; n < 2; ++n) il[n] = 32 * nh + 16 * n + fr;
    int prow[4];
#pragma unroll
    for (int mt = 0; mt < 4; ++mt) prow[mt] = 32 * (mt >> 1) + 8 * (fr >> 2) + 4 * (mt & 1) + (fr & 3);
#pragma unroll
    for (int pass = 0; pass < 2; ++pass) {
        asm volatile("s_waitcnt vmcnt(0)" ::: "memory");
        __syncthreads();
        const int hh = pass * 4 + hl, h = g * 8 + hh;
        const float Dh = d_skip[h];
        u32x4 zr[2][2];
#pragma unroll
        for (int q = 0; q < 2; ++q)
#pragma unroll
            for (int n = 0; n < 2; ++n) zr[q][n] = *(const u32x4*)(proj + (size_t)(R0 + 64 * rh + il[n]) * NPROJ + PZ + h * HDIM + 32 * q + 8 * fq);
        bf16x8 sa[4][4];
        if (c > 0) { const bf16* sp = s_in + ((size_t)((b * 16 + c) * 16 + h) * HDIM) * NSTATE;
#pragma unroll
            for (int ks = 0; ks < 4; ++ks)
#pragma unroll
                for (int mt = 0; mt < 4; ++mt) sa[ks][mt] = *(const bf16x8*)(sp + (size_t)prow[mt] * NSTATE + 32 * ks + 8 * fq); }
        float ai[2];
#pragma unroll
        for (int n = 0; n < 2; ++n) ai[n] = acum[hh * 128 + 64 * rh + il[n]];
        f32x4 hv[4][2];
#pragma unroll
        for (int m = 0; m < 4; ++m)
#pragma unroll
            for (int n = 0; n < 2; ++n) hv[m][n] = (f32x4){0.f, 0.f, 0.f, 0.f};
#pragma unroll
        for (int ks = 0; ks < 4; ++ks) {
            if (ks <= ksmax) {
                const int j = 32 * ks + 8 * fq;
                const f32x4 aj0 = *(LAS f32x4*)(acum + hh * 128 + j), aj1 = *(LAS f32x4*)(acum + hh * 128 + j + 4);
                const f32x4 dj0 = *(LAS f32x4*)(dtv + hh * 128 + j), dj1 = *(LAS f32x4*)(dtv + hh * 128 + j + 4);
                bf16x8 sf[2];
#pragma unroll
                for (int n = 0; n < 2; ++n) {
                    const u32x4 raw = *(LAS u32x4*)(RG + il[n] * LDT + j);
                    float v[8];
                    v[0] = __uint_as_float(raw.x << 16); v[1] = __uint_as_float(raw.x & 0xffff0000u); v[2] = __uint_as_float(raw.y << 16); v[3] = __uint_as_float(raw.y & 0xffff0000u);
                    v[4] = __uint_as_float(raw.z << 16); v[5] = __uint_as_float(raw.z & 0xffff0000u); v[6] = __uint_as_float(raw.w << 16); v[7] = __uint_as_float(raw.w & 0xffff0000u);
                    int dd = 64 * rh + il[n] - j; asm volatile("" : "+v"(dd));
#pragma unroll
                    for (int e = 0; e < 8; ++e) { const float aj = e < 4 ? aj0[e & 3] : aj1[e & 3], dj = e < 4 ? dj0[e & 3] : dj1[e & 3];
                        v[e] = (e <= dd) ? v[e] * __expf(ai[n] - aj) * dj : 0.f; }
                    if (ks == ksmax) {
#pragma unroll
                        for (int e = 0; e < 8; ++e) v[e] += (e == dd) ? Dh : 0.f; }
                    u32x4 o; o.x = pk_bf16(v[0], v[1]); o.y = pk_bf16(v[2], v[3]); o.z = pk_bf16(v[4], v[5]); o.w = pk_bf16(v[6], v[7]);
                    sf[n] = __builtin_bit_cast(bf16x8, o);
                }
#pragma unroll
                for (int mt = 0; mt < 4; ++mt) { const bf16x8 a = *(LAS bf16x8*)(RX + (hl * 64 + prow[mt]) * LDT + j);
#pragma unroll
                    for (int n = 0; n < 2; ++n) hv[mt][n] = __builtin_amdgcn_mfma_f32_16x16x32_bf16(a, sf[n], hv[mt][n], 0, 0, 0); }
            }
        }
        if (c > 0) {
            float ei[2];
#pragma unroll
            for (int n = 0; n < 2; ++n) ei[n] = __expf(ai[n]);
#pragma unroll
            for (int ks = 0; ks < 4; ++ks) { const int n0 = 32 * ks + 8 * fq;
                bf16x8 cf[2];
#pragma unroll
                for (int n = 0; n < 2; ++n) { const u32x4 raw = *(LAS u32x4*)(RC + il[n] * LDT + n0); const float e = ei[n];
                    u32x4 o;
                    o.x = pk_bf16(__uint_as_float(raw.x << 16) * e, __uint_as_float(raw.x & 0xffff0000u) * e); o.y = pk_bf16(__uint_as_float(raw.y << 16) * e, __uint_as_float(raw.y & 0xffff0000u) * e);
                    o.z = pk_bf16(__uint_as_float(raw.z << 16) * e, __uint_as_float(raw.z & 0xffff0000u) * e); o.w = pk_bf16(__uint_as_float(raw.w << 16) * e, __uint_as_float(raw.w & 0xffff0000u) * e);
                    cf[n] = __builtin_bit_cast(bf16x8, o); }
#pragma unroll
                for (int mt = 0; mt < 4; ++mt) {
#pragma unroll
                    for (int n = 0; n < 2; ++n) hv[mt][n] = __builtin_amdgcn_mfma_f32_16x16x32_bf16(sa[ks][mt], cf[n], hv[mt][n], 0, 0, 0); }
            }
        }
        if (pass == 0) { __syncthreads(); PC_XLOAD(1); }
        float sq[2] = {0.f, 0.f};
#pragma unroll
        for (int q = 0; q < 2; ++q)
#pragma unroll
            for (int n = 0; n < 2; ++n) {
#pragma unroll
                for (int hf = 0; hf < 2; ++hf) { const int mt = 2 * q + hf; const unsigned z01 = hf ? zr[q][n].z : zr[q][n].x, z23 = hf ? zr[q][n].w : zr[q][n].y;
                    const float z[4] = {__uint_as_float(z01 << 16), __uint_as_float(z01 & 0xffff0000u), __uint_as_float(z23 << 16), __uint_as_float(z23 & 0xffff0000u)};
                    float hq[4];
#pragma unroll
                    for (int r = 0; r < 4; ++r) { hq[r] = hv[mt][n][r] * fast_silu(z[r]); sq[n] += hq[r] * hq[r]; }
                    hvp[pass][mt][n].x = pk_bf16(hq[0], hq[1]); hvp[pass][mt][n].y = pk_bf16(hq[2], hq[3]); }
            }
#pragma unroll
        for (int n = 0; n < 2; ++n) { float s = sq[n]; s += __shfl_xor(s, 16); s += __shfl_xor(s, 32); if (fq == 0) sqb[il[n] * 8 + hh] = s; }
    }
    __syncthreads();
#pragma unroll
    for (int n = 0; n < 2; ++n) {
        const f32x4 s0 = *(LAS f32x4*)(sqb + il[n] * 8), s1 = *(LAS f32x4*)(sqb + il[n] * 8 + 4);
        const float rs = 1.f / sqrtf(((s0[0] + s0[1]) + (s0[2] + s0[3]) + (s1[0] + s1[1]) + (s1[2] + s1[3])) * (1.f / 512.f) + LN_EPS);
#pragma unroll
        for (int pass = 0; pass < 2; ++pass)
#pragma unroll
            for (int q = 0; q < 2; ++q) { const int ch = (g * 8 + pass * 4 + hl) * HDIM + 32 * q + 8 * fq;
                const f32x4 g0 = *(const f32x4*)(gw + ch), g1 = *(const f32x4*)(gw + ch + 4); const u32x2 ha = hvp[pass][2 * q][n], hb = hvp[pass][2 * q + 1][n];
                u32x4 o;
                o.x = pk_bf16(__uint_as_float(ha.x << 16) * rs * g0[0], __uint_as_float(ha.x & 0xffff0000u) * rs * g0[1]); o.y = pk_bf16(__uint_as_float(ha.y << 16) * rs * g0[2], __uint_as_float(ha.y & 0xffff0000u) * rs * g0[3]);
                o.z = pk_bf16(__uint_as_float(hb.x << 16) * rs * g1[0], __uint_as_float(hb.x & 0xffff0000u) * rs * g1[1]); o.w = pk_bf16(__uint_as_float(hb.y << 16) * rs * g1[2], __uint_as_float(hb.y & 0xffff0000u) * rs * g1[3]);
                *(u32x4*)(A2 + (size_t)(R0 + 64 * rh + il[n]) * DM + ch) = o; }
    }
}


__device__ __forceinline__ void ld_row8(const float* __restrict__ p, int lane, f32x4 (&v)[8]) {
#pragma unroll
    for (int k = 0; k < 8; ++k) v[k] = __builtin_nontemporal_load((const f32x4*)(p + 4 * lane + 256 * k));
}
__device__ __forceinline__ void row_stats8(const f32x4 (&v)[8], float& mean, float& rstd) {
    float s = 0.f;
#pragma unroll
    for (int k = 0; k < 8; ++k) s += (v[k][0] + v[k][1]) + (v[k][2] + v[k][3]);
    mean = wave_sum(s) * (1.f / DM);
    float q = 0.f;
#pragma unroll
    for (int k = 0; k < 8; ++k) { const f32x4 d = v[k] - mean; q += (d[0] * d[0] + d[1] * d[1]) + (d[2] * d[2] + d[3] * d[3]); }
    rstd = 1.f / sqrtf(wave_sum(q) * (1.f / DM) + LN_EPS);
}
__device__ __forceinline__ void w_ln_h1_row(int r, int lane, const float* __restrict__ x_prompt, const float* __restrict__ x_sample, const float* __restrict__ g, const float* __restrict__ b,
                                            const float* __restrict__ mod, float* __restrict__ stats, bf16* __restrict__ h1, bf16* __restrict__ xna) {
    const float* xr = r < MP ? x_prompt + (size_t)r * DM : x_sample + (size_t)(r - MP) * DM;
    f32x4 v[8]; ld_row8(xr, lane, v);
    float mean, rstd; row_stats8(v, mean, rstd);
    if (lane == 0) { stats[2 * r] = mean; stats[2 * r + 1] = rstd; }
    const float* mr = mod + (size_t)modrow(r) * NMOD;
#pragma unroll
    for (int k = 0; k < 8; ++k) { const int c = 4 * lane + 256 * k;
        const f32x4 gg = *(const f32x4*)(g + c), bb = *(const f32x4*)(b + c), sc = *(const f32x4*)(mr + DM + c), sh = *(const f32x4*)(mr + c);
        const f32x4 xn = (v[k] - mean) * rstd * gg + bb; const f32x4 o = xn * (sc + 1.f) + sh;
        u32x2 w; w.x = pk_bf16(o[0], o[1]); w.y = pk_bf16(o[2], o[3]); *(u32x2*)(h1 + (size_t)r * DM + c) = w;
        if (xna) { const f32x4 xa = xn * ALPHA; u32x2 w2; w2.x = pk_bf16(xa[0], xa[1]); w2.y = pk_bf16(xa[2], xa[3]); *(u32x2*)(xna + (size_t)r * DM + c) = w2; } }
}
__device__ __forceinline__ void w_ln_mix_row(int r, int lane, const float* __restrict__ x_prompt, const float* __restrict__ x_sample, const float* __restrict__ stats, const float* __restrict__ lg, const float* __restrict__ lb,
                                             const float* __restrict__ mod, const float* __restrict__ mix, const float* __restrict__ slab, const float* __restrict__ g2, const float* __restrict__ b2, float* __restrict__ x1, bf16* __restrict__ h2) {
    const float* xr = r < MP ? x_prompt + (size_t)r * DM : x_sample + (size_t)(r - MP) * DM;
    const float mean0 = stats[2 * r], rstd0 = stats[2 * r + 1];
    const float* mr = mod + (size_t)modrow(r) * NMOD;
    f32x4 v[8];
#pragma unroll
    for (int k = 0; k < 8; ++k) { const int c = 4 * lane + 256 * k;
        const f32x4 xv = *(const f32x4*)(xr + c), gg = *(const f32x4*)(lg + c), bb = *(const f32x4*)(lb + c), gm = *(const f32x4*)(mr + 2 * DM + c); f32x4 mx;
        if (slab && r >= MP) { mx = *(const f32x4*)(slab + (size_t)(r - MP) * DM + c);
#pragma unroll
            for (int s = 1; s < 8; ++s) mx += *(const f32x4*)(slab + (size_t)s * (MS * DM) + (size_t)(r - MP) * DM + c); }
        else mx = *(const f32x4*)(mix + (size_t)r * DM + c);
        const f32x4 xn = (xv - mean0) * rstd0 * gg + bb; v[k] = xn * ALPHA + (gm + 1.f) * mx; }
    float mean, rstd; row_stats8(v, mean, rstd);
#pragma unroll
    for (int k = 0; k < 8; ++k) { const int c = 4 * lane + 256 * k;
        const f32x4 gg = *(const f32x4*)(g2 + c), bb = *(const f32x4*)(b2 + c), sc = *(const f32x4*)(mr + 4 * DM + c), sh = *(const f32x4*)(mr + 3 * DM + c);
        const f32x4 o = (v[k] - mean) * rstd * gg + bb; *(f32x4*)(x1 + (size_t)r * DM + c) = o;
        const f32x4 hh = o * (sc + 1.f) + sh; u32x2 w; w.x = pk_bf16(hh[0], hh[1]); w.y = pk_bf16(hh[2], hh[3]); *(u32x2*)(h2 + (size_t)r * DM + c) = w; }
}
__device__ __forceinline__ void w_ln_out_row(int r, int lane, const float* __restrict__ mod, const float* __restrict__ f, const float* __restrict__ slab, const float* __restrict__ g3, const float* __restrict__ b3, float* __restrict__ xy) {
    const float* mr = mod + (size_t)modrow(r) * NMOD;
    f32x4 v[8];
#pragma unroll
    for (int k = 0; k < 8; ++k) { const int c = 4 * lane + 256 * k;
        const f32x4 xv = *(const f32x4*)(xy + (size_t)r * DM + c), gf = *(const f32x4*)(mr + 5 * DM + c); f32x4 fv;
        if (slab && r >= MP) { fv = *(const f32x4*)(slab + (size_t)(r - MP) * DM + c);
#pragma unroll
            for (int s = 1; s < 8; ++s) fv += *(const f32x4*)(slab + (size_t)s * (MS * DM) + (size_t)(r - MP) * DM + c); }
        else fv = *(const f32x4*)(f + (size_t)r * DM + c);
        v[k] = xv * ALPHA + (gf + 1.f) * fv; }
    float mean, rstd; row_stats8(v, mean, rstd);
#pragma unroll
    for (int k = 0; k < 8; ++k) { const int c = 4 * lane + 256 * k;
        const f32x4 gg = *(const f32x4*)(g3 + c), bb = *(const f32x4*)(b3 + c);
        *(f32x4*)(xy + (size_t)r * DM + c) = (v[k] - mean) * rstd * gg + bb; }
}
__device__ __forceinline__ float fast_gelu(float x) { const float u = 0.7978845608028654f * (x + 0.044715f * x * x * x); const float e = __expf(2.f * u); return x - x * __builtin_amdgcn_rcpf(e + 1.f); }
__device__ __forceinline__ void w_vn_row(int r, int lane, const bf16* __restrict__ proj, const float* __restrict__ g, const float* __restrict__ b, float* __restrict__ vn, float* __restrict__ out) {
    float v[16];
#pragma unroll
    for (int k = 0; k < 2; ++k) { const u32x4 raw = *(const u32x4*)(proj + (size_t)r * NPROJ + PV + 8 * lane + 512 * k);
#pragma unroll
        for (int e = 0; e < 4; ++e) { v[8 * k + 2 * e] = fast_gelu(__uint_as_float(raw[e] << 16)); v[8 * k + 2 * e + 1] = fast_gelu(__uint_as_float(raw[e] & 0xffff0000u)); } }
    float s = 0.f;
#pragma unroll
    for (int e = 0; e < 16; ++e) s += v[e];
    const float mean = wave_sum(s) * (1.f / GMW);
    float q = 0.f;
#pragma unroll
    for (int e = 0; e < 16; ++e) { const float d = v[e] - mean; q += d * d; }
    const float rstd = 1.f / sqrtf(wave_sum(q) * (1.f / GMW) + LN_EPS);
#pragma unroll
    for (int k = 0; k < 2; ++k)
#pragma unroll
        for (int hq = 0; hq < 2; ++hq) { const int c = 8 * lane + 512 * k + 4 * hq;
            const f32x4 gg = *(const f32x4*)(g + c), bb = *(const f32x4*)(b + c);
            f32x4 o;
#pragma unroll
            for (int e = 0; e < 4; ++e) o[e] = (v[8 * k + 4 * hq + e] - mean) * rstd * gg[e] + bb[e];
            *(f32x4*)(vn + (size_t)r * GMW + c) = o; if (r >= MP) *(f32x4*)(out + O_CV + (size_t)(r - MP) * GMW + c) = o; }
}

__device__ __forceinline__ void ld_row_f32x8(const float* __restrict__ p, int lane, float (&v)[4][8]) {
#pragma unroll
    for (int k = 0; k < 4; ++k) { const f32x4 a = *(const f32x4*)(p + 8 * lane + 512 * k), b = *(const f32x4*)(p + 8 * lane + 512 * k + 4);
        v[k][0] = a[0]; v[k][1] = a[1]; v[k][2] = a[2]; v[k][3] = a[3]; v[k][4] = b[0]; v[k][5] = b[1]; v[k][6] = b[2]; v[k][7] = b[3]; }
}
__device__ __forceinline__ void ld_row_bf16x8(const bf16* __restrict__ p, int lane, float (&v)[4][8]) {
#pragma unroll
    for (int k = 0; k < 4; ++k) { const u32x4 raw = __builtin_nontemporal_load((const u32x4*)(p + 8 * lane + 512 * k));
#pragma unroll
        for (int e = 0; e < 4; ++e) { v[k][2 * e] = __uint_as_float(raw[e] << 16); v[k][2 * e + 1] = __uint_as_float(raw[e] & 0xffff0000u); } }
}
__device__ __forceinline__ void row_stats48(const float (&v)[4][8], float& mean, float& rstd) {
    float s = 0.f;
#pragma unroll
    for (int k = 0; k < 4; ++k)
#pragma unroll
        for (int e = 0; e < 8; ++e) s += v[k][e];
    mean = wave_sum(s) * (1.f / DM);
    float q = 0.f;
#pragma unroll
    for (int k = 0; k < 4; ++k)
#pragma unroll
        for (int e = 0; e < 8; ++e) { const float d = v[k][e] - mean; q += d * d; }
    rstd = 1.f / sqrtf(wave_sum(q) * (1.f / DM) + LN_EPS);
}
__device__ __forceinline__ void st_row_bf16x8(bf16* __restrict__ p, int lane, int k, const float (&o)[8]) {
    u32x4 w; w.x = pk_bf16(o[0], o[1]); w.y = pk_bf16(o[2], o[3]); w.z = pk_bf16(o[4], o[5]); w.w = pk_bf16(o[6], o[7]); *(u32x4*)(p + 8 * lane + 512 * k) = w;
}
__device__ __forceinline__ void sum_slabs8(const bf16* __restrict__ slab, int rs, int lane, float (&mx)[4][8]) {
#pragma unroll
    for (int k = 0; k < 4; ++k)
#pragma unroll
        for (int e = 0; e < 8; ++e) mx[k][e] = 0.f;
#pragma unroll 1
    for (int s = 0; s < 8; s += 4) {
        u32x4 raw[4][4];
#pragma unroll
        for (int q = 0; q < 4; ++q)
#pragma unroll
            for (int k = 0; k < 4; ++k) raw[q][k] = __builtin_nontemporal_load((const u32x4*)(slab + (size_t)(s + q) * (MS * DM) + (size_t)rs * DM + 8 * lane + 512 * k));
#pragma unroll
        for (int q = 0; q < 4; ++q)
#pragma unroll
            for (int k = 0; k < 4; ++k)
#pragma unroll
                for (int e = 0; e < 4; ++e) { mx[k][2 * e] += __uint_as_float(raw[q][k][e] << 16); mx[k][2 * e + 1] += __uint_as_float(raw[q][k][e] & 0xffff0000u); } }
}
__device__ __forceinline__ void w_ln_mix3_row(int r, int lane, const float* __restrict__ x_prompt, const float* __restrict__ x_sample, const float* __restrict__ stats, const float* __restrict__ lg, const float* __restrict__ lb,
                                              const float* __restrict__ mod, const bf16* __restrict__ mixb, const bf16* __restrict__ slab, const float* __restrict__ g2, const float* __restrict__ b2,
                                              bf16* __restrict__ X1, int x1_pitch, bf16* __restrict__ h2) {
    const float* xr = r < MP ? x_prompt + (size_t)r * DM : x_sample + (size_t)(r - MP) * DM;
    const float mean0 = stats[2 * r], rstd0 = stats[2 * r + 1];
    const float* mr = mod + (size_t)modrow(r) * NMOD;
    float v[4][8], mx[4][8];
    if (slab && r >= MP) sum_slabs8(slab, r - MP, lane, mx); else ld_row_bf16x8(mixb + (size_t)r * DM, lane, mx);
    ld_row_f32x8(xr, lane, v);
#pragma unroll
    for (int k = 0; k < 4; ++k) { const int c = 8 * lane + 512 * k;
#pragma unroll
        for (int hq = 0; hq < 2; ++hq) { const f32x4 gg = *(const f32x4*)(lg + c + 4 * hq), bb = *(const f32x4*)(lb + c + 4 * hq), gm = *(const f32x4*)(mr + 2 * DM + c + 4 * hq);
#pragma unroll
            for (int e = 0; e < 4; ++e) { const float xn = (v[k][4 * hq + e] - mean0) * rstd0 * gg[e] + bb[e]; v[k][4 * hq + e] = ALPHA * xn + (1.f + gm[e]) * mx[k][4 * hq + e]; } } }
    float mean, rstd; row_stats48(v, mean, rstd);
#pragma unroll
    for (int k = 0; k < 4; ++k) { const int c = 8 * lane + 512 * k; float o[8], hh[8];
#pragma unroll
        for (int hq = 0; hq < 2; ++hq) { const f32x4 gg = *(const f32x4*)(g2 + c + 4 * hq), bb = *(const f32x4*)(b2 + c + 4 * hq), sc = *(const f32x4*)(mr + 4 * DM + c + 4 * hq), sh = *(const f32x4*)(mr + 3 * DM + c + 4 * hq);
#pragma unroll
            for (int e = 0; e < 4; ++e) { o[4 * hq + e] = (v[k][4 * hq + e] - mean) * rstd * gg[e] + bb[e]; hh[4 * hq + e] = o[4 * hq + e] * (1.f + sc[e]) + sh[e]; } }
        st_row_bf16x8(X1 + (size_t)r * x1_pitch, lane, k, o); st_row_bf16x8(h2 + (size_t)r * DM, lane, k, hh); }
}
__device__ __forceinline__ void w_ln_out3_row(int r, int lane, const float* __restrict__ mod, const bf16* X1, int x1_pitch, const bf16* __restrict__ fb, const bf16* __restrict__ slab,
                                              const float* __restrict__ g3, const float* __restrict__ b3, float* y) {
    const float* mr = mod + (size_t)modrow(r) * NMOD;
    float v[4][8], fv[4][8];
    if (slab && r >= MP) sum_slabs8(slab, r - MP, lane, fv); else ld_row_bf16x8(fb + (size_t)r * DM, lane, fv);
    ld_row_bf16x8(X1 + (size_t)r * x1_pitch, lane, v);
#pragma unroll
    for (int k = 0; k < 4; ++k) { const int c = 8 * lane + 512 * k;
#pragma unroll
        for (int hq = 0; hq < 2; ++hq) { const f32x4 gf = *(const f32x4*)(mr + 5 * DM + c + 4 * hq);
#pragma unroll
            for (int e = 0; e < 4; ++e) v[k][4 * hq + e] = ALPHA * v[k][4 * hq + e] + (1.f + gf[e]) * fv[k][4 * hq + e]; } }
    float mean, rstd; row_stats48(v, mean, rstd);
    asm volatile("" ::: "memory");
#pragma unroll
    for (int k = 0; k < 4; ++k) { const int c = 8 * lane + 512 * k;
#pragma unroll
        for (int hq = 0; hq < 2; ++hq) { const f32x4 gg = *(const f32x4*)(g3 + c + 4 * hq), bb = *(const f32x4*)(b3 + c + 4 * hq); f32x4 o;
#pragma unroll
            for (int e = 0; e < 4; ++e) o[e] = (v[k][4 * hq + e] - mean) * rstd * gg[e] + bb[e];
            *(f32x4*)(y + (size_t)r * DM + c + 4 * hq) = o; } }
}

__device__ __forceinline__ void w_ln_h1_proc(int r, int lane, const f32x4 (&v)[8], const float* __restrict__ g, const float* __restrict__ b, const float* __restrict__ mod, float* __restrict__ stats, bf16* __restrict__ h1) {
    float mean, rstd; row_stats8(v, mean, rstd);
    if (lane == 0) { stats[2 * r] = mean; stats[2 * r + 1] = rstd; }
    const float* mr = mod + (size_t)modrow(r) * NMOD;
#pragma unroll
    for (int k = 0; k < 8; ++k) { const int c = 4 * lane + 256 * k;
        const f32x4 gg = *(const f32x4*)(g + c), bb = *(const f32x4*)(b + c), sc = *(const f32x4*)(mr + DM + c), sh = *(const f32x4*)(mr + c);
        const f32x4 xn = (v[k] - mean) * rstd * gg + bb; const f32x4 o = xn * (sc + 1.f) + sh;
        u32x2 w; w.x = pk_bf16(o[0], o[1]); w.y = pk_bf16(o[2], o[3]); *(u32x2*)(h1 + (size_t)r * DM + c) = w; }
}
__device__ __forceinline__ void ld_raw_bf16x8(const bf16* __restrict__ p, int lane, u32x4 (&raw)[4]) {
#pragma unroll
    for (int k = 0; k < 4; ++k) raw[k] = *(const u32x4*)(p + 8 * lane + 512 * k);
}
__device__ __forceinline__ void ld_raw_f32x8(const float* __restrict__ p, int lane, f32x4 (&raw)[8]) {
#pragma unroll
    for (int k = 0; k < 4; ++k) { raw[2 * k] = *(const f32x4*)(p + 8 * lane + 512 * k); raw[2 * k + 1] = *(const f32x4*)(p + 8 * lane + 512 * k + 4); }
}
__device__ __forceinline__ void unpack_bf16x8(const u32x4 (&raw)[4], float (&v)[4][8]) {
#pragma unroll
    for (int k = 0; k < 4; ++k)
#pragma unroll
        for (int e = 0; e < 4; ++e) { v[k][2 * e] = __uint_as_float(raw[k][e] << 16); v[k][2 * e + 1] = __uint_as_float(raw[k][e] & 0xffff0000u); }
}
__device__ __forceinline__ void w_ln_mix3_proc(int r, int lane, const f32x4 (&xraw)[8], const u32x4 (&mraw)[4], const float* __restrict__ stats, const float* __restrict__ lg, const float* __restrict__ lb,
                                               const float* __restrict__ mod, const bf16* __restrict__ slab, const float* __restrict__ g2, const float* __restrict__ b2, bf16* __restrict__ X1, int x1_pitch, bf16* __restrict__ h2) {
    const float mean0 = stats[2 * r], rstd0 = stats[2 * r + 1];
    const float* mr = mod + (size_t)modrow(r) * NMOD;
    float v[4][8], mx[4][8];
    if (slab && r >= MP) sum_slabs8(slab, r - MP, lane, mx); else unpack_bf16x8(mraw, mx);
#pragma unroll
    for (int k = 0; k < 4; ++k) { const int c = 8 * lane + 512 * k;
#pragma unroll
        for (int hq = 0; hq < 2; ++hq) { const f32x4 gg = *(const f32x4*)(lg + c + 4 * hq), bb = *(const f32x4*)(lb + c + 4 * hq), gm = *(const f32x4*)(mr + 2 * DM + c + 4 * hq); const f32x4 xv = xraw[2 * k + hq];
#pragma unroll
            for (int e = 0; e < 4; ++e) { const float xn = (xv[e] - mean0) * rstd0 * gg[e] + bb[e]; v[k][4 * hq + e] = ALPHA * xn + (1.f + gm[e]) * mx[k][4 * hq + e]; } } }
    float mean, rstd; row_stats48(v, mean, rstd);
#pragma unroll
    for (int k = 0; k < 4; ++k) { const int c = 8 * lane + 512 * k; float o[8], hh[8];
#pragma unroll
        for (int hq = 0; hq < 2; ++hq) { const f32x4 gg = *(const f32x4*)(g2 + c + 4 * hq), bb = *(const f32x4*)(b2 + c + 4 * hq), sc = *(const f32x4*)(mr + 4 * DM + c + 4 * hq), sh = *(const f32x4*)(mr + 3 * DM + c + 4 * hq);
#pragma unroll
            for (int e = 0; e < 4; ++e) { o[4 * hq + e] = (v[k][4 * hq + e] - mean) * rstd * gg[e] + bb[e]; hh[4 * hq + e] = o[4 * hq + e] * (1.f + sc[e]) + sh[e]; } }
        st_row_bf16x8(X1 + (size_t)r * x1_pitch, lane, k, o); st_row_bf16x8(h2 + (size_t)r * DM, lane, k, hh); }
}
__device__ __forceinline__ void w_ln_out3_proc(int r, int lane, const u32x4 (&xraw)[4], const u32x4 (&fraw)[4], const float* __restrict__ mod, const bf16* __restrict__ slab,
                                               const float* __restrict__ g3, const float* __restrict__ b3, float* y) {
    const float* mr = mod + (size_t)modrow(r) * NMOD;
    float v[4][8], fv[4][8];
    if (slab && r >= MP) sum_slabs8(slab, r - MP, lane, fv); else unpack_bf16x8(fraw, fv);
    unpack_bf16x8(xraw, v);
#pragma unroll
    for (int k = 0; k < 4; ++k) { const int c = 8 * lane + 512 * k;
#pragma unroll
        for (int hq = 0; hq < 2; ++hq) { const f32x4 gf = *(const f32x4*)(mr + 5 * DM + c + 4 * hq);
#pragma unroll
            for (int e = 0; e < 4; ++e) v[k][4 * hq + e] = ALPHA * v[k][4 * hq + e] + (1.f + gf[e]) * fv[k][4 * hq + e]; } }
    float mean, rstd; row_stats48(v, mean, rstd);
#pragma unroll
    for (int k = 0; k < 4; ++k) { const int c = 8 * lane + 512 * k;
#pragma unroll
        for (int hq = 0; hq < 2; ++hq) { const f32x4 gg = *(const f32x4*)(g3 + c + 4 * hq), bb = *(const f32x4*)(b3 + c + 4 * hq); f32x4 o;
#pragma unroll
            for (int e = 0; e < 4; ++e) o[e] = (v[k][4 * hq + e] - mean) * rstd * gg[e] + bb[e];
            *(f32x4*)(y + (size_t)r * DM + c + 4 * hq) = o; } }
}

__device__ __forceinline__ void w_ln_h1_lds(int r, int lane, const float* __restrict__ xrow, LAS const float* UV, float* __restrict__ stats, bf16* __restrict__ h1) {
    f32x4 v[8]; ld_row8(xrow, lane, v);
    float mean, rstd; row_stats8(v, mean, rstd);
    if (lane == 0) { stats[2 * r] = mean; stats[2 * r + 1] = rstd; }
#pragma unroll
    for (int k = 0; k < 8; ++k) { const int c = 4 * lane + 256 * k;
        const f32x4 U = *(LAS const f32x4*)(UV + c), V = *(LAS const f32x4*)(UV + DM + c);
        const f32x4 o = (v[k] - mean) * rstd * U + V;
        u32x2 w; w.x = pk_bf16(o[0], o[1]); w.y = pk_bf16(o[2], o[3]); *(u32x2*)(h1 + (size_t)r * DM + c) = w; }
}
__device__ __forceinline__ void w_ln_mix3_lds(int r, int lane, const float* __restrict__ xrow, const bf16* __restrict__ mixrow, const float* __restrict__ stats, LAS const float* C, LAS const float* Bt,
                                              bf16* __restrict__ X1row, bf16* __restrict__ h2row) {
    const float mean0 = stats[2 * r], rstd0 = stats[2 * r + 1];
    float v[4][8], mx[4][8];
    ld_row_bf16x8(mixrow, lane, mx);
    ld_row_f32x8(xrow, lane, v);
#pragma unroll
    for (int k = 0; k < 4; ++k) { const int c = 8 * lane + 512 * k;
#pragma unroll
        for (int hq = 0; hq < 2; ++hq) { const f32x4 a1 = *(LAS const f32x4*)(C + c + 4 * hq), b1 = *(LAS const f32x4*)(C + DM + c + 4 * hq), gm = *(LAS const f32x4*)(Bt + c + 4 * hq);
#pragma unroll
            for (int e = 0; e < 4; ++e) v[k][4 * hq + e] = (v[k][4 * hq + e] - mean0) * rstd0 * a1[e] + b1[e] + gm[e] * mx[k][4 * hq + e]; } }
    float mean, rstd; row_stats48(v, mean, rstd);
#pragma unroll
    for (int k = 0; k < 4; ++k) { const int c = 8 * lane + 512 * k; float o[8], hh[8];
#pragma unroll
        for (int hq = 0; hq < 2; ++hq) { const f32x4 gg = *(LAS const f32x4*)(C + 2 * DM + c + 4 * hq), bb = *(LAS const f32x4*)(C + 3 * DM + c + 4 * hq), u2 = *(LAS const f32x4*)(Bt + DM + c + 4 * hq), v2 = *(LAS const f32x4*)(Bt + 2 * DM + c + 4 * hq);
#pragma unroll
            for (int e = 0; e < 4; ++e) { const float t = (v[k][4 * hq + e] - mean) * rstd; o[4 * hq + e] = t * gg[e] + bb[e]; hh[4 * hq + e] = t * u2[e] + v2[e]; } }
        st_row_bf16x8(X1row, lane, k, o); st_row_bf16x8(h2row, lane, k, hh); }
}
__device__ __forceinline__ void w_ln_out3_lds(int r, int lane, const bf16* X1row, const bf16* __restrict__ frow, LAS const float* C, LAS const float* GF, float* yrow, LAS float* tr) {
    float v[4][8], fv[4][8];
    ld_row_bf16x8(frow, lane, fv);
    ld_row_bf16x8(X1row, lane, v);
#pragma unroll
    for (int k = 0; k < 4; ++k) { const int c = 8 * lane + 512 * k;
#pragma unroll
        for (int hq = 0; hq < 2; ++hq) { const f32x4 gf = *(LAS const f32x4*)(GF + c + 4 * hq);
#pragma unroll
            for (int e = 0; e < 4; ++e) v[k][4 * hq + e] = ALPHA * v[k][4 * hq + e] + gf[e] * fv[k][4 * hq + e]; } }
    float mean, rstd; row_stats48(v, mean, rstd);
    asm volatile("" ::: "memory");
#pragma unroll
    for (int k = 0; k < 4; ++k) { const int c = 8 * lane + 512 * k;
        *(LAS f32x4*)(tr + c) = (f32x4){(v[k][0] - mean) * rstd, (v[k][1] - mean) * rstd, (v[k][2] - mean) * rstd, (v[k][3] - mean) * rstd};
        *(LAS f32x4*)(tr + c + 4) = (f32x4){(v[k][4] - mean) * rstd, (v[k][5] - mean) * rstd, (v[k][6] - mean) * rstd, (v[k][7] - mean) * rstd}; }
#pragma unroll
    for (int k = 0; k < 8; ++k) { const int c = 4 * lane + 256 * k;
        const f32x4 t = *(LAS const f32x4*)(tr + c), gg = *(LAS const f32x4*)(C + c), bb = *(LAS const f32x4*)(C + DM + c);
        *(f32x4*)(yrow + c) = t * gg + bb; }
}

typedef float f32x2r __attribute__((ext_vector_type(2)));
__device__ __forceinline__ void wg_row_stats(const f32x4 (&v)[8], LAS f32x2r* red, int wid, int lane, float (&mean)[8], float (&rstd)[8]) {
#pragma unroll
    for (int i = 0; i < 8; ++i) { float s = (v[i][0] + v[i][1]) + (v[i][2] + v[i][3]), q = (v[i][0] * v[i][0] + v[i][1] * v[i][1]) + (v[i][2] * v[i][2] + v[i][3] * v[i][3]);
        s = wave_sum(s); q = wave_sum(q); if (lane == 0) red[i * 8 + wid] = (f32x2r){s, q}; }
    __syncthreads();
#pragma unroll
    for (int i = 0; i < 8; ++i) { float s = 0.f, q = 0.f;
#pragma unroll
        for (int w = 0; w < 8; ++w) { const f32x2r t = red[i * 8 + w]; s += t.x; q += t.y; }
        mean[i] = s * (1.f / DM); rstd[i] = 1.f / sqrtf(fmaxf(q * (1.f / DM) - mean[i] * mean[i], 0.f) + LN_EPS); }
}
__device__ __forceinline__ void wg_ln_h1(int r0, int wid, int lane, const float* __restrict__ x, LAS const float* UV, LAS f32x2r* red, float* __restrict__ stats, bf16* __restrict__ h1) {
    const int c = 256 * wid + 4 * lane;
    const f32x4 U = *(LAS const f32x4*)(UV + c), V = *(LAS const f32x4*)(UV + DM + c);
#pragma unroll 1
    for (int grp = 0; grp < 4; ++grp) { const int rb = r0 + 8 * grp;
        f32x4 v[8];
#pragma unroll
        for (int i = 0; i < 8; ++i) v[i] = *(const f32x4*)(x + (size_t)(rb + i) * DM + c);
        float mean[8], rstd[8]; wg_row_stats(v, red + (grp & 1) * 64, wid, lane, mean, rstd);
        if (wid == 0 && lane < 8) { float m = 0.f, rs = 0.f;
#pragma unroll
            for (int i = 0; i < 8; ++i) { m = lane == i ? mean[i] : m; rs = lane == i ? rstd[i] : rs; }
            stats[2 * (rb + lane)] = m; stats[2 * (rb + lane) + 1] = rs; }
#pragma unroll
        for (int i = 0; i < 8; ++i) { const f32x4 o = (v[i] - mean[i]) * rstd[i] * U + V; u32x2 w; w.x = pk_bf16(o[0], o[1]); w.y = pk_bf16(o[2], o[3]); *(u32x2*)(h1 + (size_t)(rb + i) * DM + c) = w; } }
}
__device__ __forceinline__ void wg_ln_mix(int r0, int wid, int lane, const float* __restrict__ x, const bf16* __restrict__ mixb, const float* __restrict__ stats, LAS const float* Cc, LAS const float* Bt, LAS f32x2r* red,
                                          bf16* __restrict__ X1, int x1_pitch, bf16* __restrict__ h2) {
    const int c = 256 * wid + 4 * lane;
    const f32x4 A1 = *(LAS const f32x4*)(Cc + c), B1 = *(LAS const f32x4*)(Cc + DM + c), G2 = *(LAS const f32x4*)(Cc + 2 * DM + c), B2 = *(LAS const f32x4*)(Cc + 3 * DM + c);
    const f32x4 GM = *(LAS const f32x4*)(Bt + c), U2 = *(LAS const f32x4*)(Bt + DM + c), V2 = *(LAS const f32x4*)(Bt + 2 * DM + c);
#pragma unroll 1
    for (int grp = 0; grp < 4; ++grp) { const int rb = r0 + 8 * grp;
        f32x4 v[8]; u32x2 mr[8];
#pragma unroll
        for (int i = 0; i < 8; ++i) { v[i] = *(const f32x4*)(x + (size_t)(rb + i) * DM + c); mr[i] = *(const u32x2*)(mixb + (size_t)(rb + i) * DM + c); }
#pragma unroll
        for (int i = 0; i < 8; ++i) { const float m0 = stats[2 * (rb + i)], s0 = stats[2 * (rb + i) + 1];
            const f32x4 mx = (f32x4){__uint_as_float(mr[i].x << 16), __uint_as_float(mr[i].x & 0xffff0000u), __uint_as_float(mr[i].y << 16), __uint_as_float(mr[i].y & 0xffff0000u)};
            v[i] = (v[i] - m0) * s0 * A1 + B1 + GM * mx; }
        float mean[8], rstd[8]; wg_row_stats(v, red + (grp & 1) * 64, wid, lane, mean, rstd);
#pragma unroll
        for (int i = 0; i < 8; ++i) { const f32x4 t = (v[i] - mean[i]) * rstd[i]; const f32x4 o = t * G2 + B2, hh = t * U2 + V2;
            u32x2 w; w.x = pk_bf16(o[0], o[1]); w.y = pk_bf16(o[2], o[3]); *(u32x2*)(X1 + (size_t)(rb + i) * x1_pitch + c) = w;
            u32x2 w2; w2.x = pk_bf16(hh[0], hh[1]); w2.y = pk_bf16(hh[2], hh[3]); *(u32x2*)(h2 + (size_t)(rb + i) * DM + c) = w2; } }
}
__device__ __forceinline__ void wg_ln_out(int r0, int wid, int lane, const bf16* X1, int x1_pitch, const bf16* __restrict__ fb, LAS const float* Cc, LAS const float* GFp, LAS f32x2r* red, float* y) {
    const int c = 256 * wid + 4 * lane;
    const f32x4 G3 = *(LAS const f32x4*)(Cc + c), B3 = *(LAS const f32x4*)(Cc + DM + c), GF = *(LAS const f32x4*)(GFp + c);
#pragma unroll 1
    for (int grp = 0; grp < 4; ++grp) { const int rb = r0 + 8 * grp;
        f32x4 v[8]; u32x2 xr[8], fr[8];
#pragma unroll
        for (int i = 0; i < 8; ++i) { xr[i] = *(const u32x2*)(X1 + (size_t)(rb + i) * x1_pitch + c); fr[i] = *(const u32x2*)(fb + (size_t)(rb + i) * DM + c); }
#pragma unroll
        for (int i = 0; i < 8; ++i) { const f32x4 x1 = (f32x4){__uint_as_float(xr[i].x << 16), __uint_as_float(xr[i].x & 0xffff0000u), __uint_as_float(xr[i].y << 16), __uint_as_float(xr[i].y & 0xffff0000u)};
            const f32x4 fv = (f32x4){__uint_as_float(fr[i].x << 16), __uint_as_float(fr[i].x & 0xffff0000u), __uint_as_float(fr[i].y << 16), __uint_as_float(fr[i].y & 0xffff0000u)};
            v[i] = x1 * ALPHA + GF * fv; }
        float mean[8], rstd[8]; wg_row_stats(v, red + (grp & 1) * 64, wid, lane, mean, rstd);
#pragma unroll
        for (int i = 0; i < 8; ++i) *(f32x4*)(y + (size_t)(rb + i) * DM + c) = (v[i] - mean[i]) * rstd[i] * G3 + B3; }
}


__device__ __forceinline__ void w_vstats_row(int r, int lane, const bf16* __restrict__ proj, const float* __restrict__ g, const float* __restrict__ b, float* __restrict__ vstats, float* __restrict__ out) {
    float v[16];
#pragma unroll
    for (int k = 0; k < 2; ++k) { const u32x4 raw = *(const u32x4*)(proj + (size_t)r * NPROJ + PV + 8 * lane + 512 * k);
#pragma unroll
        for (int e = 0; e < 4; ++e) { v[8 * k + 2 * e] = fast_gelu(__uint_as_float(raw[e] << 16)); v[8 * k + 2 * e + 1] = fast_gelu(__uint_as_float(raw[e] & 0xffff0000u)); } }
    float s = 0.f;
#pragma unroll
    for (int e = 0; e < 16; ++e) s += v[e];
    const float mean = wave_sum(s) * (1.f / GMW);
    float q = 0.f;
#pragma unroll
    for (int e = 0; e < 16; ++e) { const float d = v[e] - mean; q += d * d; }
    const float rstd = 1.f / sqrtf(wave_sum(q) * (1.f / GMW) + LN_EPS);
    if (lane == 0) { vstats[2 * r] = mean; vstats[2 * r + 1] = rstd; }
    if (r >= MP) {
#pragma unroll
        for (int k = 0; k < 2; ++k)
#pragma unroll
            for (int hq = 0; hq < 2; ++hq) { const int c = 8 * lane + 512 * k + 4 * hq;
                const f32x4 gg = *(const f32x4*)(g + c), bb = *(const f32x4*)(b + c);
                f32x4 o;
#pragma unroll
                for (int e = 0; e < 4; ++e) o[e] = (v[8 * k + 4 * hq + e] - mean) * rstd * gg[e] + bb[e];
                *(f32x4*)(out + O_CV + (size_t)(r - MP) * GMW + c) = o; }
    }
}
__device__ __forceinline__ void w_gmlp_ln_row(int r, int lane, bf16* proj, const float* __restrict__ g, const float* __restrict__ b, float* __restrict__ out) {
    float v[16];
#pragma unroll
    for (int k = 0; k < 2; ++k) { const u32x4 raw = __builtin_nontemporal_load((const u32x4*)(proj + (size_t)r * NPROJ + PV + 8 * lane + 512 * k));
#pragma unroll
        for (int e = 0; e < 4; ++e) { v[8 * k + 2 * e] = fast_gelu(__uint_as_float(raw[e] << 16)); v[8 * k + 2 * e + 1] = fast_gelu(__uint_as_float(raw[e] & 0xffff0000u)); } }
    float s = 0.f;
#pragma unroll
    for (int e = 0; e < 16; ++e) s += v[e];
    const float mean = wave_sum(s) * (1.f / GMW);
    float q = 0.f;
#pragma unroll
    for (int e = 0; e < 16; ++e) { const float d = v[e] - mean; q += d * d; }
    const float rstd = 1.f / sqrtf(wave_sum(q) * (1.f / GMW) + LN_EPS);
#pragma unroll
    for (int k = 0; k < 2; ++k) { const int c = 8 * lane + 512 * k;
        const f32x4 g0 = *(const f32x4*)(g + c), g1 = *(const f32x4*)(g + c + 4), b0 = *(const f32x4*)(b + c), b1 = *(const f32x4*)(b + c + 4);
        f32x4 o0, o1;
#pragma unroll
        for (int e = 0; e < 4; ++e) { o0[e] = (v[8 * k + e] - mean) * rstd * g0[e] + b0[e]; o1[e] = (v[8 * k + 4 + e] - mean) * rstd * g1[e] + b1[e]; }
        if (r >= MP) { *(f32x4*)(out + O_CV + (size_t)(r - MP) * GMW + c) = o0; *(f32x4*)(out + O_CV + (size_t)(r - MP) * GMW + c + 4) = o1; }
        else { u32x4 w; w.x = pk_bf16(o0[0], o0[1]); w.y = pk_bf16(o0[2], o0[3]); w.z = pk_bf16(o1[0], o1[1]); w.w = pk_bf16(o1[2], o1[3]); *(u32x4*)(proj + (size_t)r * NPROJ + PV + c) = w; } }
}
__device__ __forceinline__ void gmlp_group(LAS unsigned char* lds, int hd, int bc0, int bcs, int cnt, const bf16* __restrict__ proj, const float* __restrict__ w_s, const float* __restrict__ b_s, bf16* __restrict__ A2) {
    int tid = threadIdx.x; asm volatile("" : "+v"(tid)); const int wid = __builtin_amdgcn_readfirstlane(tid >> 6), lane = tid & 63, fr = lane & 15, fq = lane >> 4;
    LAS bf16* Wl = (LAS bf16*)(lds + 2 * SSD_IMG);
    const int dq = wid & 3, ih = wid >> 2, dg = tid >> 5, tb = tid & 31;
    const bf16* vsrc = proj + (size_t)(4 * tb) * NPROJ + PV + hd * GMHD + 8 * dg;
    u32x4 raw[4];
#pragma unroll
    for (int t = 0; t < 4; ++t) raw[t] = *(const u32x4*)(vsrc + (size_t)(bc0 * 128 + t) * NPROJ);
    float bs[4];
#pragma unroll
    for (int n = 0; n < 4; ++n) bs[n] = b_s[hd * 128 + 16 * (2 * n + ih) + fr];
    __syncthreads();
    {
        const int i = tid >> 2, j0 = (tid & 3) * 32; const float* wp = w_s + ((size_t)hd * 128 + i) * 128 + j0;
#pragma unroll
        for (int q = 0; q < 4; ++q) { const f32x4 a = *(const f32x4*)(wp + 8 * q), c = *(const f32x4*)(wp + 8 * q + 4); const int j = j0 + 8 * q;
            u32x4 w; w.x = pk_bf16(j <= i ? a[0] : 0.f, j + 1 <= i ? a[1] : 0.f); w.y = pk_bf16(j + 2 <= i ? a[2] : 0.f, j + 3 <= i ? a[3] : 0.f);
            w.z = pk_bf16(j + 4 <= i ? c[0] : 0.f, j + 5 <= i ? c[1] : 0.f); w.w = pk_bf16(j + 6 <= i ? c[2] : 0.f, j + 7 <= i ? c[3] : 0.f);
            *(LAS u32x4*)(Wl + i * LDT + j) = w; }
    }
    int prow[2];
#pragma unroll
    for (int mt = 0; mt < 2; ++mt) prow[mt] = 32 * dq + 8 * (fr >> 2) + 4 * mt + (fr & 3);
    const bf16* usrc = proj + (size_t)(16 * ih + fr) * NPROJ + PU + hd * GMHD + 32 * dq + 8 * fq;
    bf16* dsto = A2 + (size_t)(16 * ih + fr) * DM + SSDW + hd * GMHD + 32 * dq + 8 * fq;
#pragma unroll 1
    for (int k = 0; k < cnt; ++k) {
        const int R0 = (bc0 + k * bcs) * 128;
        LAS bf16* vT = (LAS bf16*)(lds + (k & 1) * SSD_IMG);
#pragma unroll
        for (int e = 0; e < 4; ++e) { u32x2 w;
            w.x = __builtin_amdgcn_perm(raw[1][e], raw[0][e], 0x05040100u); w.y = __builtin_amdgcn_perm(raw[3][e], raw[2][e], 0x05040100u); *(LAS u32x2*)(vT + (8 * dg + 2 * e) * LDT + 4 * tb) = w;
            w.x = __builtin_amdgcn_perm(raw[1][e], raw[0][e], 0x07060302u); w.y = __builtin_amdgcn_perm(raw[3][e], raw[2][e], 0x07060302u); *(LAS u32x2*)(vT + (8 * dg + 2 * e + 1) * LDT + 4 * tb) = w; }
        if (k + 1 < cnt) {
#pragma unroll
            for (int t = 0; t < 4; ++t) raw[t] = *(const u32x4*)(vsrc + (size_t)(R0 + bcs * 128 + t) * NPROJ); }
        u32x4 ur[4];
#pragma unroll
        for (int n = 0; n < 4; ++n) ur[n] = *(const u32x4*)(usrc + (size_t)(R0 + 32 * n) * NPROJ);
        __syncthreads();
        f32x4 acc[2][4];
#pragma unroll
        for (int mt = 0; mt < 2; ++mt)
#pragma unroll
            for (int n = 0; n < 4; ++n) acc[mt][n] = (f32x4){0.f, 0.f, 0.f, 0.f};
#pragma unroll
        for (int ks = 0; ks < 4; ++ks) { const int j = 32 * ks + 8 * fq;
            const bf16x8 a0 = *(LAS bf16x8*)(vT + prow[0] * LDT + j), a1 = *(LAS bf16x8*)(vT + prow[1] * LDT + j);
#pragma unroll
            for (int n = 0; n < 4; ++n) if (32 * ks <= 16 * (2 * n + 1) + 15 && (32 * ks <= 16 * (2 * n) + 15 || ih == 1)) { const bf16x8 bw = *(LAS bf16x8*)(Wl + (16 * (2 * n + ih) + fr) * LDT + j);
                acc[0][n] = __builtin_amdgcn_mfma_f32_16x16x32_bf16(a0, bw, acc[0][n], 0, 0, 0); acc[1][n] = __builtin_amdgcn_mfma_f32_16x16x32_bf16(a1, bw, acc[1][n], 0, 0, 0); } }
#pragma unroll
        for (int n = 0; n < 4; ++n) {
            const float u0 = fast_gelu(__uint_as_float(ur[n].x << 16)), u1 = fast_gelu(__uint_as_float(ur[n].x & 0xffff0000u)), u2 = fast_gelu(__uint_as_float(ur[n].y << 16)), u3 = fast_gelu(__uint_as_float(ur[n].y & 0xffff0000u));
            const float u4 = fast_gelu(__uint_as_float(ur[n].z << 16)), u5 = fast_gelu(__uint_as_float(ur[n].z & 0xffff0000u)), u6 = fast_gelu(__uint_as_float(ur[n].w << 16)), u7 = fast_gelu(__uint_as_float(ur[n].w & 0xffff0000u));
            u32x4 o; o.x = pk_bf16(u0 * (acc[0][n][0] + bs[n]), u1 * (acc[0][n][1] + bs[n])); o.y = pk_bf16(u2 * (acc[0][n][2] + bs[n]), u3 * (acc[0][n][3] + bs[n]));
            o.z = pk_bf16(u4 * (acc[1][n][0] + bs[n]), u5 * (acc[1][n][1] + bs[n])); o.w = pk_bf16(u6 * (acc[1][n][2] + bs[n]), u7 * (acc[1][n][3] + bs[n]));
            *(u32x4*)(dsto + (size_t)(R0 + 32 * n) * DM) = o; }
    }
}
__device__ __forceinline__ void gmlp_sample_item(int bs, const bf16* __restrict__ proj, const float* __restrict__ vn_s, const float* __restrict__ w_s, const float* __restrict__ b_s, bf16* __restrict__ A2) {
    int tid = threadIdx.x; asm volatile("" : "+v"(tid));
    const int c0 = 2 * tid, hd = c0 >> 7, R0 = MP + bs * DSEQ;
    float v[8][2];
#pragma unroll
    for (int j = 0; j < 8; ++j) { const float2 t = *(const float2*)(vn_s + (size_t)(bs * DSEQ + j) * GMW + c0); v[j][0] = t.x; v[j][1] = t.y; }
#pragma unroll
    for (int i = 0; i < 8; ++i) { float a0 = 0.f, a1 = 0.f;
#pragma unroll
        for (int j = 0; j <= i; ++j) { const float w = w_s[((size_t)hd * 128 + i) * 128 + j]; a0 += w * v[j][0]; a1 += w * v[j][1]; }
        const float bsv = b_s[hd * 128 + i];
        const unsigned ur = *(const unsigned*)(proj + (size_t)(R0 + i) * NPROJ + PU + c0);
        const float u0 = fast_gelu(__uint_as_float(ur << 16)), u1 = fast_gelu(__uint_as_float(ur & 0xffff0000u));
        *(unsigned*)(A2 + (size_t)(R0 + i) * DM + SSDW + c0) = pk_bf16(u0 * (a0 + bsv), u1 * (a1 + bsv)); }
}


__device__ __forceinline__ void p0_transpose_item(const float* __restrict__ W, int K, int ld, int nblk, bf16* __restrict__ WT, LAS float* scr, int item, int lane) {
    const int kb = item / nblk, nb = item % nblk, k0 = 64 * kb, n0 = 32 * nb;
    float tv[32];
#pragma unroll
    for (int i = 0; i < 32; ++i) { const int kk = 2 * i + (lane >> 5); tv[i] = __builtin_nontemporal_load(W + (size_t)(k0 + kk) * ld + n0 + (lane & 31)); }
#pragma unroll
    for (int i = 0; i < 32; ++i) { const int kk = 2 * i + (lane >> 5); scr[kk * 33 + (lane & 31)] = tv[i]; }
    asm volatile("s_waitcnt lgkmcnt(0)" ::: "memory");
    const int c = lane & 7;
#pragma unroll
    for (int j = 0; j < 4; ++j) { const int n = (lane >> 3) + 8 * j; const LAS float* s = scr + (8 * c) * 33 + n;
        u32x4 o; o.x = pk_bf16(s[0 * 33], s[1 * 33]); o.y = pk_bf16(s[2 * 33], s[3 * 33]); o.z = pk_bf16(s[4 * 33], s[5 * 33]); o.w = pk_bf16(s[6 * 33], s[7 * 33]);
        *(u32x4*)(WT + (size_t)(n0 + n) * K + k0 + 8 * c) = o; }
    asm volatile("s_waitcnt lgkmcnt(0)" ::: "memory");
}
constexpr int MOD_LDW = 136, MOD_WBUF = 48 * MOD_LDW * 2;
__device__ __forceinline__ void mod_item(LAS unsigned char* lds, int item, const bf16* __restrict__ csilu, const float* __restrict__ w_mod, const float* __restrict__ b_mod, float* __restrict__ mod) {
    int tid = threadIdx.x; asm volatile("" : "+v"(tid)); const int wid = __builtin_amdgcn_readfirstlane(tid >> 6), lane = tid & 63, fr = lane & 15, fq = lane >> 4;
    const int n0 = 48 * item;
    __syncthreads();
    const bool stg = tid < 384;
    const int sn4 = tid % 12, skq = tid / 12;
    const float* wsrc = w_mod + (size_t)(4 * skq) * NMOD + n0 + 4 * sn4;
    f32x4 pre[4][4];
    if (stg) {
#pragma unroll
        for (int u = 0; u < 4; ++u)
#pragma unroll
            for (int j = 0; j < 4; ++j) pre[u][j] = __builtin_nontemporal_load((const f32x4*)(wsrc + (size_t)(128 * u + j) * NMOD)); }
    constexpr int ALD = 136, ABUF = 132 * ALD * 2;
    LAS unsigned char* abase = lds + 2 * MOD_WBUF;
    u32x4 areg[4][5];
#define MOD_ALOAD(u_, kcn) do { _Pragma("unroll") for (int i_ = 0; i_ < 5; ++i_) { const int p_ = tid + 512 * i_; if (p_ < 132 * 16) areg[u_][i_] = *(const u32x4*)(csilu + (size_t)(p_ >> 4) * DM + 128 * (kcn) + 8 * (p_ & 15)); } } while (0)
#pragma unroll
    for (int u = 0; u < 4; ++u) MOD_ALOAD(u, u);
    f32x4 acc[3], acc9[3];
#pragma unroll
    for (int nt = 0; nt < 3; ++nt) { acc[nt] = (f32x4){0.f, 0.f, 0.f, 0.f}; acc9[nt] = (f32x4){0.f, 0.f, 0.f, 0.f}; }
#pragma unroll 1
    for (int kc4 = 0; kc4 < 16; kc4 += 4) {
#pragma unroll
      for (int u = 0; u < 4; ++u) { const int kc = kc4 + u;
        LAS bf16* Wb = (LAS bf16*)(lds + (u & 1) * MOD_WBUF); LAS bf16* Ab = (LAS bf16*)(abase + (u & 1) * ABUF);
#pragma unroll
        for (int i_ = 0; i_ < 5; ++i_) { const int p_ = tid + 512 * i_; if (p_ < 132 * 16) *(LAS u32x4*)(Ab + (p_ >> 4) * ALD + 8 * (p_ & 15)) = areg[u][i_]; }
        if (kc < 12) MOD_ALOAD(u, kc + 4);
        if (stg) {
#pragma unroll
            for (int e = 0; e < 4; ++e) { u32x2 w; w.x = pk_bf16(pre[u][0][e], pre[u][1][e]); w.y = pk_bf16(pre[u][2][e], pre[u][3][e]); *(LAS u32x2*)(Wb + (4 * sn4 + e) * MOD_LDW + 4 * skq) = w; }
            if (kc < 12) {
#pragma unroll
                for (int j = 0; j < 4; ++j) pre[u][j] = __builtin_nontemporal_load((const f32x4*)(wsrc + (size_t)(128 * (kc + 4) + j) * NMOD)); }
        }
        __syncthreads();
#pragma unroll
        for (int ks = 0; ks < 4; ++ks) {
            const int kk = 32 * ks + 8 * fq;
            const bf16x8 afr = *(LAS bf16x8*)(Ab + (16 * wid + fr) * ALD + kk);
            bf16x8 bfr[3];
#pragma unroll
            for (int nt = 0; nt < 3; ++nt) bfr[nt] = *(LAS bf16x8*)(Wb + (16 * nt + fr) * MOD_LDW + kk);
#pragma unroll
            for (int nt = 0; nt < 3; ++nt) acc[nt] = __builtin_amdgcn_mfma_f32_16x16x32_bf16(afr, bfr[nt], acc[nt], 0, 0, 0);
            if (((4 * kc + ks) & 7) == wid) {
                u32x4 ep = (u32x4){0u, 0u, 0u, 0u};
                if (fr < 4) ep = *(LAS u32x4*)(Ab + (128 + fr) * ALD + kk);
                const bf16x8 ef = __builtin_bit_cast(bf16x8, ep);
#pragma unroll
                for (int nt = 0; nt < 3; ++nt) acc9[nt] = __builtin_amdgcn_mfma_f32_16x16x32_bf16(ef, bfr[nt], acc9[nt], 0, 0, 0);
            }
        }
      }
    }
#undef MOD_ALOAD
#pragma unroll
    for (int nt = 0; nt < 3; ++nt) { const int n = n0 + 16 * nt + fr; const float bb = b_mod[n];
#pragma unroll
        for (int r = 0; r < 4; ++r) mod[(size_t)(16 * wid + 4 * fq + r) * NMOD + n] = acc[nt][r] + bb; }
    __syncthreads();
    LAS float* red = (LAS float*)(lds + 2 * MOD_WBUF + 2 * ABUF);
    if (fq == 0) {
#pragma unroll
        for (int nt = 0; nt < 3; ++nt) *(LAS f32x4*)(red + ((wid * 3 + nt) * 16 + fr) * 4) = acc9[nt]; }
    __syncthreads();
    if (tid < 192) { const int nt = tid >> 6, f = (tid >> 2) & 15, r = tid & 3; float s = 0.f;
#pragma unroll
        for (int w = 0; w < 8; ++w) s += red[((w * 3 + nt) * 16 + f) * 4 + r];
        const int n = n0 + 16 * nt + f; mod[(size_t)(128 + r) * NMOD + n] = s + b_mod[n]; }
}


constexpr int SM_XS = 0, SM_BS = 16384, SM_CS = 20480, SM_G = 24576, SM_SQ = 24832, SM_END = 25088;
__device__ __forceinline__ void sample_ssd_item(LAS unsigned char* lds, int item, const bf16* __restrict__ proj, const float* __restrict__ dt, const float* __restrict__ state_conv, const float* __restrict__ conv_w,
                                                const float* __restrict__ conv_b, const float* __restrict__ a_log, const float* __restrict__ d_skip, const float* __restrict__ gw, const float* __restrict__ state_ssm,
                                                bf16* __restrict__ A2, float* __restrict__ out) {
    int tid = threadIdx.x; asm volatile("" : "+v"(tid)); const int wid = __builtin_amdgcn_readfirstlane(tid >> 6), lane = tid & 63, fr = lane & 15, fq = lane >> 4;
    const int bs = item >> 1, g = item & 1, R0 = MP + bs * DSEQ, h = g * 8 + wid;
    LAS float* xs = (LAS float*)(lds + SM_XS); LAS float* Bs = (LAS float*)(lds + SM_BS); LAS float* Cs = (LAS float*)(lds + SM_CS); LAS float* Gl = (LAS float*)(lds + SM_G); LAS float* sqb = (LAS float*)(lds + SM_SQ);
    __syncthreads();
#define SM_LOAD_XP_ROW(dstv, pos, chn) do { if ((pos) < 3) { const float* sp_ = state_conv + ((size_t)bs * 3 + (pos)) * CONVD + (chn); const f32x4 a_ = *(const f32x4*)sp_, b_ = *(const f32x4*)(sp_ + 4); \
            dstv[0] = a_[0]; dstv[1] = a_[1]; dstv[2] = a_[2]; dstv[3] = a_[3]; dstv[4] = b_[0]; dstv[5] = b_[1]; dstv[6] = b_[2]; dstv[7] = b_[3]; } \
        else { const u32x4 q_ = *(const u32x4*)(proj + (size_t)(R0 + (pos) - 3) * NPROJ + PX + (chn)); \
            _Pragma("unroll") for (int e_ = 0; e_ < 4; ++e_) { dstv[2 * e_] = __uint_as_float(q_[e_] << 16); dstv[2 * e_ + 1] = __uint_as_float(q_[e_] & 0xffff0000u); } } } while (0)
#define SM_CONV_TASK(chn, dstp) do { const int ch_ = (chn); float r_[4][8]; \
        _Pragma("unroll") for (int k = 0; k < 4; ++k) SM_LOAD_XP_ROW(r_[k], wid + k, ch_); \
        float o_[8]; { const f32x4 a_ = *(const f32x4*)(conv_b + ch_), b_ = *(const f32x4*)(conv_b + ch_ + 4); o_[0] = a_[0]; o_[1] = a_[1]; o_[2] = a_[2]; o_[3] = a_[3]; o_[4] = b_[0]; o_[5] = b_[1]; o_[6] = b_[2]; o_[7] = b_[3]; } \
        _Pragma("unroll") for (int k = 0; k < 4; ++k) { const f32x4 a_ = *(const f32x4*)(conv_w + k * CONVD + ch_), b_ = *(const f32x4*)(conv_w + k * CONVD + ch_ + 4); \
            o_[0] += a_[0] * r_[k][0]; o_[1] += a_[1] * r_[k][1]; o_[2] += a_[2] * r_[k][2]; o_[3] += a_[3] * r_[k][3]; o_[4] += b_[0] * r_[k][4]; o_[5] += b_[1] * r_[k][5]; o_[6] += b_[2] * r_[k][6]; o_[7] += b_[3] * r_[k][7]; } \
        LAS float* d_ = (dstp); *(LAS f32x4*)d_ = (f32x4){fast_silu(o_[0]), fast_silu(o_[1]), fast_silu(o_[2]), fast_silu(o_[3])}; *(LAS f32x4*)(d_ + 4) = (f32x4){fast_silu(o_[4]), fast_silu(o_[5]), fast_silu(o_[6]), fast_silu(o_[7])}; \
        if (wid >= 5) { float* c_ = out + O_CONVS + ((size_t)bs * 3 + (wid - 5)) * CONVD + ch_; *(f32x4*)c_ = (f32x4){r_[3][0], r_[3][1], r_[3][2], r_[3][3]}; *(f32x4*)(c_ + 4) = (f32x4){r_[3][4], r_[3][5], r_[3][6], r_[3][7]}; } } while (0)
    SM_CONV_TASK(g * 512 + 8 * lane, xs + wid * 512 + 8 * lane);
    { const int cg = lane & 31;
      SM_CONV_TASK(cg < 16 ? SSDW + g * NSTATE + 8 * cg : SSDW + NGRP * NSTATE + g * NSTATE + 8 * (cg - 16), (cg < 16 ? Bs + 8 * cg : Cs + 8 * (cg - 16)) + wid * 128); }
#undef SM_CONV_TASK
#undef SM_LOAD_XP_ROW
    const float* sp = state_ssm + ((size_t)(bs * NHEAD + h) * HDIM) * NSTATE;
    f32x4 S[4][4][2];
    LAS float* tw = (LAS float*)(lds + SM_END) + wid * (16 * 132);
#pragma unroll
    for (int mt = 0; mt < 4; ++mt)
#pragma unroll
        for (int i = 0; i < 8; ++i) S[mt][i >> 1][i & 1] = __builtin_nontemporal_load((const f32x4*)(sp + (size_t)(16 * mt) * NSTATE + 256 * i + 4 * lane));
#pragma unroll
    for (int mt = 0; mt < 4; ++mt) {
#pragma unroll
        for (int i = 0; i < 8; ++i) *(LAS f32x4*)(tw + (2 * i + (lane >> 5)) * 132 + 4 * (lane & 31)) = S[mt][i >> 1][i & 1];
#pragma unroll
        for (int ks = 0; ks < 4; ++ks) { S[mt][ks][0] = *(LAS f32x4*)(tw + fr * 132 + 32 * ks + 8 * fq); S[mt][ks][1] = *(LAS f32x4*)(tw + fr * 132 + 32 * ks + 8 * fq + 4); }
    }
    const float A = -__expf(a_log[h]), Dh = d_skip[h];
    float dtv[8], ac[8];
    { float run = 0.f;
#pragma unroll
      for (int t = 0; t < 8; ++t) { dtv[t] = dt[(size_t)(R0 + t) * 16 + h]; run += dtv[t] * A; ac[t] = run; } }
    __syncthreads();
    if (tid < 64) { const int t = tid >> 3, s = tid & 7; float a = 0.f;
        for (int n = 0; n < NSTATE; n += 4) { const f32x4 cv = *(LAS f32x4*)(Cs + t * 128 + n), bv = *(LAS f32x4*)(Bs + s * 128 + n); a += (cv[0] * bv[0] + cv[1] * bv[1]) + (cv[2] * bv[2] + cv[3] * bv[3]); }
        Gl[t * 8 + s] = a; }
    __syncthreads();
    f32x4 yacc[4];
#pragma unroll
    for (int mt = 0; mt < 4; ++mt) yacc[mt] = (f32x4){0.f, 0.f, 0.f, 0.f};
    float act_ = 0.f;
#pragma unroll
    for (int t = 0; t < 8; ++t) act_ = fr == t ? ac[t] : act_;
    const float et = __expf(act_);
#pragma unroll
    for (int ks = 0; ks < 4; ++ks) {
        u32x4 cp = (u32x4){0u, 0u, 0u, 0u};
        if (fr < 8) { const f32x4 c0 = *(LAS f32x4*)(Cs + fr * 128 + 32 * ks + 8 * fq), c1 = *(LAS f32x4*)(Cs + fr * 128 + 32 * ks + 8 * fq + 4);
            cp.x = pk_bf16(c0[0] * et, c0[1] * et); cp.y = pk_bf16(c0[2] * et, c0[3] * et); cp.z = pk_bf16(c1[0] * et, c1[1] * et); cp.w = pk_bf16(c1[2] * et, c1[3] * et); }
        const bf16x8 cf = __builtin_bit_cast(bf16x8, cp);
#pragma unroll
        for (int mt = 0; mt < 4; ++mt) { u32x4 sp4; sp4.x = pk_bf16(S[mt][ks][0][0], S[mt][ks][0][1]); sp4.y = pk_bf16(S[mt][ks][0][2], S[mt][ks][0][3]); sp4.z = pk_bf16(S[mt][ks][1][0], S[mt][ks][1][1]); sp4.w = pk_bf16(S[mt][ks][1][2], S[mt][ks][1][3]);
            yacc[mt] = __builtin_amdgcn_mfma_f32_16x16x32_bf16(__builtin_bit_cast(bf16x8, sp4), cf, yacc[mt], 0, 0, 0); }
    }
    {
        u32x4 gp = (u32x4){0u, 0u, 0u, 0u};
        if (fq == 0 && fr < 8) { float gd[8];
#pragma unroll
            for (int s = 0; s < 8; ++s) gd[s] = s <= fr ? Gl[fr * 8 + s] * __expf(act_ - ac[s]) * dtv[s] : 0.f;
            gp.x = pk_bf16(gd[0], gd[1]); gp.y = pk_bf16(gd[2], gd[3]); gp.z = pk_bf16(gd[4], gd[5]); gp.w = pk_bf16(gd[6], gd[7]); }
        const bf16x8 gf = __builtin_bit_cast(bf16x8, gp);
#pragma unroll
        for (int mt = 0; mt < 4; ++mt) { u32x4 xp = (u32x4){0u, 0u, 0u, 0u};
            if (fq == 0) { const LAS float* xq = xs + wid * 64 + 16 * mt + fr;
                xp.x = pk_bf16(xq[0], xq[512]); xp.y = pk_bf16(xq[1024], xq[1536]); xp.z = pk_bf16(xq[2048], xq[2560]); xp.w = pk_bf16(xq[3072], xq[3584]); }
            yacc[mt] = __builtin_amdgcn_mfma_f32_16x16x32_bf16(__builtin_bit_cast(bf16x8, xp), gf, yacc[mt], 0, 0, 0); }
    }
    { const float dc = __expf(ac[7]);
#pragma unroll
      for (int mt = 0; mt < 4; ++mt)
#pragma unroll
          for (int ks = 0; ks < 4; ++ks) { S[mt][ks][0] = S[mt][ks][0] * dc; S[mt][ks][1] = S[mt][ks][1] * dc; }
#pragma unroll
      for (int t = 0; t < 8; ++t) { const float wt = dtv[t] * __expf(ac[7] - ac[t]);
          float xw[4];
#pragma unroll
          for (int mt = 0; mt < 4; ++mt) xw[mt] = wt * xs[t * 512 + wid * 64 + 16 * mt + fr];
#pragma unroll
          for (int ks = 0; ks < 4; ++ks) { const f32x4 b0 = *(LAS f32x4*)(Bs + t * 128 + 32 * ks + 8 * fq), b1 = *(LAS f32x4*)(Bs + t * 128 + 32 * ks + 8 * fq + 4);
#pragma unroll
              for (int mt = 0; mt < 4; ++mt) { S[mt][ks][0] = S[mt][ks][0] + b0 * xw[mt]; S[mt][ks][1] = S[mt][ks][1] + b1 * xw[mt]; } } }
      float* so = out + O_SSMS + ((size_t)(bs * NHEAD + h) * HDIM) * NSTATE;
      LAS float* tw = (LAS float*)(lds + SM_END) + wid * (16 * 132);
#pragma unroll
      for (int mt = 0; mt < 4; ++mt) {
#pragma unroll
          for (int ks = 0; ks < 4; ++ks) { *(LAS f32x4*)(tw + fr * 132 + 32 * ks + 8 * fq) = S[mt][ks][0]; *(LAS f32x4*)(tw + fr * 132 + 32 * ks + 8 * fq + 4) = S[mt][ks][1]; }
#pragma unroll
          for (int i = 0; i < 8; ++i) { const f32x4 t = *(LAS f32x4*)(tw + (2 * i + (lane >> 5)) * 132 + 4 * (lane & 31)); __builtin_nontemporal_store(t, (f32x4*)(so + (size_t)(16 * mt) * NSTATE + 256 * i + 4 * lane)); }
      } }
    float hq[4][4]; float sq = 0.f;
    if (fr < 8) {
#pragma unroll
        for (int mt = 0; mt < 4; ++mt) { const int p0 = 16 * mt + 4 * fq;
            const u32x2 zr = *(const u32x2*)(proj + (size_t)(R0 + fr) * NPROJ + PZ + h * HDIM + p0);
            const float z[4] = {__uint_as_float(zr.x << 16), __uint_as_float(zr.x & 0xffff0000u), __uint_as_float(zr.y << 16), __uint_as_float(zr.y & 0xffff0000u)};
            const f32x4 xv = *(LAS f32x4*)(xs + fr * 512 + wid * 64 + p0);
#pragma unroll
            for (int r = 0; r < 4; ++r) { hq[mt][r] = (yacc[mt][r] + Dh * xv[r]) * fast_silu(z[r]); sq += hq[mt][r] * hq[mt][r]; } }
    }
    sq += __shfl_xor(sq, 16); sq += __shfl_xor(sq, 32);
    if (lane < 8) sqb[lane * 8 + wid] = sq;
    __syncthreads();
    if (fr < 8) { const f32x4 s0 = *(LAS f32x4*)(sqb + fr * 8), s1 = *(LAS f32x4*)(sqb + fr * 8 + 4);
        const float rs = 1.f / sqrtf(((s0[0] + s0[1]) + (s0[2] + s0[3]) + (s1[0] + s1[1]) + (s1[2] + s1[3])) * (1.f / 512.f) + LN_EPS);
#pragma unroll
        for (int mt = 0; mt < 4; ++mt) { const int ch = h * HDIM + 16 * mt + 4 * fq; const f32x4 gv = *(const f32x4*)(gw + ch);
            u32x2 o; o.x = pk_bf16(hq[mt][0] * rs * gv[0], hq[mt][1] * rs * gv[1]); o.y = pk_bf16(hq[mt][2] * rs * gv[2], hq[mt][3] * rs * gv[3]);
            *(u32x2*)(A2 + (size_t)(R0 + fr) * DM + ch) = o; } }
}

__device__ __forceinline__ void p_transpose_tile(const VB& v, bool on, const float* __restrict__ W, int K, int ld, int col0, int N, bf16* __restrict__ WT, int item) {
    LAS float* tile = v.scr;
    const int nb = N / 64, kb = item / nb, nbi = item % nb, k0 = kb * 64, n0 = nbi * 64, tid = v.vt;
    if (on) {
#pragma unroll
        for (int i = 0; i < 16; ++i) { const int kk = i * 4 + (tid >> 6), nn = tid & 63; tile[kk * 65 + nn] = W[(size_t)(k0 + kk) * ld + col0 + n0 + nn]; }
    }
    __syncthreads();
    if (on) {
#pragma unroll
        for (int i = 0; i < 16; ++i) { const int nn = i * 4 + (tid >> 6), kk = tid & 63; WT[(size_t)(n0 + nn) * K + k0 + kk] = f2bf(tile[kk * 65 + nn]); }
    }
    __syncthreads();
}
__device__ __forceinline__ void p_mod_item(const VB& v, bool on, int item, const float* __restrict__ c_prompt, const float* __restrict__ c_sample, const float* __restrict__ w_mod, const float* __restrict__ b_mod, float* __restrict__ mod) {
    LAS float* sc = v.scr;
    const int tid = v.vt, bx = item % (NMOD / 256), by = item / (NMOD / 256), n = bx * 256 + tid, r0 = by * 12;
    float acc[12];
#pragma unroll
    for (int i = 0; i < 12; ++i) acc[i] = 0.f;
    for (int k0 = 0; k0 < DM; k0 += 256) {
        __syncthreads();
        if (on) {
#pragma unroll
            for (int i = 0; i < 12; ++i) { const int r = r0 + i; const float* c = r < NPB ? c_prompt + (size_t)r * DM : c_sample + (size_t)(r - NPB) * DM; sc[i * 256 + tid] = silu_f(c[k0 + tid]); }
        }
        __syncthreads();
        if (on) {
            for (int kk = 0; kk < 256; ++kk) { const float w = w_mod[(size_t)(k0 + kk) * NMOD + n];
#pragma unroll
                for (int i = 0; i < 12; ++i) acc[i] += sc[i * 256 + kk] * w; }
        }
    }
    if (on) { const float bb = b_mod[n];
#pragma unroll
        for (int i = 0; i < 12; ++i) mod[(size_t)(r0 + i) * NMOD + n] = acc[i] + bb; }
}
__device__ __forceinline__ void p_ln_h1_row(const VB& vb, int r, const float* __restrict__ x_prompt, const float* __restrict__ x_sample, const float* __restrict__ g, const float* __restrict__ b,
                                            const float* __restrict__ mod, float* __restrict__ stats, bf16* __restrict__ h1) {
    const int tid = vb.vt;
    const float* xr = r < MP ? x_prompt + (size_t)r * DM : x_sample + (size_t)(r - MP) * DM;
    float v[8];
    { const f32x4 a = *(const f32x4*)(xr + tid * 4), c = *(const f32x4*)(xr + 1024 + tid * 4); v[0] = a[0]; v[1] = a[1]; v[2] = a[2]; v[3] = a[3]; v[4] = c[0]; v[5] = c[1]; v[6] = c[2]; v[7] = c[3]; }
    float s = 0.f;
#pragma unroll
    for (int j = 0; j < 8; ++j) s += v[j];
    const float mean = vb_sum(s, vb.scr, tid) * (1.f / DM);
    float q = 0.f;
#pragma unroll
    for (int j = 0; j < 8; ++j) { const float d = v[j] - mean; q += d * d; }
    const float rstd = 1.f / sqrtf(vb_sum(q, vb.scr, tid) * (1.f / DM) + LN_EPS);
    if (tid == 0) { stats[2 * r] = mean; stats[2 * r + 1] = rstd; }
    const float* mr = mod + (size_t)modrow(r) * NMOD;
#pragma unroll
    for (int j = 0; j < 8; ++j) { const int c = (j < 4 ? 0 : 1024) + tid * 4 + (j & 3);
        const float xn = (v[j] - mean) * rstd * g[c] + b[c];
        h1[(size_t)r * DM + c] = f2bf(xn * (1.f + mr[DM + c]) + mr[c]); }
}
__device__ __forceinline__ void p_dt_item(int vt, int item, const bf16* __restrict__ h1, const float* __restrict__ wdt, const float* __restrict__ dt_bias, float* __restrict__ dt) {
    const int r = item * 16 + (vt >> 4), h = vt & 15;
    const bf16* hr = h1 + (size_t)r * DM; const float* w = wdt + (size_t)h * DM;
    float a = 0.f;
    for (int k = 0; k < DM; ++k) a += bf2f(hr[k]) * w[k];
    dt[r * 16 + h] = softplus_f(a + dt_bias[h]);
}
__device__ __forceinline__ void p_conv_item(int vt, int item, const bf16* __restrict__ proj, const float* __restrict__ state_conv, const float* __restrict__ conv_w, const float* __restrict__ conv_b,
                                            float* __restrict__ act, float* __restrict__ out) {
    const int r = item / 6, c = (item % 6) * 256 + vt;
    int t, rowbase; const float* sc = nullptr;
    if (r < MP) { t = r & (SEQ - 1); rowbase = r - t; } else { const int bs = (r - MP) >> 3; t = (r - MP) & 7; rowbase = r - t; sc = state_conv + (size_t)bs * 3 * CONVD; }
    float a = conv_b[c];
#pragma unroll
    for (int k = 0; k < 4; ++k) { const int tp = t - 3 + k; float xv;
        if (tp >= 0) xv = bf2f(proj[(size_t)(rowbase + tp) * NPROJ + PX + c]); else xv = sc ? sc[(size_t)(tp + 3) * CONVD + c] : 0.f;
        a += conv_w[k * CONVD + c] * xv; }
    act[(size_t)r * CONVD + c] = silu_f(a);
    const float pre = bf2f(proj[(size_t)r * NPROJ + PX + c]);
    if (r < MP) { if (t >= SEQ - 3) out[O_CONVP + ((size_t)(r >> 11) * 3 + (t - (SEQ - 3))) * CONVD + c] = pre; }
    else { if (t >= DSEQ - 3) out[O_CONVS + ((size_t)((r - MP) >> 3) * 3 + (t - (DSEQ - 3))) * CONVD + c] = pre; }
}
__device__ __forceinline__ void p_ssd_seq_item(int tid, int item, const float* __restrict__ act, const float* __restrict__ dt, const float* __restrict__ a_log, const float* __restrict__ d_skip,
                                               const float* __restrict__ state_ssm, float* __restrict__ y, float* __restrict__ out) {
    const int seq = item >> 4, h = item & 15, p = tid >> 2, q = tid & 3, g = h >> 3;
    const float A = -expf(a_log[h]), D = d_skip[h];
    int row0, L; float* sout;
    float S[32];
    if (seq < NPB) { row0 = seq * SEQ; L = SEQ; sout = out + O_SSMP + ((size_t)(seq * NHEAD + h) * HDIM + p) * NSTATE + q * 32;
#pragma unroll
        for (int n = 0; n < 32; ++n) S[n] = 0.f; }
    else { const int bs = seq - NPB; row0 = MP + bs * DSEQ; L = DSEQ; sout = out + O_SSMS + ((size_t)(bs * NHEAD + h) * HDIM + p) * NSTATE + q * 32;
        const float* s0 = state_ssm + ((size_t)(bs * NHEAD + h) * HDIM + p) * NSTATE + q * 32;
#pragma unroll
        for (int n = 0; n < 32; ++n) S[n] = s0[n]; }
    for (int t = 0; t < L; ++t) {
        const int r = row0 + t; const float* ar = act + (size_t)r * CONVD;
        const float dtv = dt[r * 16 + h], dA = expf(dtv * A), xv = ar[h * HDIM + p], xd = dtv * xv;
        const float* Bp = ar + SSDW + g * NSTATE + q * 32; const float* Cp = ar + SSDW + NGRP * NSTATE + g * NSTATE + q * 32;
        float part = 0.f;
#pragma unroll
        for (int n = 0; n < 32; ++n) { S[n] = dA * S[n] + xd * Bp[n]; part += S[n] * Cp[n]; }
        part += __shfl_xor(part, 1); part += __shfl_xor(part, 2);
        if (q == 0) y[(size_t)r * SSDW + h * HDIM + p] = part + D * xv;
    }
#pragma unroll
    for (int n = 0; n < 32; ++n) sout[n] = S[n];
}
__device__ __forceinline__ void p_gated_norm_row(const VB& vb, int r, const float* __restrict__ y, const bf16* __restrict__ proj, const float* __restrict__ gw, bf16* __restrict__ A2) {
    LAS float* red = vb.scr; const int tid = vb.vt, c0 = tid * 4;
    float hv[4]; float q = 0.f;
#pragma unroll
    for (int j = 0; j < 4; ++j) { const float z = bf2f(proj[(size_t)r * NPROJ + PZ + c0 + j]); hv[j] = y[(size_t)r * SSDW + c0 + j] * silu_f(z); q += hv[j] * hv[j]; }
    q = wave_sum(q);
    __syncthreads();
    if ((tid & 63) == 0) red[tid >> 6] = q;
    __syncthreads();
    const float ms = (tid < 128 ? red[0] + red[1] : red[2] + red[3]) * (1.f / 512.f);
    const float rs = 1.f / sqrtf(ms + LN_EPS);
#pragma unroll
    for (int j = 0; j < 4; ++j) A2[(size_t)r * DM + c0 + j] = f2bf(hv[j] * rs * gw[c0 + j]);
}
__device__ __forceinline__ void p_vn_row(const VB& vb, int r, const bf16* __restrict__ proj, const float* __restrict__ g, const float* __restrict__ b, float* __restrict__ vn, float* __restrict__ out) {
    const int tid = vb.vt, c0 = tid * 4;
    float v[4]; float s = 0.f;
#pragma unroll
    for (int j = 0; j < 4; ++j) { v[j] = gelu_f(bf2f(proj[(size_t)r * NPROJ + PV + c0 + j])); s += v[j]; }
    const float mean = vb_sum(s, vb.scr, tid) * (1.f / GMW);
    float q = 0.f;
#pragma unroll
    for (int j = 0; j < 4; ++j) { const float d = v[j] - mean; q += d * d; }
    const float rstd = 1.f / sqrtf(vb_sum(q, vb.scr, tid) * (1.f / GMW) + LN_EPS);
#pragma unroll
    for (int j = 0; j < 4; ++j) { const float o = (v[j] - mean) * rstd * g[c0 + j] + b[c0 + j]; vn[(size_t)r * GMW + c0 + j] = o; if (r >= MP) out[O_CV + (size_t)(r - MP) * GMW + c0 + j] = o; }
}
__device__ __forceinline__ void p_gmlp_mix_row(int tid, int r, const bf16* __restrict__ proj, const float* __restrict__ vn, const float* __restrict__ w_s, const float* __restrict__ b_s, bf16* __restrict__ A2) {
    const int c0 = tid * 4, hd = c0 >> 7;
    const int i = r < MP ? (r & 127) : ((r - MP) & 7), base = r - i;
    const float* wrow = w_s + ((size_t)hd * 128 + i) * 128;
    float a[4] = {0.f, 0.f, 0.f, 0.f};
    for (int j = 0; j <= i; ++j) { const float w = wrow[j]; const f32x4 vv = *(const f32x4*)(vn + (size_t)(base + j) * GMW + c0);
#pragma unroll
        for (int e = 0; e < 4; ++e) a[e] += w * vv[e]; }
    const float bs = b_s[hd * 128 + i];
#pragma unroll
    for (int e = 0; e < 4; ++e) { const float u = gelu_f(bf2f(proj[(size_t)r * NPROJ + PU + c0 + e])); A2[(size_t)r * DM + SSDW + c0 + e] = f2bf(u * (a[e] + bs)); }
}
__device__ __forceinline__ void p_ln_mix_row(const VB& vb, int r, const float* __restrict__ x_prompt, const float* __restrict__ x_sample, const float* __restrict__ stats, const float* __restrict__ lg, const float* __restrict__ lb,
                                             const float* __restrict__ mod, const float* __restrict__ mix, const float* __restrict__ g2, const float* __restrict__ b2, float* __restrict__ x1, bf16* __restrict__ h2) {
    const int tid = vb.vt;
    const float* xr = r < MP ? x_prompt + (size_t)r * DM : x_sample + (size_t)(r - MP) * DM;
    const float mean0 = stats[2 * r], rstd0 = stats[2 * r + 1];
    const float* mr = mod + (size_t)modrow(r) * NMOD;
    float v[8]; float s = 0.f;
#pragma unroll
    for (int j = 0; j < 8; ++j) { const int c = (j < 4 ? 0 : 1024) + tid * 4 + (j & 3);
        const float xn = (xr[c] - mean0) * rstd0 * lg[c] + lb[c];
        v[j] = ALPHA * xn + (1.f + mr[2 * DM + c]) * mix[(size_t)r * DM + c]; s += v[j]; }
    const float mean = vb_sum(s, vb.scr, tid) * (1.f / DM);
    float q = 0.f;
#pragma unroll
    for (int j = 0; j < 8; ++j) { const float d = v[j] - mean; q += d * d; }
    const float rstd = 1.f / sqrtf(vb_sum(q, vb.scr, tid) * (1.f / DM) + LN_EPS);
#pragma unroll
    for (int j = 0; j < 8; ++j) { const int c = (j < 4 ? 0 : 1024) + tid * 4 + (j & 3);
        const float o = (v[j] - mean) * rstd * g2[c] + b2[c];
        x1[(size_t)r * DM + c] = o;
        h2[(size_t)r * DM + c] = f2bf(o * (1.f + mr[4 * DM + c]) + mr[3 * DM + c]); }
}
__device__ __forceinline__ void p_ln_out_row(const VB& vb, int r, const float* __restrict__ mod, const float* __restrict__ f, const float* __restrict__ g3, const float* __restrict__ b3, float* __restrict__ xy) {
    const int tid = vb.vt;
    const float* mr = mod + (size_t)modrow(r) * NMOD;
    float v[8]; float s = 0.f;
#pragma unroll
    for (int j = 0; j < 8; ++j) { const int c = (j < 4 ? 0 : 1024) + tid * 4 + (j & 3);
        v[j] = ALPHA * xy[(size_t)r * DM + c] + (1.f + mr[5 * DM + c]) * f[(size_t)r * DM + c]; s += v[j]; }
    const float mean = vb_sum(s, vb.scr, tid) * (1.f / DM);
    float q = 0.f;
#pragma unroll
    for (int j = 0; j < 8; ++j) { const float d = v[j] - mean; q += d * d; }
    const float rstd = 1.f / sqrtf(vb_sum(q, vb.scr, tid) * (1.f / DM) + LN_EPS);
#pragma unroll
    for (int j = 0; j < 8; ++j) { const int c = (j < 4 ? 0 : 1024) + tid * 4 + (j & 3); xy[(size_t)r * DM + c] = (v[j] - mean) * rstd * g3[c] + b3[c]; }
}

__global__ void __launch_bounds__(NWAVES * 64, 2) mega_fwd(Args args) {
    extern __shared__ __attribute__((aligned(16))) unsigned char lds_raw[];
    LAS unsigned char* lds = (LAS unsigned char*)lds_raw;
    volatile LAS unsigned* MISC = (volatile LAS unsigned*)(lds + MISC_OFF);
    const int tid = threadIdx.x, G = gridDim.x;
    for (int u = tid; u < (LDS_BYTES - LDSCTL_OFF) / 4; u += NWAVES * 64) ((LAS unsigned*)(lds + LDSCTL_OFF))[u] = 0u;
    __syncthreads();
    unsigned char* ws = args.ws;
    XcdBarrier bar = xcd_barrier_post((unsigned*)(ws + WS_CTL) + CW_BAR, MISC + 8);
    unsigned* ctlw = (unsigned*)(ws + WS_CTL);

    const float* x_prompt = args.in[0]; const float* x_sample = args.in[1]; const float* state_ssm = args.in[2]; const float* state_conv = args.in[3];
    const float* c_prompt = args.in[4]; const float* c_sample = args.in[5]; const float* ln_in_g = args.in[6]; const float* ln_in_b = args.in[7];
    const float* w_mod = args.in[8]; const float* b_mod = args.in[9]; const float* w_in = args.in[10]; const float* conv_w = args.in[11];
    const float* conv_b = args.in[12]; const float* dt_bias = args.in[13]; const float* a_log = args.in[14]; const float* d_skip = args.in[15];
    const float* ssd_norm_g = args.in[16]; const float* gm_ln_g = args.in[17]; const float* gm_ln_b = args.in[18]; const float* gm_w_s = args.in[19];
    const float* gm_b_s = args.in[20]; const float* w_out = args.in[21]; const float* ln_mix_g = args.in[22]; const float* ln_mix_b = args.in[23];
    const float* w_ff1 = args.in[24]; const float* w_ff2 = args.in[25]; const float* ln_ffn_g = args.in[26]; const float* ln_ffn_b = args.in[27];
    float* out = args.out;
    bf16* Wt_in = (bf16*)(ws + WS_WIN); bf16* Wt_out = (bf16*)(ws + WS_WOUT); bf16* Wt_ff1 = (bf16*)(ws + WS_WFF1); bf16* Wt_ff2 = (bf16*)(ws + WS_WFF2);
    float* mod = (float*)(ws + WS_MOD); float* stats = (float*)(ws + WS_STATS); float* vstats = (float*)(ws + WS_STATS + 512 * 1024); float* dt = (float*)(ws + WS_DT);
    bf16* hbuf = (bf16*)(ws + WS_H); bf16* proj = (bf16*)(ws + WS_BIG); float* act = (float*)(ws + WS_ACT); bf16* hid = (bf16*)(ws + WS_BIG);
    bf16* mixb = (bf16*)(ws + WS_E); bf16* csilu = (bf16*)(ws + WS_STATS + 256 * 1024); bf16* slab1 = (bf16*)(ws + WS_BIG); bf16* slab2 = (bf16*)(ws + WS_SLAB2); bf16* xsb = (bf16*)(ws + WS_SLAB2);   float* ybuf = (float*)(ws + WS_E); bf16* cs = (bf16*)(ws + WS_E); float* cd = (float*)(ws + WS_CD); bf16* s_in = (bf16*)(ws + WS_SIN); float* vn = (float*)(ws + WS_VN); float* mix = (float*)(ws + WS_E); float* fbuf = (float*)(ws + WS_E);

    #define MAKE_VB() VB vb; { int t_ = threadIdx.x; asm volatile("" : "+v"(t_)); const int half_ = __builtin_amdgcn_readfirstlane(t_ >> 8); vb.vt = t_ & 255; vb.id = (int)blockIdx.x * 2 + half_; vb.n = 2 * (int)gridDim.x; vb.scr = (LAS float*)(lds + half_ * 32768); }

    { int t_ = threadIdx.x; asm volatile("" : "+v"(t_)); const int lane = t_ & 63, wv = __builtin_amdgcn_readfirstlane(t_ >> 6), gw = (int)blockIdx.x * NWAVES + wv, NGW = G * NWAVES;
      for (int i = (int)blockIdx.x * 512 + t_; i < NSEQ * DM / 4; i += G * 512) { const int r = i / (DM / 4), k4 = i % (DM / 4);
          const f32x4 cv = *(const f32x4*)((r < NPB ? c_prompt + (size_t)r * DM : c_sample + (size_t)(r - NPB) * DM) + 4 * k4);
          u32x2 w; w.x = pk_bf16(fast_silu(cv[0]), fast_silu(cv[1])); w.y = pk_bf16(fast_silu(cv[2]), fast_silu(cv[3])); *(u32x2*)(csilu + (size_t)r * DM + 4 * k4) = w; }
      asm volatile("s_waitcnt vmcnt(0)" ::: "memory");
      __syncthreads();
      if (t_ == 0) { __builtin_amdgcn_fence(__ATOMIC_RELEASE, "agent"); asm volatile("s_waitcnt vmcnt(0)" ::: "memory"); (void)xb_add(ctlw + CW_CSILU, 1u); }
      LAS float* scr = (LAS float*)(lds + wv * 8448);
      constexpr int I1 = 32 * 80, I2 = 32 * 64, I3 = 32 * 64, I4 = 32 * 256, I5 = 128 * 64;
      const int IT = (G == 256) ? I1 + I2 : I1 + I2 + I3 + I4 + I5;
      for (int it = gw; it < IT; it += NGW) { int r = it;
          if (r < I1) { p0_transpose_item(w_in, DM, DINP, 80, Wt_in, scr, r, lane); continue; } r -= I1;
          if (r < I2) { p0_transpose_item(w_in + 2576, DM, DINP, 64, Wt_in + (size_t)2560 * DM, scr, r, lane); continue; } r -= I2;
          if (r < I3) { p0_transpose_item(w_out, DM, DM, 64, Wt_out, scr, r, lane); continue; } r -= I3;
          if (r < I4) { p0_transpose_item(w_ff1, DM, DFF, 256, Wt_ff1, scr, r, lane); continue; } r -= I4;
          p0_transpose_item(w_ff2, DFF, DM, 64, Wt_ff2, scr, r, lane); }
      for (int i = (int)blockIdx.x * 512 + t_; i < 256 * DM; i += G * 512) { const int h = i / DM, k = i % DM; Wt_in[(size_t)(NPROJ + h) * DM + k] = h < 16 ? f2bf(w_in[(size_t)k * DINP + 2560 + h]) : (bf16)0; }
    }
    { int t_ = threadIdx.x; asm volatile("" : "+v"(t_));
      if (t_ == 0) { unsigned* tmo = ctlw + CW_BAR; XB_SPIN(xb_ld(ctlw + CW_CSILU) < (unsigned)G, tmo); __builtin_amdgcn_fence(__ATOMIC_ACQUIRE, "agent"); asm volatile("s_waitcnt vmcnt(0)" ::: "memory"); }
      __syncthreads(); }
    if (G == 256) mod_item(lds, ((int)blockIdx.x & 7) * 32 + ((int)blockIdx.x >> 3), csilu, w_mod, b_mod, mod);
    else for (int it = blockIdx.x; it < NMOD / 48; it += G) mod_item(lds, it, csilu, w_mod, b_mod, mod);
    xcd_barrier(bar);
    { int t_ = threadIdx.x; asm volatile("" : "+v"(t_)); const int lane = t_ & 63, gw = (int)blockIdx.x * NWAVES + __builtin_amdgcn_readfirstlane(t_ >> 6), NGW = G * NWAVES;
      LAS float* UV = (LAS float*)lds;
      __syncthreads();
      {
          const int c = 4 * t_; const f32x4 g = *(const f32x4*)(ln_in_g + c), b = *(const f32x4*)(ln_in_b + c);
          f32x4 sc[NPB], sh[NPB];
#pragma unroll
          for (int bb = 0; bb < NPB; ++bb) { sc[bb] = *(const f32x4*)(mod + (size_t)bb * NMOD + DM + c); sh[bb] = *(const f32x4*)(mod + (size_t)bb * NMOD + c); }
#pragma unroll
          for (int bb = 0; bb < NPB; ++bb) { const f32x4 s1 = sc[bb] + 1.f; *(LAS f32x4*)(UV + bb * 2 * DM + c) = g * s1; *(LAS f32x4*)(UV + bb * 2 * DM + DM + c) = b * s1 + sh[bb]; } }
      __syncthreads();
      const int rs_odd = gw & 1, rs_j = gw >> 1, rs_n = (G == 256) ? (rs_odd ? 5 : 4) : (MROWS - gw + NGW - 1) / NGW;
#pragma unroll 1
      for (int rs_k = 0; rs_k < rs_n; ++rs_k) { const int r = (G != 256) ? gw + rs_k * NGW : rs_odd ? 3072 + rs_j + 1024 * rs_k : (rs_k == 0 ? MP + rs_j : rs_j + 1024 * (rs_k - 1));
          if (r < MP) w_ln_h1_lds(r, lane, x_prompt + (size_t)r * DM, UV + (r >> 11) * 2 * DM, stats, hbuf);
          else w_ln_h1_row(r, lane, x_prompt, x_sample, ln_in_g, ln_in_b, mod, stats, hbuf, nullptr); } }
    xcd_barrier(bar);
    { pg8::Gemm g{hbuf, Wt_in, MROWS, NPROJ + 256, DM, 0}; pg8::StaticOrder S; S.init(MROWS, NPROJ + 256, G, (int)blockIdx.x, DM); pg8::EpiProj E{proj, dt, dt_bias};
      pg8::gemm_phase<pg8::EpiProj, pg8::StaticOrder, true, true>(lds, g, S, E); }
    if (G == 256 && blockIdx.x >= 172) {
        int t_ = threadIdx.x; asm volatile("" : "+v"(t_)); const int lane = t_ & 63, wv = __builtin_amdgcn_readfirstlane(t_ >> 6); LAS float* scr = (LAS float*)(lds + wv * 8448);
        for (int it = ((int)blockIdx.x - 172) * NWAVES + wv; it < 32 * 256 + 32 * 64; it += 84 * NWAVES) {
            if (it < 32 * 256) p0_transpose_item(w_ff1, DM, DFF, 256, Wt_ff1, scr, it, lane); else p0_transpose_item(w_out, DM, DM, 64, Wt_out, scr, it - 32 * 256, lane); } }
    xcd_barrier(bar);
    { const bool sample_first = (((int)blockIdx.x >> 3) & 1) != 0;
#pragma unroll 1
      for (int step = 0; step < 3; ++step) {
        const int what = (step == 1) ? 0 : (((step == 0) == sample_first) ? 1 : 2);
        if (what == 0) {
    { MAKE_VB();
    for (int i = vb.id * 256 + vb.vt; i < NPB * 3 * CONVD; i += vb.n * 256) { const int bb = i / (3 * CONVD), jj = (i / CONVD) % 3, cc = i % CONVD; out[O_CONVP + i] = bf2f(proj[(size_t)(bb * SEQ + SEQ - 3 + jj) * NPROJ + PX + cc]); }
    }
    { int t_ = threadIdx.x; asm volatile("" : "+v"(t_)); const int lane = t_ & 63, gw = (int)blockIdx.x * NWAVES + __builtin_amdgcn_readfirstlane(t_ >> 6), NGW = G * NWAVES;
      for (int r = gw; r < MROWS; r += NGW) w_gmlp_ln_row(r, lane, proj, gm_ln_g, gm_ln_b, out); }
        } else if (what == 1) { for (int it = blockIdx.x; it < NSB * NGRP; it += G) sample_ssd_item(lds, it, proj, dt, state_conv, conv_w, conv_b, a_log, d_skip, ssd_norm_g, state_ssm, hbuf, out); }
        else { for (int it = blockIdx.x; it < NPB * 16 * NGRP * 2; it += G) ssd_phaseA_item(lds, it, proj, dt, conv_w, conv_b, a_log, cs, cd, xsb); }
      } }
    xcd_barrier(bar);
    { MAKE_VB();
    if ((int)threadIdx.x < 256)
    for (int e = (int)blockIdx.x * 256 + (int)threadIdx.x; e < NPB * NHEAD * HDIM * NSTATE / 8; e += G * 256) {
        const int bh = e / (HDIM * NSTATE / 8), rem = e % (HDIM * NSTATE / 8), bb = bh >> 4, hh = bh & 15;
        u32x4 cv[16]; float dc[16];
#pragma unroll
        for (int cc = 0; cc < 16; ++cc) { cv[cc] = __builtin_nontemporal_load((const u32x4*)(cs + ((size_t)((bb * 16 + cc) * 16 + hh) * (HDIM * NSTATE / 8) + rem) * 8)); dc[cc] = cd[(bb * 16 + cc) * 16 + hh]; }
        float sv[8];
#pragma unroll
        for (int k = 0; k < 8; ++k) sv[k] = 0.f;
#pragma unroll
        for (int cc = 0; cc < 16; ++cc) {
            u32x4 w; w.x = pk_bf16(sv[0], sv[1]); w.y = pk_bf16(sv[2], sv[3]); w.z = pk_bf16(sv[4], sv[5]); w.w = pk_bf16(sv[6], sv[7]);
            *(u32x4*)(s_in + ((size_t)((bb * 16 + cc) * 16 + hh) * (HDIM * NSTATE / 8) + rem) * 8) = w;
#pragma unroll
            for (int k = 0; k < 4; ++k) { sv[2 * k] = sv[2 * k] * dc[cc] + __uint_as_float(cv[cc][k] << 16); sv[2 * k + 1] = sv[2 * k + 1] * dc[cc] + __uint_as_float(cv[cc][k] & 0xffff0000u); } }
        *(f32x4*)(out + O_SSMP + (size_t)e * 8) = (f32x4){sv[0], sv[1], sv[2], sv[3]}; *(f32x4*)(out + O_SSMP + (size_t)e * 8 + 4) = (f32x4){sv[4], sv[5], sv[6], sv[7]}; }
    }
    xcd_barrier(bar);
    { MAKE_VB();
    }
    if (G == 256) {
        const int bx = (int)blockIdx.x, rh = (bx >> 3) & 1, w = (bx & 7) + 8 * (bx >> 4);
        ssd_phaseC_half(lds, 2 * w + rh, proj, dt, conv_w, conv_b, a_log, d_skip, ssd_norm_g, s_in, xsb, hbuf);
        if (rh == 0) gmlp_group(lds, w & 7, w >> 3, 16, 3, proj, gm_w_s, gm_b_s, hbuf);
        else { gmlp_group(lds, w & 7, 48 + (w >> 3), 0, 1, proj, gm_w_s, gm_b_s, hbuf); gmlp_sample_item(w, proj, out + O_CV, gm_w_s, gm_b_s, hbuf); }
    } else {
        for (int it = blockIdx.x; it < NPB * 16 * NGRP * 2; it += G) ssd_phaseC_half(lds, it, proj, dt, conv_w, conv_b, a_log, d_skip, ssd_norm_g, s_in, xsb, hbuf);
        for (int it = blockIdx.x; it < NPB * 16 * GMNH; it += G) gmlp_group(lds, it & 7, it >> 3, 0, 1, proj, gm_w_s, gm_b_s, hbuf);
        for (int bs = blockIdx.x; bs < NSB; bs += G) gmlp_sample_item(bs, proj, out + O_CV, gm_w_s, gm_b_s, hbuf);
    }
    xcd_barrier(bar);
    { pg8::Gemm g{hbuf, Wt_out, MROWS, DM, DM, 0}; pg8::EpiBf16S E{mixb, slab1, DM, 0};
      if (G == 256) { pg8::SplitOrder S; S.init((int)blockIdx.x, DM); pg8::gemm_phase<pg8::EpiBf16S, pg8::SplitOrder, true, true>(lds, g, S, E); }
      else { pg8::StaticOrder S; S.init(MROWS, DM, G, (int)blockIdx.x, DM); pg8::gemm_phase<pg8::EpiBf16S, pg8::StaticOrder, true, true>(lds, g, S, E); } }
    {
      LAS float* Cc = (LAS float*)lds; LAS float* Bt = Cc + 4 * DM;
      xcd_barrier_fill(bar, [&]() { int t_ = threadIdx.x; asm volatile("" : "+v"(t_));
#pragma unroll 1
        for (int cg = t_ - 64; cg < 512; cg += 448) {
          const int c = 4 * cg; const f32x4 g1 = *(const f32x4*)(ln_in_g + c), b1 = *(const f32x4*)(ln_in_b + c), g2 = *(const f32x4*)(ln_mix_g + c), b2 = *(const f32x4*)(ln_mix_b + c);
          f32x4 gm[NPB], scf[NPB], shf[NPB];
#pragma unroll
          for (int bb = 0; bb < NPB; ++bb) { const float* mr = mod + (size_t)bb * NMOD + c; gm[bb] = *(const f32x4*)(mr + 2 * DM); shf[bb] = *(const f32x4*)(mr + 3 * DM); scf[bb] = *(const f32x4*)(mr + 4 * DM); }
          *(LAS f32x4*)(Cc + c) = g1 * ALPHA; *(LAS f32x4*)(Cc + DM + c) = b1 * ALPHA; *(LAS f32x4*)(Cc + 2 * DM + c) = g2; *(LAS f32x4*)(Cc + 3 * DM + c) = b2;
#pragma unroll
          for (int bb = 0; bb < NPB; ++bb) { const f32x4 s1 = scf[bb] + 1.f; *(LAS f32x4*)(Bt + bb * 3 * DM + c) = gm[bb] + 1.f; *(LAS f32x4*)(Bt + bb * 3 * DM + DM + c) = g2 * s1; *(LAS f32x4*)(Bt + bb * 3 * DM + 2 * DM + c) = b2 * s1 + shf[bb]; } } }); }
    { int t_ = threadIdx.x; asm volatile("" : "+v"(t_)); const int lane = t_ & 63, gw = (int)blockIdx.x * NWAVES + __builtin_amdgcn_readfirstlane(t_ >> 6), NGW = G * NWAVES;
      LAS float* Cc = (LAS float*)lds; LAS float* Bt = Cc + 4 * DM;
      const int rs_odd = gw & 1, rs_j = gw >> 1, rs_n = (G == 256) ? (rs_odd ? 5 : 4) : (MROWS - gw + NGW - 1) / NGW;
#pragma unroll 1
      for (int rs_k = 0; rs_k < rs_n; ++rs_k) { const int r = (G != 256) ? gw + rs_k * NGW : rs_odd ? 3072 + rs_j + 1024 * rs_k : (rs_k == 0 ? MP + rs_j : rs_j + 1024 * (rs_k - 1));
          if (r < MP) w_ln_mix3_lds(r, lane, x_prompt + (size_t)r * DM, mixb + (size_t)r * DM, stats, Cc, Bt + (r >> 11) * 3 * DM, (bf16*)(out + O_YP) + (size_t)r * 2 * DM, hbuf + (size_t)r * DM);
          else w_ln_mix3_row(r, lane, x_prompt, x_sample, stats, ln_in_g, ln_in_b, mod, mixb, G == 256 ? slab1 : nullptr, ln_mix_g, ln_mix_b, (bf16*)(out + O_YP), 2 * DM, hbuf); } }
    xcd_barrier(bar);
    { pg8::Gemm g{hbuf, Wt_ff1, MROWS, DFF, DM, 0}; pg8::StaticOrder S; S.init(MROWS, DFF, G, (int)blockIdx.x, DM); pg8::EpiBf16P<2> E{hid, DFF, 0};
      pg8::gemm_phase<pg8::EpiBf16P<2>, pg8::StaticOrder, true, true>(lds, g, S, E); }
    if (G == 256 && blockIdx.x >= 128) {
        int t_ = threadIdx.x; asm volatile("" : "+v"(t_)); const int lane = t_ & 63, wv = __builtin_amdgcn_readfirstlane(t_ >> 6); LAS float* scr = (LAS float*)(lds + wv * 8448);
        for (int it = ((int)blockIdx.x - 128) * NWAVES + wv; it < 128 * 64; it += 128 * NWAVES) p0_transpose_item(w_ff2, DFF, DM, 64, Wt_ff2, scr, it, lane); }
    xcd_barrier(bar);
    { pg8::Gemm g{hid, Wt_ff2, MROWS, DM, DFF, 0}; pg8::EpiBf16S E{mixb, slab2, DM, 0};
      if (G == 256) { pg8::SplitOrder S; S.init((int)blockIdx.x, DFF); pg8::gemm_phase<pg8::EpiBf16S, pg8::SplitOrder, true, true>(lds, g, S, E); }
      else { pg8::StaticOrder S; S.init(MROWS, DM, G, (int)blockIdx.x, DFF); pg8::gemm_phase<pg8::EpiBf16S, pg8::StaticOrder, true, true>(lds, g, S, E); } }
    {
      LAS float* Cc = (LAS float*)lds; LAS float* GF = Cc + 2 * DM;
      xcd_barrier_fill(bar, [&]() { int t_ = threadIdx.x; asm volatile("" : "+v"(t_));
#pragma unroll 1
        for (int cg = t_ - 64; cg < 512; cg += 448) {
          const int c = 4 * cg; const f32x4 g3 = *(const f32x4*)(ln_ffn_g + c), b3 = *(const f32x4*)(ln_ffn_b + c);
          f32x4 gf[NPB];
#pragma unroll
          for (int bb = 0; bb < NPB; ++bb) gf[bb] = *(const f32x4*)(mod + (size_t)bb * NMOD + 5 * DM + c);
          *(LAS f32x4*)(Cc + c) = g3; *(LAS f32x4*)(Cc + DM + c) = b3;
#pragma unroll
          for (int bb = 0; bb < NPB; ++bb) *(LAS f32x4*)(GF + bb * DM + c) = gf[bb] + 1.f; } }); }
    { int t_ = threadIdx.x; asm volatile("" : "+v"(t_)); const int lane = t_ & 63, gw = (int)blockIdx.x * NWAVES + __builtin_amdgcn_readfirstlane(t_ >> 6), NGW = G * NWAVES;
      LAS float* Cc = (LAS float*)lds; LAS float* GF = Cc + 2 * DM;
      const int rs_odd = gw & 1, rs_j = gw >> 1, rs_n = (G == 256) ? (rs_odd ? 5 : 4) : (MROWS - gw + NGW - 1) / NGW;
#pragma unroll 1
      for (int rs_k = 0; rs_k < rs_n; ++rs_k) { const int r = (G != 256) ? gw + rs_k * NGW : rs_odd ? 3072 + rs_j + 1024 * rs_k : (rs_k == 0 ? MP + rs_j : rs_j + 1024 * (rs_k - 1));
          if (r < MP) w_ln_out3_lds(r, lane, (const bf16*)(out + O_YP) + (size_t)r * 2 * DM, mixb + (size_t)r * DM, Cc, GF + (r >> 11) * DM, out + O_YP + (size_t)r * DM, GF + NPB * DM + (gw & 7) * DM);
          else w_ln_out3_row(r, lane, mod, (const bf16*)(out + O_YP), 2 * DM, mixb, G == 256 ? slab2 : nullptr, ln_ffn_g, ln_ffn_b, out + O_YP); } }
}

extern "C" void kernel_launch(void* const* d_in, const int* in_sizes, int n_in, void* d_out, int out_size, void* d_ws, size_t ws_size, hipStream_t stream) {
    static int grid = 0;
    if (grid == 0) {
        if (n_in != 28 || ws_size < WS_END) { fprintf(stderr, "kernel_launch: unexpected n_in %d / ws_size %zu\n", n_in, ws_size); grid = -1; return; }
        int dev = 0, cus = 0;
        if (hipGetDevice(&dev) != hipSuccess || hipDeviceGetAttribute(&cus, hipDeviceAttributeMultiprocessorCount, dev) != hipSuccess) { grid = -1; return; }
        if (hipFuncSetAttribute((const void*)mega_fwd, hipFuncAttributeMaxDynamicSharedMemorySize, LDS_BYTES) != hipSuccess) { fprintf(stderr, "kernel_launch: hipFuncSetAttribute failed\n"); grid = -1; return; }
        int per_cu = 0; (void)hipOccupancyMaxActiveBlocksPerMultiprocessor(&per_cu, (const void*)mega_fwd, NWAVES * 64, LDS_BYTES); (void)hipGetLastError();
        if (per_cu < 1) fprintf(stderr, "kernel_launch: occupancy query reports %d blocks per CU\n", per_cu);
        grid = cus;
    }
    if (grid < 0) return;
    (void)hipMemsetAsync((char*)d_ws + WS_CTL, 0, CTL_ZERO_BYTES, stream);
    Args a{};
    for (int i = 0; i < 28; ++i) a.in[i] = (const float*)d_in[i];
    a.out = (float*)d_out; a.ws = (unsigned char*)d_ws;
    hipLaunchKernelGGL(mega_fwd, dim3(grid), dim3(NWAVES * 64), LDS_BYTES, stream, a);
}
```
